# Optimizing an MI355X kernel written in HIP

```python
import math
import jax, jax.numpy as jnp
from jax import lax
import numpy as np

D_MODEL = 1024
BATCH = 16
SEQ = 4096
DEPTH = 4

SB_HEADS = 8
SB_HEAD_DIM = D_MODEL // SB_HEADS
SB_WIDTH = SB_HEADS * SB_HEAD_DIM
SB_BLOCK = 128
S5_WIDTH = D_MODEL // 2
S5_GROUP = 16
S5_GROUPS = S5_WIDTH // S5_GROUP
S5_STATE = 64
S5_DT_MIN = 1e-3
S5_DT_MAX = 1e-1
EVEN_IN = 4 * SB_WIDTH + 2 * S5_WIDTH
EVEN_MIX = SB_WIDTH + S5_WIDTH
GLA_HEADS = 4
GLA_KEY = D_MODEL // 2
GLA_VAL = D_MODEL
GLA_DK = GLA_KEY // GLA_HEADS
GLA_DV = GLA_VAL // GLA_HEADS
GLA_RANK = 16
GLA_TAU = 16.0
GLA_CHUNK = 64
ODD_IN = 2 * GLA_KEY + 2 * GLA_VAL + GLA_RANK
N_EVEN = (DEPTH + 1) // 2
N_ODD = DEPTH // 2
EPS = 1e-6

kernel_name = "hybrid_stickbreak_s5_gla_trunk"


def rms_norm(x, g):
    xf = x.astype(jnp.float32)
    y = xf * lax.rsqrt(jnp.mean(xf * xf, axis=-1, keepdims=True) + EPS)
    return (y * g.astype(jnp.float32)).astype(x.dtype)


def stick_breaking_attention(q, k, v):
    bsz, L, h, dh = q.shape
    qf = q.astype(jnp.float32) * (dh ** -0.5)
    kf = k.astype(jnp.float32)
    vf = v.astype(jnp.float32)
    outs = []
    for blk in range(L // SB_BLOCK):
        q0 = blk * SB_BLOCK
        kend = q0 + SB_BLOCK
        z = jnp.einsum('bthd,bshd->bhts', qf[:, q0:kend], kf[:, :kend])
        t_idx = q0 + jnp.arange(SB_BLOCK)[:, None]
        s_idx = jnp.arange(kend)[None, :]
        causal = s_idx < t_idx
        log_beta = jax.nn.log_sigmoid(z)
        log_one_minus = jnp.where(causal, log_beta - z, 0.0)
        rest = lax.cumsum(log_one_minus, axis=3, reverse=True) - log_one_minus
        w = jnp.where(causal, jnp.exp(log_beta + rest), 0.0)
        outs.append(jnp.einsum('bhts,bshd->bthd', w, vf[:, :kend]))
    return jnp.concatenate(outs, axis=1).astype(q.dtype)


def s5_mixer(u, lam_re, lam_im, log_dt, b_re, b_im, c_re, c_im, d_skip, w_glu, b_glu):
    f32 = jnp.float32
    bsz, L, _ = u.shape
    uf = u.astype(f32).reshape(bsz, L, S5_GROUPS, S5_GROUP)
    lam = lax.complex(lam_re.astype(f32), lam_im.astype(f32))
    dt = jnp.exp(log_dt.astype(f32))[:, None]
    lam_bar = jnp.exp(lam * dt)
    bmat = lax.complex(b_re.astype(f32), b_im.astype(f32))
    b_bar = ((lam_bar - 1.0) / lam)[..., None] * bmat
    bu = lax.complex(jnp.einsum('gnp,blgp->blgn', b_bar.real, uf),
                     jnp.einsum('gnp,blgp->blgn', b_bar.imag, uf))
    a = jnp.broadcast_to(lam_bar, bu.shape)

    def combine(left, right):
        a_l, x_l = left
        a_r, x_r = right
        return a_r * a_l, a_r * x_l + x_r

    _, hstate = lax.associative_scan(combine, (a, bu), axis=1)
    y = (jnp.einsum('gpn,blgn->blgp', c_re.astype(f32), hstate.real)
         - jnp.einsum('gpn,blgn->blgp', c_im.astype(f32), hstate.imag)
         + d_skip.astype(f32) * uf)
    y = jax.nn.gelu(y.reshape(bsz, L, S5_WIDTH))
    y = y * jax.nn.sigmoid(y @ w_glu.astype(f32) + b_glu.astype(f32))
    return y.astype(u.dtype)


def gla_chunked(q, k, v, log_a):
    f32 = jnp.float32
    bsz, L, h, dk = q.shape
    dv = v.shape[-1]
    c = GLA_CHUNK
    n = L // c
    qc = (q.astype(f32) * (dk ** -0.5)).reshape(bsz, n, c, h, dk)
    kc = k.astype(f32).reshape(bsz, n, c, h, dk)
    vc = v.astype(f32).reshape(bsz, n, c, h, dv)
    g = jnp.cumsum(log_a.astype(f32).reshape(bsz, n, c, h, dk), axis=2)
    g_last = g[:, :, -1]
    q_dec = qc * jnp.exp(g)
    k_inv = kc * jnp.exp(-g)
    k_dec = kc * jnp.exp(g_last[:, :, None] - g)
    scores = jnp.einsum('bnthk,bnshk->bnhts', q_dec, k_inv)
    mask = jnp.tril(jnp.ones((c, c), dtype=bool))
    scores = jnp.where(mask, scores, 0.0)
    o_intra = jnp.einsum('bnhts,bnshv->bnthv', scores, vc)

    def step(state, inp):
        qd, kd, vv, gl = inp
        o = jnp.einsum('bthk,bhkv->bthv', qd, state)
        state = jnp.exp(gl)[..., None] * state + jnp.einsum('bthk,bthv->bhkv', kd, vv)
        return state, o

    s0 = jnp.zeros((bsz, h, dk, dv), f32)
    _, o_inter = lax.scan(step, s0, (jnp.moveaxis(q_dec, 1, 0), jnp.moveaxis(k_dec, 1, 0),
                                     jnp.moveaxis(vc, 1, 0), jnp.moveaxis(g_last, 1, 0)))
    o = o_intra + jnp.moveaxis(o_inter, 0, 1)
    return o.reshape(bsz, L, h, dv)


def setup_inputs(seed: int = 0) -> dict:
    key = jax.random.key(seed)
    ks = jax.random.split(key, 24)
    f32 = jnp.float32
    nrm = lambda k, shape, s: jax.random.normal(k, shape, f32) * s
    x = jax.random.normal(ks[0], (BATCH, SEQ, D_MODEL), f32)
    even_norm_g = 1.0 + nrm(ks[1], (N_EVEN, D_MODEL), 0.02)
    even_w_in = nrm(ks[2], (N_EVEN, D_MODEL, EVEN_IN), D_MODEL ** -0.5)
    sb_q_norm_g = 1.0 + nrm(ks[3], (N_EVEN, SB_HEAD_DIM), 0.02)
    sb_k_norm_g = 1.0 + nrm(ks[4], (N_EVEN, SB_HEAD_DIM), 0.02)
    s5_lambda_re = -0.5 + nrm(ks[5], (N_EVEN, S5_GROUPS, S5_STATE), 0.01)
    n_idx = jnp.arange(S5_STATE, dtype=f32)
    s5_lambda_im = math.pi * n_idx + nrm(ks[6], (N_EVEN, S5_GROUPS, S5_STATE), 0.01)
    s5_log_dt = jax.random.uniform(ks[7], (N_EVEN, S5_GROUPS), f32,
                                   math.log(S5_DT_MIN), math.log(S5_DT_MAX))
    s5_b_re = nrm(ks[8], (N_EVEN, S5_GROUPS, S5_STATE, S5_GROUP), (2 * S5_GROUP) ** -0.5)
    s5_b_im = nrm(ks[9], (N_EVEN, S5_GROUPS, S5_STATE, S5_GROUP), (2 * S5_GROUP) ** -0.5)
    s5_c_re = nrm(ks[10], (N_EVEN, S5_GROUPS, S5_GROUP, S5_STATE), S5_STATE ** -0.5)
    s5_c_im = nrm(ks[11], (N_EVEN, S5_GROUPS, S5_GROUP, S5_STATE), S5_STATE ** -0.5)
    s5_d = nrm(ks[12], (N_EVEN, S5_GROUPS, S5_GROUP), 1.0)
    s5_w_glu = nrm(ks[13], (N_EVEN, S5_WIDTH, S5_WIDTH), S5_WIDTH ** -0.5)
    s5_b_glu = nrm(ks[14], (N_EVEN, S5_WIDTH), 0.02)
    even_w_out = nrm(ks[15], (N_EVEN, EVEN_MIX, D_MODEL), EVEN_MIX ** -0.5)
    odd_norm_g = 1.0 + nrm(ks[16], (N_ODD, D_MODEL), 0.02)
    odd_w_in = nrm(ks[17], (N_ODD, D_MODEL, ODD_IN), D_MODEL ** -0.5)
    gla_w_gate = nrm(ks[18], (N_ODD, GLA_RANK, GLA_KEY), GLA_RANK ** -0.5)
    gla_b_gate = nrm(ks[19], (N_ODD, GLA_KEY), 0.1)
    gla_o_norm_g = 1.0 + nrm(ks[20], (N_ODD, GLA_DV), 0.02)
    odd_w_out = nrm(ks[21], (N_ODD, GLA_VAL, D_MODEL), GLA_VAL ** -0.5)
    return {"x": x, "even_norm_g": even_norm_g, "even_w_in": even_w_in,
            "sb_q_norm_g": sb_q_norm_g, "sb_k_norm_g": sb_k_norm_g,
            "s5_lambda_re": s5_lambda_re, "s5_lambda_im": s5_lambda_im, "s5_log_dt": s5_log_dt,
            "s5_b_re": s5_b_re, "s5_b_im": s5_b_im, "s5_c_re": s5_c_re, "s5_c_im": s5_c_im,
            "s5_d": s5_d, "s5_w_glu": s5_w_glu, "s5_b_glu": s5_b_glu, "even_w_out": even_w_out,
            "odd_norm_g": odd_norm_g, "odd_w_in": odd_w_in, "gla_w_gate": gla_w_gate,
            "gla_b_gate": gla_b_gate, "gla_o_norm_g": gla_o_norm_g, "odd_w_out": odd_w_out}


def reference(x, even_norm_g, even_w_in, sb_q_norm_g, sb_k_norm_g, s5_lambda_re, s5_lambda_im,
              s5_log_dt, s5_b_re, s5_b_im, s5_c_re, s5_c_im, s5_d, s5_w_glu, s5_b_glu, even_w_out,
              odd_norm_g, odd_w_in, gla_w_gate, gla_b_gate, gla_o_norm_g, odd_w_out):
    bsz, L, _ = x.shape
    for layer in range(DEPTH):
        i = layer // 2
        if layer % 2 == 0:
            h = rms_norm(x, even_norm_g[i])
            proj = h @ even_w_in[i]
            q, k, v, z_a, u, z_b = jnp.split(
                proj, [SB_WIDTH, 2 * SB_WIDTH, 3 * SB_WIDTH, 4 * SB_WIDTH,
                       4 * SB_WIDTH + S5_WIDTH], axis=-1)
            q = rms_norm(q.reshape(bsz, L, SB_HEADS, SB_HEAD_DIM), sb_q_norm_g[i])
            k = rms_norm(k.reshape(bsz, L, SB_HEADS, SB_HEAD_DIM), sb_k_norm_g[i])
            v = v.reshape(bsz, L, SB_HEADS, SB_HEAD_DIM)
            o_a = stick_breaking_attention(q, k, v).reshape(bsz, L, SB_WIDTH) * jax.nn.silu(z_a)
            o_b = s5_mixer(u, s5_lambda_re[i], s5_lambda_im[i], s5_log_dt[i], s5_b_re[i],
                           s5_b_im[i], s5_c_re[i], s5_c_im[i], s5_d[i], s5_w_glu[i],
                           s5_b_glu[i]) * jax.nn.silu(z_b)
            x = x + jnp.concatenate([o_a, o_b], axis=-1) @ even_w_out[i]
        else:
            h = rms_norm(x, odd_norm_g[i])
            proj = h @ odd_w_in[i]
            q, k, v, z, r = jnp.split(
                proj, [GLA_KEY, 2 * GLA_KEY, 2 * GLA_KEY + GLA_VAL,
                       2 * GLA_KEY + 2 * GLA_VAL], axis=-1)
            log_a = jax.nn.log_sigmoid((r @ gla_w_gate[i] + gla_b_gate[i]).astype(jnp.float32)) / GLA_TAU
            o = gla_chunked(q.reshape(bsz, L, GLA_HEADS, GLA_DK),
                            k.reshape(bsz, L, GLA_HEADS, GLA_DK),
                            v.reshape(bsz, L, GLA_HEADS, GLA_DV),
                            log_a.reshape(bsz, L, GLA_HEADS, GLA_DK))
            o = rms_norm(o, gla_o_norm_g[i]).astype(x.dtype).reshape(bsz, L, GLA_VAL)
            x = x + (o * jax.nn.silu(z)) @ odd_w_out[i]
    return x
```

```cpp
#include <hip/hip_runtime.h>
#include <hip/hip_cooperative_groups.h>
#include <cstdio>
namespace cg = cooperative_groups;

#ifndef COOP
#define COOP 1
#endif

#define DI __device__ __forceinline__
typedef unsigned short u16;
typedef __attribute__((ext_vector_type(8))) short bf16x8;
typedef __attribute__((ext_vector_type(4))) short s16x4;
typedef __attribute__((ext_vector_type(16))) float f32x16;
typedef __attribute__((ext_vector_type(4))) float f32x4;
typedef __attribute__((ext_vector_type(2))) float f32x2;
typedef __attribute__((ext_vector_type(4))) unsigned u32x4;
typedef __attribute__((ext_vector_type(2))) unsigned u32x2;
typedef __bf16 bf2_t __attribute__((ext_vector_type(2)));
typedef __attribute__((address_space(3))) s16x4 lds_s16x4;

#define MFMA(a, b, c) __builtin_amdgcn_mfma_f32_32x32x16_bf16((a), (b), (c), 0, 0, 0)

constexpr int NTOK = 65536;
constexpr int SEQ = 4096;
constexpr int LDE = 5120;
constexpr int LDO = 3200;
constexpr float EPS = 1e-6f;
constexpr int SMEM_BYTES = 77824;

struct Params {
  const float *x, *even_norm_g, *even_w_in, *sb_q_g, *sb_k_g, *lam_re, *lam_im, *log_dt, *b_re, *b_im, *c_re, *c_im,
      *s5_d, *w_glu, *b_glu, *even_w_out, *odd_norm_g, *odd_w_in, *gla_w_gate, *gla_b_gate, *gla_o_g, *odd_w_out;
  float* out;
  char* ws;
  DI u16* WtEin() const { return (u16*)(ws + 0ull); }
  DI u16* WtEout() const { return (u16*)(ws + 20971520ull); }
  DI u16* WtGlu() const { return (u16*)(ws + 27262976ull); }
  DI u16* WtOin() const { return (u16*)(ws + 28311552ull); }
  DI u16* WtOout() const { return (u16*)(ws + 41418752ull); }
  DI u16* WgT() const { return (u16*)(ws + 45613056ull); }
  DI u16* WtMQ() const { return (u16*)(ws + 45645824ull); }
  DI u16* WtP() const { return (u16*)(ws + 87588864ull); }
  DI float* LT() const { return (float*)(ws + 95977472ull); }
  DI u16* xb() const { return (u16*)(ws + 96010240ull); }
  DI float* part() const { return (float*)(ws + 230227968ull); }
  DI u16* proj() const { return (u16*)(ws + 232325120ull); }
  DI u16* yb() const { return (u16*)(ws + 903413760ull); }
  DI float* Sc() const { return (float*)(ws + 970522624ull); }
  DI u16* hp() const { return (u16*)(ws + 1004077056ull); }
  DI float* ssqg() const { return (float*)(ws + 1020854272ull); }
};

DI unsigned pk2(float a, float b) { f32x2 v = {a, b}; return __builtin_bit_cast(unsigned, __builtin_convertvector(v, bf2_t)); }
DI u16 f2bf(float a) { return (u16)(pk2(a, 0.f) & 0xffffu); }
DI float bflo(unsigned u) { return __uint_as_float(u << 16); }
DI float bfhi(unsigned u) { return __uint_as_float(u & 0xffff0000u); }
DI int crow(int i, int h) { return (i & 3) + 8 * (i >> 2) + 4 * h; }
DI float fexp2(float x) { return __builtin_amdgcn_exp2f(x); }
DI float flog2(float x) { return __builtin_amdgcn_logf(x); }
DI float frcp(float x) { return __builtin_amdgcn_rcpf(x); }
DI float fexp(float x) { return fexp2(x * 1.44269504088896f); }
DI float sigmoidf_(float x) { return frcp(1.f + fexp(-x)); }
DI float siluf_(float x) { return x * sigmoidf_(x); }
DI unsigned off_b(unsigned row, unsigned ch) { return 256u * row + 16u * (ch ^ (((row & 3) << 2) | ((row >> 2) & 3))); }
DI unsigned off_g(unsigned row, unsigned ch) { return 128u * row + 16u * (ch ^ ((row >> 1) & 7)); }
DI s16x4 tr_read(const char* p) { return __builtin_amdgcn_ds_read_tr16_b64_v4i16((lds_s16x4*)p); }
DI bf16x8 cat4(s16x4 lo, s16x4 hi) { return __builtin_shufflevector(lo, hi, 0, 1, 2, 3, 4, 5, 6, 7); }
DI f32x16 zero16() { f32x16 z;
#pragma unroll
  for (int i = 0; i < 16; ++i) z[i] = 0.f; return z; }
DI bf16x8 pack8(const float* f) {
  u32x4 r; r[0] = pk2(f[0], f[1]); r[1] = pk2(f[2], f[3]); r[2] = pk2(f[4], f[5]); r[3] = pk2(f[6], f[7]);
  return __builtin_bit_cast(bf16x8, r);
}
DI void unpack8(bf16x8 v, float* f) {
  u32x4 r = __builtin_bit_cast(u32x4, v);
#pragma unroll
  for (int i = 0; i < 4; ++i) { f[2 * i] = bflo(r[i]); f[2 * i + 1] = bfhi(r[i]); }
}
DI bf16x8 ldg8(const u16* p) { return *(const bf16x8*)p; }
DI float red16(float v) {
  v += __shfl_xor(v, 1); v += __shfl_xor(v, 2); v += __shfl_xor(v, 4); v += __shfl_xor(v, 8); return v;
}
DI void wave_lds_fence() { __builtin_amdgcn_fence(__ATOMIC_RELEASE, "wavefront"); __builtin_amdgcn_wave_barrier(); __builtin_amdgcn_fence(__ATOMIC_ACQUIRE, "wavefront"); }

template <class AL, class EP>
DI void gemm_tile(int tid, char* smem, const AL& al, const u16* __restrict__ Bt, int ldb, int K, int row0, int col0, const EP& ep) {
  const int w = tid >> 6, l = tid & 63, r = l & 31, h = l >> 5;
  char* As = smem;
  char* Bs = smem + 32768;
  f32x16 acc[2][4];
#pragma unroll
  for (int mi = 0; mi < 2; ++mi)
#pragma unroll
    for (int ni = 0; ni < 4; ++ni) acc[mi][ni] = zero16();
  const int lrow = tid >> 3, lch = tid & 7;
  bf16x8 ra[8], rb[4];
  const unsigned boff = ((unsigned)(col0 + lrow) * (unsigned)ldb + lch * 8) * 2u;
  const unsigned bstep = 64u * (unsigned)ldb;
  auto gload = [&](int k0) {
    const char* ab = al.base(k0);
    unsigned ao = al.off(row0 + lrow, k0 + lch * 8);
    unsigned st = al.step32(k0), bs = bstep, bo = boff + 2u * k0;
    asm volatile("" : "+s"(st), "+s"(bs));
    asm volatile("" : "+v"(ao), "+v"(bo));
#pragma unroll
    for (int i = 0; i < 8; ++i) ra[i] = *(const bf16x8*)(ab + (ao + i * st));
#pragma unroll
    for (int i = 0; i < 4; ++i) rb[i] = *(const bf16x8*)((const char*)Bt + (bo + i * bs));
  };
  const unsigned wbase = off_g(lrow, lch);
  unsigned xo[4];
#pragma unroll
  for (int s = 0; s < 4; ++s) xo[s] = 16u * ((2 * s + h) ^ ((r >> 1) & 7));
  const unsigned abase = 128u * (64 * w + r), bbase = 32768u + 128u * r;
  gload(0);
  for (int k0 = 0; k0 < K; k0 += 64) {
    if constexpr (AL::kRowScale) {
      float* rsl = (float*)(smem + 49152);
      if ((k0 & 255) == 0) {
        rsl[tid] = al.rowscale(row0 + tid, k0 >> 8);
        __syncthreads();
      }
#pragma unroll
      for (int i = 0; i < 8; ++i) {
        const float sc = rsl[lrow + 32 * i];
        float f[8]; unpack8(ra[i], f);
#pragma unroll
        for (int j = 0; j < 8; ++j) f[j] *= sc;
        ra[i] = pack8(f);
      }
    }
#pragma unroll
    for (int i = 0; i < 8; ++i) *(bf16x8*)(As + wbase + 4096 * i) = ra[i];
#pragma unroll
    for (int i = 0; i < 4; ++i) *(bf16x8*)(Bs + wbase + 4096 * i) = rb[i];
    __syncthreads();
    if (k0 + 64 < K) gload(k0 + 64);
#pragma unroll
    for (int s = 0; s < 4; ++s) {
      bf16x8 a[2], b[4];
#pragma unroll
      for (int mi = 0; mi < 2; ++mi) a[mi] = *(const bf16x8*)(smem + abase + 4096 * mi + xo[s]);
#pragma unroll
      for (int ni = 0; ni < 4; ++ni) b[ni] = *(const bf16x8*)(smem + bbase + 4096 * ni + xo[s]);
#pragma unroll
      for (int mi = 0; mi < 2; ++mi)
#pragma unroll
        for (int ni = 0; ni < 4; ++ni) acc[mi][ni] = MFMA(a[mi], b[ni], acc[mi][ni]);
      __builtin_amdgcn_sched_barrier(0);
    }
    __syncthreads();
  }
  float* stg = (float*)(smem + w * 16896);
#pragma unroll
  for (int mi = 0; mi < 2; ++mi) {
#pragma unroll
    for (int ni = 0; ni < 4; ++ni)
#pragma unroll
      for (int i = 0; i < 16; ++i) stg[crow(i, h) * 132 + 32 * ni + r] = acc[mi][ni][i];
    wave_lds_fence();
#pragma unroll
    for (int ps = 0; ps < 8; ++ps) {
      const int rr = 4 * ps + (l >> 4), cc = (l & 15) * 8;
      float v[8];
      f32x4 v0 = *(const f32x4*)(stg + rr * 132 + cc), v1 = *(const f32x4*)(stg + rr * 132 + cc + 4);
#pragma unroll
      for (int j = 0; j < 4; ++j) { v[j] = v0[j]; v[4 + j] = v1[j]; }
      ep(row0 + 64 * w + 32 * mi + rr, col0 + cc, v, l);
    }
    wave_lds_fence();
  }
  __syncthreads();
}

struct ALPlain {
  static constexpr bool kRowScale = false;
  const u16* base_; int ld; int kseg; int off0; int off1;
  DI const char* base(int) const { return (const char*)base_; }
  DI unsigned off(int row, int k) const { return ((unsigned)row * (unsigned)ld + k + (k < kseg ? off0 : off1)) * 2u; }
  DI unsigned step32(int) const { return 64u * (unsigned)ld; }
  DI float rowscale(int, int) const { return 1.f; }
};
struct ALGlaOut {
  static constexpr bool kRowScale = true;
  const u16* base_; const float* ssq;
  DI const char* base(int) const { return (const char*)base_; }
  DI unsigned off(int row, int k) const { return ((unsigned)row * LDO + 1024 + k) * 2u; }
  DI unsigned step32(int) const { return 64u * LDO; }
  DI float rowscale(int row, int hd) const {
    const f32x4* p = (const f32x4*)(ssq + (size_t)row * 32 + hd * 8);
    f32x4 a = p[0], b = p[1];
    float s = a[0] + a[1] + a[2] + a[3] + b[0] + b[1] + b[2] + b[3];
    return __builtin_amdgcn_rsqf(s * (1.f / 256.f) + EPS);
  }
};
struct ALS5 {
  static constexpr bool kRowScale = false;
  const u16* proj; const u16* hp; int g;
  DI const char* base(int k0) const { return (const char*)(k0 < 512 ? proj : hp); }
  DI unsigned off(int row, int k) const {
    if (k < 512) return ((unsigned)(row * 32 + (k >> 4)) * LDE + 4096 + g * 16 + (k & 15)) * 2u;
    return (((unsigned)row * 32 + g) * 128 + (k - 512)) * 2u;
  }
  DI unsigned step32(int k) const { return k < 512 ? 2u * 32 * 32 * LDE : 2u * 32 * 32 * 128; }
  DI float rowscale(int, int) const { return 1.f; }
};

DI float row_rstd(const float* part, int row) {
  const f32x4* p = (const f32x4*)(part + (size_t)row * 8);
  f32x4 a = p[0], b = p[1];
  float s = a[0] + a[1] + a[2] + a[3] + b[0] + b[1] + b[2] + b[3];
  return __builtin_amdgcn_rsqf(s * (1.f / 1024.f) + EPS);
}
struct EPEvenIn {
  const float* part; u16* proj; const float* qg; const float* kg;
  DI void operator()(int row, int col, float* v, int) const {
    const float rs = row_rstd(part, row);
#pragma unroll
    for (int j = 0; j < 8; ++j) v[j] *= rs;
    if (col < 2048) {
      float s = 0.f;
#pragma unroll
      for (int j = 0; j < 8; ++j) s += v[j] * v[j];
      s = red16(s);
      const float rn = __builtin_amdgcn_rsqf(s * (1.f / 128.f) + EPS);
      const float* g = (col < 1024 ? qg : kg) + (col & 127);
      const float sc = rn * (col < 1024 ? 0.08838834764831845f * 1.44269504088896f : 1.f);
#pragma unroll
      for (int j = 0; j < 8; ++j) v[j] *= sc * g[j];
    }
    *(bf16x8*)(proj + (size_t)row * LDE + col) = pack8(v);
  }
};
struct EPOddIn {
  const float* part; u16* proj;
  DI void operator()(int row, int col, float* v, int) const {
    const float rs = row_rstd(part, row);
#pragma unroll
    for (int j = 0; j < 8; ++j) v[j] *= rs;
    *(bf16x8*)(proj + (size_t)row * LDO + col) = pack8(v);
  }
};
struct EPOut {
  const float* xin; float* xout; u16* xb; float* part;
  DI void operator()(int row, int col, float* v, int lane) const {
    const f32x4* xi = (const f32x4*)(xin + (size_t)row * 1024 + col);
    f32x4 a = xi[0], b = xi[1];
#pragma unroll
    for (int j = 0; j < 4; ++j) { v[j] += a[j]; v[4 + j] += b[j]; }
    f32x4* xo = (f32x4*)(xout + (size_t)row * 1024 + col);
    f32x4 o0 = {v[0], v[1], v[2], v[3]}, o1 = {v[4], v[5], v[6], v[7]};
    xo[0] = o0; xo[1] = o1;
    *(bf16x8*)(xb + (size_t)row * 1024 + col) = pack8(v);
    float s = 0.f;
#pragma unroll
    for (int j = 0; j < 8; ++j) s += v[j] * v[j];
    s = red16(s);
    if ((lane & 15) == 0) part[(size_t)row * 8 + (col >> 7)] = s;
  }
};
struct EPS5P {
  float* Sc; int g;
  DI void operator()(int row, int col, float* v, int) const {
    f32x4* o = (f32x4*)(Sc + ((size_t)row * 32 + g) * 128 + col);
    f32x4 o0 = {v[0], v[1], v[2], v[3]}, o1 = {v[4], v[5], v[6], v[7]};
    o[0] = o0; o[1] = o1;
  }
};
DI float gelu_tanh(float y) {
  const float u = 0.7978845608028654f * (y + 0.044715f * y * y * y);
  const float t = 1.f - 2.f * frcp(1.f + fexp(2.f * u));
  return 0.5f * y * (1.f + t);
}
struct EPS5Y {
  const u16* proj; u16* yb; const float* dsk; int g;
  DI void operator()(int row, int col, float* v, int) const {
    const int tok = row * 32 + (col >> 4), ch = g * 16 + (col & 15);
    float u[8]; unpack8(ldg8(proj + (size_t)tok * LDE + 4096 + ch), u);
#pragma unroll
    for (int j = 0; j < 8; ++j) v[j] = gelu_tanh(v[j] + dsk[ch + j] * u[j]);
    *(bf16x8*)(yb + (size_t)tok * 512 + ch) = pack8(v);
  }
};
struct EPGlu {
  u16* proj; const u16* yb; const float* bg;
  DI void operator()(int row, int col, float* v, int) const {
    float y[8], z[8];
    unpack8(ldg8(yb + (size_t)row * 512 + col), y);
    u16* zp = proj + (size_t)row * LDE + 4608 + col;
    unpack8(ldg8(zp), z);
#pragma unroll
    for (int j = 0; j < 8; ++j) v[j] = y[j] * sigmoidf_(v[j] + bg[col + j]) * siluf_(z[j]);
    *(bf16x8*)zp = pack8(v);
  }
};

DI void transpose_tile(int tid, char* smem, const float* __restrict__ src, u16* __restrict__ dst, int K, int N, int kt, int nt,
                       const float* scale, int smask) {
  float* t = (float*)smem;
  const int k0 = kt * 64, n0 = nt * 64;
#pragma unroll
  for (int i = 0; i < 16; ++i) {
    const int kk = (tid >> 6) + 4 * i, nn = tid & 63;
    float v = 0.f;
    if (n0 + nn < N) v = src[(size_t)(k0 + kk) * N + n0 + nn] * (scale ? scale[(k0 + kk) & smask] : 1.f);
    t[kk * 65 + nn] = v;
  }
  __syncthreads();
#pragma unroll
  for (int i = 0; i < 2; ++i) {
    const int c = tid + 256 * i;
    const int nn = c >> 3, k8 = (c & 7) * 8;
    float f[8];
#pragma unroll
    for (int j = 0; j < 8; ++j) f[j] = t[(k8 + j) * 65 + nn];
    *(bf16x8*)(dst + (size_t)(n0 + nn) * K + k0 + k8) = pack8(f);
  }
  __syncthreads();
}

DI void s5_setup(int tid, const Params& p, char* smem, int lg) {
  float* pw_re = (float*)smem;
  float* pw_im = pw_re + 33 * 64;
  float* bb_re = pw_im + 33 * 64;
  float* bb_im = bb_re + 1024;
  float* cc_re = bb_im + 1024;
  float* cc_im = cc_re + 1024;
  float* f_re = cc_im + 1024;
  float* f_im = f_re + 64;
  float* Kt = f_im + 64;
  if (tid < 64) {
    const float lr = p.lam_re[lg * 64 + tid], li = p.lam_im[lg * 64 + tid];
    const float dt = expf(p.log_dt[lg]);
    const float mag = expf(lr * dt);
    float sn, cs; sincosf(li * dt, &sn, &cs);
    const float br = mag * cs, bi = mag * sn;
    float pr = 1.f, pi = 0.f;
    for (int t = 0; t <= 32; ++t) {
      pw_re[t * 64 + tid] = pr; pw_im[t * 64 + tid] = pi;
      const float nr = pr * br - pi * bi, ni = pr * bi + pi * br;
      pr = nr; pi = ni;
    }
    p.LT()[(lg * 64 + tid) * 2] = pw_re[32 * 64 + tid];
    p.LT()[(lg * 64 + tid) * 2 + 1] = pw_im[32 * 64 + tid];
    const float nr = br - 1.f, ni = bi, den = 1.f / (lr * lr + li * li);
    f_re[tid] = (nr * lr + ni * li) * den;
    f_im[tid] = (ni * lr - nr * li) * den;
  }
  __syncthreads();
  for (int e = tid; e < 1024; e += 256) {
    const int n = e >> 4;
    const float br = p.b_re[(size_t)lg * 1024 + e], bi = p.b_im[(size_t)lg * 1024 + e];
    bb_re[e] = f_re[n] * br - f_im[n] * bi;
    bb_im[e] = f_re[n] * bi + f_im[n] * br;
    cc_re[e] = p.c_re[(size_t)lg * 1024 + e];
    cc_im[e] = p.c_im[(size_t)lg * 1024 + e];
  }
  __syncthreads();
  {
    const int pp = tid >> 4, pq = tid & 15;
    for (int t = 0; t < 32; ++t) {
      float s = 0.f;
      for (int n = 0; n < 64; ++n) {
        const float cr = cc_re[pp * 64 + n], ci = cc_im[pp * 64 + n];
        const float wr = pw_re[t * 64 + n], wi = pw_im[t * 64 + n];
        const float xr = cr * wr - ci * wi, xi = cr * wi + ci * wr;
        s += xr * bb_re[n * 16 + pq] - xi * bb_im[n * 16 + pq];
      }
      Kt[t * 256 + tid] = s;
    }
  }
  __syncthreads();
  u16* mq = p.WtMQ() + (size_t)lg * 512 * 640;
  for (int c = tid; c < 512 * 80; c += 256) {
    const int no = c / 80, k8 = (c % 80) * 8;
    const int t = no >> 4, pp = no & 15;
    float f[8];
    if (k8 < 512) {
      const int s = k8 >> 4, q0 = k8 & 15;
#pragma unroll
      for (int j = 0; j < 8; ++j) f[j] = (s <= t) ? Kt[(t - s) * 256 + pp * 16 + q0 + j] : 0.f;
    } else if (k8 < 576) {
      const int n0 = k8 - 512;
#pragma unroll
      for (int j = 0; j < 8; ++j) {
        const int n = n0 + j;
        f[j] = cc_re[pp * 64 + n] * pw_re[(t + 1) * 64 + n] - cc_im[pp * 64 + n] * pw_im[(t + 1) * 64 + n];
      }
    } else {
      const int n0 = k8 - 576;
#pragma unroll
      for (int j = 0; j < 8; ++j) {
        const int n = n0 + j;
        f[j] = -(cc_re[pp * 64 + n] * pw_im[(t + 1) * 64 + n] + cc_im[pp * 64 + n] * pw_re[(t + 1) * 64 + n]);
      }
    }
    *(bf16x8*)(mq + (size_t)no * 640 + k8) = pack8(f);
  }
  u16* wp = p.WtP() + (size_t)lg * 128 * 512;
  for (int c = tid; c < 128 * 64; c += 256) {
    const int nn = c >> 6, k8 = (c & 63) * 8;
    const int n = nn & 63, s = k8 >> 4, q0 = k8 & 15;
    const float wr = pw_re[(31 - s) * 64 + n], wi = pw_im[(31 - s) * 64 + n];
    float f[8];
#pragma unroll
    for (int j = 0; j < 8; ++j) {
      const float br = bb_re[n * 16 + q0 + j], bi = bb_im[n * 16 + q0 + j];
      f[j] = (nn < 64) ? (wr * br - wi * bi) : (wr * bi + wi * br);
    }
    *(bf16x8*)(wp + (size_t)nn * 512 + k8) = pack8(f);
  }
  __syncthreads();
}

DI void phase_prologue(int tid, int bid, const Params& p, char* smem) {
  const int nb = gridDim.x;
  for (int it = bid; it < 64; it += nb) s5_setup(tid, p, smem, it);
  for (int lyr = 0; lyr < 2; ++lyr) {
    struct TJ { const float* src; u16* dst; int K, N, Npad; const float* sc; int smask; };
    const TJ jobs[5] = {
        {p.even_w_in + (size_t)lyr * 1024 * 5120, p.WtEin() + (size_t)lyr * 5120 * 1024, 1024, 5120, 5120, p.even_norm_g + lyr * 1024, 1023},
        {p.even_w_out + (size_t)lyr * 1536 * 1024, p.WtEout() + (size_t)lyr * 1024 * 1536, 1536, 1024, 1024, nullptr, 0},
        {p.w_glu + (size_t)lyr * 512 * 512, p.WtGlu() + (size_t)lyr * 512 * 512, 512, 512, 512, nullptr, 0},
        {p.odd_w_in + (size_t)lyr * 1024 * 3088, p.WtOin() + (size_t)lyr * 3200 * 1024, 1024, 3088, 3200, p.odd_norm_g + lyr * 1024, 1023},
        {p.odd_w_out + (size_t)lyr * 1024 * 1024, p.WtOout() + (size_t)lyr * 1024 * 1024, 1024, 1024, 1024, p.gla_o_g + lyr * 256, 255}};
#pragma unroll
    for (int j = 0; j < 5; ++j) {
      const int nkt = jobs[j].K / 64, nnt = jobs[j].Npad / 64;
      for (int t = bid; t < nkt * nnt; t += nb)
        transpose_tile(tid, smem, jobs[j].src, jobs[j].dst, jobs[j].K, jobs[j].N, t % nkt, t / nkt, jobs[j].sc, jobs[j].smask);
    }
    for (int e = bid * 256 + tid; e < 512 * 16; e += nb * 256) {
      const int c = e >> 4, k = e & 15;
      p.WgT()[(size_t)lyr * 8192 + e] = f2bf(p.gla_w_gate[(size_t)lyr * 8192 + k * 512 + c]);
    }
  }
  const int w = tid >> 6, l = tid & 63;
  for (int row = bid * 4 + w; row < NTOK; row += nb * 4) {
    const f32x4* xr = (const f32x4*)(p.x + (size_t)row * 1024);
    float s = 0.f;
#pragma unroll
    for (int i = 0; i < 2; ++i) {
      f32x4 a = xr[(l + 64 * i) * 2], b = xr[(l + 64 * i) * 2 + 1];
      float f[8] = {a[0], a[1], a[2], a[3], b[0], b[1], b[2], b[3]};
#pragma unroll
      for (int j = 0; j < 8; ++j) s += f[j] * f[j];
      *(bf16x8*)(p.xb() + (size_t)row * 1024 + (l + 64 * i) * 8) = pack8(f);
    }
#pragma unroll
    for (int m = 1; m < 64; m <<= 1) s += __shfl_xor(s, m);
    if (l < 8) p.part()[(size_t)row * 8 + l] = (l == 0) ? s : 0.f;
  }
}

DI void attn_item(int tid, const Params& p, char* smem, int b, int hh, int qb) {
  const int w = tid >> 6, l = tid & 63, r = l & 31, h = l >> 5;
  char* Ks = smem;
  char* Vs = smem + 16384;
  char* Qs = smem + 32768 + w * 8192;
  float* flags = (float*)(smem + 65536);
  float* stg = (float*)(smem + w * 8704);
  const u16* base = p.proj() + (size_t)b * SEQ * LDE;
  const int q0 = qb * 128, qw0 = q0 + 32 * w;
  {
    const u16* qp = base + (size_t)(qw0 + r) * LDE + hh * 128 + 8 * h;
#pragma unroll
    for (int s = 0; s < 8; ++s) *(bf16x8*)(Qs + off_b(r, 2 * s + h)) = ldg8(qp + 16 * s);
  }
  f32x16 ot[4];
#pragma unroll
  for (int d = 0; d < 4; ++d) ot[d] = zero16();
  float carry = 1.f;
  const int lrow = tid >> 4, lch = tid & 15;
  bf16x8 rk[4], rv[4];
  auto gload = [&](int jt) {
    const u16* kp = base + (size_t)(jt * 64 + lrow) * LDE + 1024 + hh * 128 + lch * 8;
#pragma unroll
    for (int i = 0; i < 4; ++i) { rk[i] = ldg8(kp + (size_t)(16 * i) * LDE); rv[i] = ldg8(kp + (size_t)(16 * i) * LDE + 1024); }
  };
  const int trq = (l & 15) >> 2, trp = l & 3, trblk = (l >> 4) & 1;
  const unsigned fr = ((r & 3) << 2) | ((r >> 2) & 3);
  unsigned xs[8];
#pragma unroll
  for (int s = 0; s < 8; ++s) xs[s] = 16u * ((2 * s + h) ^ fr);
  const char* kbase = Ks + 256 * r;
  const char* qbase = Qs + 256 * r;
  const unsigned fv = (trq << 2) | h;
  unsigned vo[4];
#pragma unroll
  for (int d = 0; d < 4; ++d) vo[d] = 16u * ((4 * d + 2 * trblk + (trp >> 1)) ^ fv) + 8u * (trp & 1);
  const char* vbase = Vs + 256 * (4 * h + trq);
  int jt = 2 * qb + 1;
  gload(jt);
  for (; jt >= 0; --jt) {
#pragma unroll
    for (int i = 0; i < 4; ++i) {
      *(bf16x8*)(Ks + off_b(lrow + 16 * i, lch)) = rk[i];
      *(bf16x8*)(Vs + off_b(lrow + 16 * i, lch)) = rv[i];
    }
    __syncthreads();
    if (jt > 0) gload(jt - 1);
    const int k0 = jt * 64;
    if (k0 <= qw0) {
      f32x16 st[2];
      st[0] = zero16(); st[1] = zero16();
#pragma unroll
      for (int s = 0; s < 8; ++s) {
        const bf16x8 qf = *(const bf16x8*)(qbase + xs[s]);
#pragma unroll
        for (int kt = 0; kt < 2; ++kt) {
          bf16x8 a = *(const bf16x8*)(kbase + 8192 * kt + xs[s]);
          st[kt] = MFMA(a, qf, st[kt]);
        }
      }
      const bool need_mask = (k0 + 63 >= qw0);
      const int tq = qw0 + r;
      float running = carry;
#pragma unroll
      for (int kt = 1; kt >= 0; --kt) {
        float bt[16];
#pragma unroll
        for (int i = 0; i < 16; ++i) {
          float z2 = fminf(fmaxf(st[kt][i], -100.f), 100.f);
          float e = fexp2(-z2);
          float be = frcp(1.f + e);
          float om = e * be;
          if (need_mask && (k0 + 32 * kt + crow(i, h) >= tq)) { be = 0.f; om = 1.f; }
          bt[i] = be; st[kt][i] = om;
        }
#pragma unroll
        for (int rg = 3; rg >= 0; --rg) {
          const int i0 = 4 * rg;
          const float s2 = st[kt][i0 + 3], s1 = s2 * st[kt][i0 + 2], s0 = s1 * st[kt][i0 + 1], T = s0 * st[kt][i0];
          const float To = __shfl_xor(T, 32);
          const float off = running * (h ? 1.f : To);
          st[kt][i0 + 3] = bt[i0 + 3] * off;
          st[kt][i0 + 2] = bt[i0 + 2] * off * s2;
          st[kt][i0 + 1] = bt[i0 + 1] * off * s1;
          st[kt][i0] = bt[i0] * off * s0;
          running = off * T * (h ? To : 1.f);
        }
      }
      carry = running;
#pragma unroll
      for (int ks = 0; ks < 4; ++ks) {
        float wv[8];
#pragma unroll
        for (int j = 0; j < 8; ++j) wv[j] = st[ks >> 1][8 * (ks & 1) + j];
        const bf16x8 bw = pack8(wv);
#pragma unroll
        for (int d = 0; d < 4; ++d) {
          s16x4 lo = tr_read(vbase + 4096 * ks + vo[d]);
          s16x4 hi = tr_read(vbase + 4096 * ks + 2048 + (vo[d] ^ 32u));
          ot[d] = MFMA(cat4(lo, hi), bw, ot[d]);
        }
      }
    }
    {
      float m = carry;
#pragma unroll
      for (int s = 1; s < 64; s <<= 1) m = fmaxf(m, __shfl_xor(m, s));
      if (l == 0) flags[w] = m;
    }
    __syncthreads();
    const float mx = fmaxf(fmaxf(flags[0], flags[1]), fmaxf(flags[2], flags[3]));
    if (mx < 1e-30f) break;
  }
#pragma unroll
  for (int hf = 0; hf < 2; ++hf) {
#pragma unroll
    for (int dd = 0; dd < 2; ++dd)
#pragma unroll
      for (int rg = 0; rg < 4; ++rg) {
        f32x4 v = {ot[2 * hf + dd][4 * rg], ot[2 * hf + dd][4 * rg + 1], ot[2 * hf + dd][4 * rg + 2], ot[2 * hf + dd][4 * rg + 3]};
        *(f32x4*)(stg + r * 68 + 32 * dd + 8 * rg + 4 * h) = v;
      }
    wave_lds_fence();
#pragma unroll
    for (int ps = 0; ps < 4; ++ps) {
      const int id = l + 64 * ps, rr = id >> 3, c8 = (id & 7) * 8;
      f32x4 v0 = *(const f32x4*)(stg + rr * 68 + c8), v1 = *(const f32x4*)(stg + rr * 68 + c8 + 4);
      u16* zp = p.proj() + ((size_t)b * SEQ + qw0 + rr) * LDE + 3072 + hh * 128 + 64 * hf + c8;
      float z[8], o[8];
      unpack8(ldg8(zp), z);
#pragma unroll
      for (int j = 0; j < 4; ++j) { o[j] = v0[j] * siluf_(z[j]); o[4 + j] = v1[j] * siluf_(z[4 + j]); }
      *(bf16x8*)zp = pack8(o);
    }
    wave_lds_fence();
  }
  __syncthreads();
}

DI void gla_item(int tid, const Params& p, char* smem, int lyr, int b, int hh, int sl) {
  const int w = tid >> 6, l = tid & 63, r = l & 31, h = l >> 5;
  char* qd = smem;
  char* ki = smem + 16384;
  char* vs = smem + 32768;
  char* sT = smem + 36864;
  float* Ef = (float*)(smem + 45056);
  u16* base = p.proj() + (size_t)b * SEQ * LDO;
  const int trq = (l & 15) >> 2, trp = l & 3, trblk = (l >> 4) & 1;
  const bf16x8 wgf = ldg8(p.WgT() + (size_t)lyr * 8192 + (hh * 128 + 32 * w + r) * 16 + 8 * h);
  const float gbias = p.gla_b_gate[lyr * 512 + hh * 128 + 32 * w + r];
  f32x16 sacc[2];
  sacc[0] = zero16(); sacc[1] = zero16();
  for (int e = tid; e < 2048; e += 256) ((unsigned*)sT)[e] = 0u;
  bf16x8 rf[2], rq[4], rkk[4], rvv;
  const int erow = tid >> 4, ech = tid & 15;
  auto load_r = [&](int n) {
#pragma unroll
    for (int mt = 0; mt < 2; ++mt) rf[mt] = ldg8(base + (size_t)(n * 64 + 32 * mt + r) * LDO + 3072 + 8 * h);
  };
  auto load_qkv = [&](int n) {
#pragma unroll
    for (int i = 0; i < 4; ++i) {
      const u16* rp = base + (size_t)(n * 64 + erow + 16 * i) * LDO + hh * 128 + ech * 8;
      rq[i] = ldg8(rp); rkk[i] = ldg8(rp + 512);
    }
    rvv = ldg8(base + (size_t)(n * 64 + (tid >> 2)) * LDO + 1024 + hh * 256 + sl * 32 + (tid & 3) * 8);
  };
  load_r(0);
  __syncthreads();
  for (int n = 0; n < 64; ++n) {
    load_qkv(n);
    {
      f32x16 ga[2];
#pragma unroll
      for (int mt = 0; mt < 2; ++mt) ga[mt] = MFMA(rf[mt], wgf, zero16());
      if (n + 1 < 64) load_r(n + 1);
      float running = 0.f;
#pragma unroll
      for (int mt = 0; mt < 2; ++mt)
#pragma unroll
        for (int rg = 0; rg < 4; ++rg) {
          float c[4];
#pragma unroll
          for (int j = 0; j < 4; ++j) {
            const float x = ga[mt][4 * rg + j] + gbias;
            const float sp = fmaxf(-x, 0.f) + 0.6931471805599453f * flog2(1.f + fexp(-fabsf(x)));
            c[j] = -sp * (1.f / 16.f);
          }
          c[1] += c[0]; c[2] += c[1]; c[3] += c[2];
          const float T = c[3], To = __shfl_xor(T, 32);
          const float off = running + (h ? To : 0.f);
#pragma unroll
          for (int j = 0; j < 4; ++j) Ef[(32 * mt + 8 * rg + 4 * h + j) * 128 + 32 * w + r] = fexp(off + c[j]);
          running = off + T + (h ? 0.f : To);
        }
    }
    __syncthreads();
    {
#pragma unroll
      for (int i = 0; i < 4; ++i) {
        const int t = erow + 16 * i;
        const f32x4* ep = (const f32x4*)(Ef + t * 128 + ech * 8);
        f32x4 e0 = ep[0], e1 = ep[1];
        float e[8] = {e0[0], e0[1], e0[2], e0[3], e1[0], e1[1], e1[2], e1[3]};
        float q[8], k[8];
        unpack8(rq[i], q); unpack8(rkk[i], k);
#pragma unroll
        for (int j = 0; j < 8; ++j) { q[j] *= e[j] * 0.08838834764831845f; k[j] *= frcp(e[j]); }
        *(bf16x8*)(qd + off_b(t, ech)) = pack8(q);
        *(bf16x8*)(ki + off_b(t, ech)) = pack8(k);
      }
      *(bf16x8*)(vs + (tid >> 2) * 64 + (tid & 3) * 16) = rvv;
    }
    __syncthreads();
    if (w < 2) {
      const int tt = w;
      f32x16 oa = zero16();
#pragma unroll
      for (int st = 0; st < 2; ++st) {
        if (st <= tt) {
          f32x16 sc = zero16();
#pragma unroll
          for (int s8 = 0; s8 < 8; ++s8) {
            bf16x8 a = *(const bf16x8*)(ki + off_b(32 * st + r, 2 * s8 + h));
            bf16x8 bq = *(const bf16x8*)(qd + off_b(32 * tt + r, 2 * s8 + h));
            sc = MFMA(a, bq, sc);
          }
          if (st == tt) {
#pragma unroll
            for (int i = 0; i < 16; ++i)
              if (crow(i, h) > r) sc[i] = 0.f;
          }
#pragma unroll
          for (int ks = 0; ks < 2; ++ks) {
            float wv[8];
#pragma unroll
            for (int j = 0; j < 8; ++j) wv[j] = sc[8 * ks + j];
            const bf16x8 bw = pack8(wv);
            const int row0 = 32 * st + 16 * ks + 4 * h + trq;
            s16x4 lo = tr_read(vs + row0 * 64 + 32 * trblk + 8 * trp);
            s16x4 hi = tr_read(vs + (row0 + 8) * 64 + 32 * trblk + 8 * trp);
            oa = MFMA(cat4(lo, hi), bw, oa);
          }
        }
      }
#pragma unroll
      for (int s8 = 0; s8 < 8; ++s8) {
        bf16x8 a = *(const bf16x8*)(sT + off_b(r, 2 * s8 + h));
        bf16x8 bq = *(const bf16x8*)(qd + off_b(32 * tt + r, 2 * s8 + h));
        oa = MFMA(a, bq, oa);
      }
      const size_t tok = (size_t)b * SEQ + n * 64 + 32 * tt + r;
      float ss = 0.f;
#pragma unroll
      for (int i = 0; i < 16; ++i) ss += oa[i] * oa[i];
      ss += __shfl_xor(ss, 32);
      if (h == 0) p.ssqg()[tok * 32 + hh * 8 + sl] = ss;
      u16* rowp = p.proj() + tok * LDO + hh * 256 + sl * 32;
#pragma unroll
      for (int rg = 0; rg < 4; ++rg) {
        const int dv0 = 8 * rg + 4 * h;
        u32x2 zz = *(const u32x2*)(rowp + 2048 + dv0);
        float z0 = bflo(zz[0]), z1 = bfhi(zz[0]), z2 = bflo(zz[1]), z3 = bfhi(zz[1]);
        u32x2 o;
        o[0] = pk2(oa[4 * rg] * siluf_(z0), oa[4 * rg + 1] * siluf_(z1));
        o[1] = pk2(oa[4 * rg + 2] * siluf_(z2), oa[4 * rg + 3] * siluf_(z3));
        *(u32x2*)(rowp + 1024 + dv0) = o;
      }
    } else {
      const int cb = 2 * (w - 2);
#pragma unroll
      for (int ks = 0; ks < 4; ++ks) {
        const int row0 = 16 * ks + 8 * h + trq;
        s16x4 lo = tr_read(vs + row0 * 64 + 32 * trblk + 8 * trp);
        s16x4 hi = tr_read(vs + (row0 + 4) * 64 + 32 * trblk + 8 * trp);
        const bf16x8 av = cat4(lo, hi);
#pragma unroll
        for (int ci = 0; ci < 2; ++ci) {
          const unsigned cch = 4 * (cb + ci) + 2 * trblk + (trp >> 1);
          s16x4 blo = tr_read(ki + off_b(row0, cch) + 8 * (trp & 1));
          s16x4 bhi = tr_read(ki + off_b(row0 + 4, cch) + 8 * (trp & 1));
          sacc[ci] = MFMA(av, cat4(blo, bhi), sacc[ci]);
        }
      }
#pragma unroll
      for (int ci = 0; ci < 2; ++ci) {
        const float el = Ef[63 * 128 + 32 * (cb + ci) + r];
#pragma unroll
        for (int i = 0; i < 16; ++i) sacc[ci][i] *= el;
      }
    }
    __syncthreads();
    if (w >= 2) {
      const int cb = 2 * (w - 2);
#pragma unroll
      for (int ci = 0; ci < 2; ++ci) {
        const int c = 32 * (cb + ci) + r;
#pragma unroll
        for (int i = 0; i < 16; ++i) *(u16*)(sT + off_b(crow(i, h), c >> 3) + (c & 7) * 2) = f2bf(sacc[ci][i]);
      }
    }
  }
  __syncthreads();
}

DI void run_phase(const Params& p, char* smem, int ph) {
  int tid = threadIdx.x, bid = blockIdx.x;
  asm volatile("" : "+v"(tid));
  asm volatile("" : "+s"(bid));
  const int nb = gridDim.x;
#ifdef ONLY
  if (ph != ONLY) return;
#endif
  if (ph == 0) { phase_prologue(tid, bid, p, smem); return; }
  const int q = ph - 1, cyc = q / 9, rem = q % 9;
  const int li = cyc;
  if (rem < 6) {
    const int lyr = li;
    switch (rem) {
      case 0: {
        ALPlain al{p.xb(), 1024, 1 << 30, 0, 0};
        EPEvenIn ep{p.part(), p.proj(), p.sb_q_g + lyr * 128, p.sb_k_g + lyr * 128};
        const u16* Bt = p.WtEin() + (size_t)lyr * 5120 * 1024;
        for (int t = bid; t < 256 * 40; t += nb) gemm_tile(tid, smem, al, Bt, 1024, 1024, (t / 40) * 256, (t % 40) * 128, ep);
      } break;
      case 1: {
        for (int it = bid; it < 4096; it += nb) {
          const int qb = 31 - (it >> 7), bh = it & 127;
          attn_item(tid, p, smem, bh >> 3, bh & 7, qb);
        }
        asm volatile("" : "+v"(tid));
        for (int t = bid; t < 256; t += nb) {
          const int g = t >> 3, mt = t & 7;
          ALS5 al{p.proj(), p.hp(), g};
          EPS5P ep{p.Sc(), g};
          gemm_tile(tid, smem, al, p.WtP() + ((size_t)lyr * 32 + g) * 128 * 512, 512, 512, mt * 256, 0, ep);
        }
      } break;
      case 2: {
        for (int idx = bid * 256 + tid; idx < 16 * 32 * 64; idx += nb * 256) {
          const int n = idx & 63, g = (idx >> 6) & 31, b = idx >> 11;
          const float lr = p.LT()[((lyr * 32 + g) * 64 + n) * 2], lim = p.LT()[((lyr * 32 + g) * 64 + n) * 2 + 1];
          float hr = 0.f, hi = 0.f;
          for (int c = 0; c < 128; ++c) {
            const size_t o = ((size_t)(b * 128 + c) * 32 + g) * 128;
            const float sr = p.Sc()[o + n], si = p.Sc()[o + 64 + n];
            p.hp()[o + n] = f2bf(hr); p.hp()[o + 64 + n] = f2bf(hi);
            const float nr = lr * hr - lim * hi + sr, ni = lr * hi + lim * hr + si;
            hr = nr; hi = ni;
          }
        }
      } break;
      case 3: {
        for (int t = bid; t < 1024; t += nb) {
          const int g = t >> 5, mt = (t >> 2) & 7, nt = t & 3;
          ALS5 al{p.proj(), p.hp(), g};
          EPS5Y ep{p.proj(), p.yb(), p.s5_d + lyr * 512, g};
          gemm_tile(tid, smem, al, p.WtMQ() + ((size_t)lyr * 32 + g) * 512 * 640, 640, 640, mt * 256, nt * 128, ep);
        }
      } break;
      case 4: {
        ALPlain al{p.yb(), 512, 1 << 30, 0, 0};
        EPGlu ep{p.proj(), p.yb(), p.b_glu + lyr * 512};
        const u16* Bt = p.WtGlu() + (size_t)lyr * 512 * 512;
        for (int t = bid; t < 256 * 4; t += nb) gemm_tile(tid, smem, al, Bt, 512, 512, (t >> 2) * 256, (t & 3) * 128, ep);
      } break;
      default: {
        ALPlain al{p.proj(), LDE, 1024, 3072, 3584};
        EPOut ep{cyc == 0 ? p.x : p.out, p.out, p.xb(), p.part()};
        const u16* Bt = p.WtEout() + (size_t)lyr * 1024 * 1536;
        for (int t = bid; t < 256 * 8; t += nb) gemm_tile(tid, smem, al, Bt, 1536, 1536, (t >> 3) * 256, (t & 7) * 128, ep);
      } break;
    }
  } else {
    const int lyr = li;
    switch (rem - 6) {
      case 0: {
        ALPlain al{p.xb(), 1024, 1 << 30, 0, 0};
        EPOddIn ep{p.part(), p.proj()};
        const u16* Bt = p.WtOin() + (size_t)lyr * 3200 * 1024;
        for (int t = bid; t < 256 * 25; t += nb) gemm_tile(tid, smem, al, Bt, 1024, 1024, (t / 25) * 256, (t % 25) * 128, ep);
      } break;
      case 1: {
        for (int it = bid; it < 512; it += nb) gla_item(tid, p, smem, lyr, it >> 5, (it >> 3) & 3, it & 7);
      } break;
      default: {
        ALGlaOut al{p.proj(), p.ssqg()};
        EPOut ep{p.out, p.out, p.xb(), p.part()};
        const u16* Bt = p.WtOout() + (size_t)lyr * 1024 * 1024;
        for (int t = bid; t < 256 * 8; t += nb) gemm_tile(tid, smem, al, Bt, 1024, 1024, (t >> 3) * 256, (t & 7) * 128, ep);
      } break;
    }
  }
}

constexpr int NPHASE = 19;

__global__ void __launch_bounds__(256, 2) fwd_kernel(Params p, int ph_lo, int ph_hi) {
  __shared__ __attribute__((aligned(16))) char smem[SMEM_BYTES];
  for (int ph = ph_lo; ph < ph_hi; ++ph) {
    if (ph > ph_lo) cg::this_grid().sync();
    run_phase(p, smem, ph);
  }
}

extern "C" void kernel_launch(void* const* d_in, const int* in_sizes, int n_in, void* d_out, int out_size, void* d_ws,
                              size_t ws_size, hipStream_t stream) {
  Params p{};
  const float** fp = (const float**)&p;
  for (int i = 0; i < 22; ++i) fp[i] = (const float*)d_in[i];
  p.out = (float*)d_out;
  p.ws = (char*)d_ws;
  if ((size_t)1029242880ull > ws_size) { fprintf(stderr, "workspace too small: have %zu\n", ws_size); return; }

  static int grid_blocks = 0;
  if (!grid_blocks) {
    int dev = 0, cus = 0, per_cu = 0;
    hipGetDevice(&dev);
    hipDeviceGetAttribute(&cus, hipDeviceAttributeMultiprocessorCount, dev);
    hipOccupancyMaxActiveBlocksPerMultiprocessor(&per_cu, fwd_kernel, 256, 0);
    if (per_cu > 2) per_cu = 2;
    grid_blocks = cus * per_cu;
    if (grid_blocks <= 0) grid_blocks = 256;
  }
#if COOP
  int lo = 0, hi = NPHASE;
  void* args[] = {&p, &lo, &hi};
  hipError_t e = hipLaunchCooperativeKernel((void*)fwd_kernel, dim3(grid_blocks), dim3(256), args, 0, stream);
  if (e != hipSuccess) fprintf(stderr, "cooperative launch failed: %s (grid %d)\n", hipGetErrorString(e), grid_blocks);
#else
  for (int ph = 0; ph < NPHASE; ++ph) hipLaunchKernelGGL(fwd_kernel, dim3(grid_blocks), dim3(256), 0, stream, p, ph, ph + 1);
#endif
}
```

```cpp
#include <hip/hip_runtime.h>
#include <hip/hip_cooperative_groups.h>
#include <cstdio>
namespace cg = cooperative_groups;

#ifndef COOP
#define COOP 1
#endif

#ifndef PROBE_VARIANT
#define PROBE_VARIANT 0
#endif
#define DI __device__ __forceinline__
typedef unsigned short u16;
typedef __attribute__((ext_vector_type(8))) short bf16x8;
typedef __attribute__((ext_vector_type(4))) short s16x4;
typedef __attribute__((ext_vector_type(16))) float f32x16;
typedef __attribute__((ext_vector_type(4))) float f32x4;
typedef __attribute__((ext_vector_type(2))) float f32x2;
typedef __attribute__((ext_vector_type(4))) unsigned u32x4;
typedef __attribute__((ext_vector_type(2))) unsigned u32x2;
typedef __bf16 bf2_t __attribute__((ext_vector_type(2)));
typedef __attribute__((address_space(3))) s16x4 lds_s16x4;

#define MFMA(a, b, c) __builtin_amdgcn_mfma_f32_32x32x16_bf16((a), (b), (c), 0, 0, 0)

constexpr int NTOK = 65536;
constexpr int SEQ = 4096;
constexpr int LDE = 5184;
constexpr int LDO = 3264;
constexpr int LDX = 1088;
constexpr int LDY = 576;
constexpr int LDK1 = 1088, LDK15 = 1600, LDK5 = 576, LDK6 = 704;
constexpr float EPS = 1e-6f;
constexpr int SMEM_BYTES = 77824;

constexpr size_t al256(size_t x) { return (x + 255) & ~(size_t)255; }
constexpr size_t OFF_WtEin = 0;
constexpr size_t OFF_WtEout = OFF_WtEin + al256((size_t)2 * 5120 * LDK1 * 2);
constexpr size_t OFF_WtGlu = OFF_WtEout + al256((size_t)2 * 1024 * LDK15 * 2);
constexpr size_t OFF_WtOin = OFF_WtGlu + al256((size_t)2 * 512 * LDK5 * 2);
constexpr size_t OFF_WtOout = OFF_WtOin + al256((size_t)2 * 3200 * LDK1 * 2);
constexpr size_t OFF_WgT = OFF_WtOout + al256((size_t)2 * 1024 * LDK1 * 2);
constexpr size_t OFF_WtMQ = OFF_WgT + al256((size_t)2 * 512 * 16 * 2);
constexpr size_t OFF_WtP = OFF_WtMQ + al256((size_t)2 * 32 * 512 * LDK6 * 2);
constexpr size_t OFF_LT = OFF_WtP + al256((size_t)2 * 32 * 128 * LDK5 * 2);
constexpr size_t OFF_xb = OFF_LT + al256((size_t)2 * 32 * 64 * 2 * 4);
constexpr size_t OFF_part = OFF_xb + al256((size_t)NTOK * LDX * 2);
constexpr size_t OFF_proj = OFF_part + al256((size_t)NTOK * 8 * 4);
constexpr size_t OFF_yb = OFF_proj + al256((size_t)NTOK * LDE * 2);
constexpr size_t OFF_Sc = OFF_yb + al256((size_t)NTOK * LDY * 2);
constexpr size_t OFF_hp = OFF_Sc + al256((size_t)2048 * 32 * 128 * 4);
constexpr size_t OFF_ssqg = OFF_hp + al256((size_t)2048 * 32 * 128 * 2);
constexpr size_t OFF_bar = OFF_ssqg + al256((size_t)NTOK * 32 * 4);
constexpr size_t WS_TOTAL = OFF_bar + al256((size_t)3456 * 4);

struct Params {
  const float *x, *even_norm_g, *even_w_in, *sb_q_g, *sb_k_g, *lam_re, *lam_im, *log_dt, *b_re, *b_im, *c_re, *c_im,
      *s5_d, *w_glu, *b_glu, *even_w_out, *odd_norm_g, *odd_w_in, *gla_w_gate, *gla_b_gate, *gla_o_g, *odd_w_out;
  float* out;
  char* ws;
  DI u16* WtEin() const { return (u16*)(ws + OFF_WtEin); }
  DI u16* WtEout() const { return (u16*)(ws + OFF_WtEout); }
  DI u16* WtGlu() const { return (u16*)(ws + OFF_WtGlu); }
  DI u16* WtOin() const { return (u16*)(ws + OFF_WtOin); }
  DI u16* WtOout() const { return (u16*)(ws + OFF_WtOout); }
  DI u16* WgT() const { return (u16*)(ws + OFF_WgT); }
  DI u16* WtMQ() const { return (u16*)(ws + OFF_WtMQ); }
  DI u16* WtP() const { return (u16*)(ws + OFF_WtP); }
  DI float* LT() const { return (float*)(ws + OFF_LT); }
  DI u16* xb() const { return (u16*)(ws + OFF_xb); }
  DI float* part() const { return (float*)(ws + OFF_part); }
  DI u16* proj() const { return (u16*)(ws + OFF_proj); }
  DI u16* yb() const { return (u16*)(ws + OFF_yb); }
  DI float* Sc() const { return (float*)(ws + OFF_Sc); }
  DI u16* hp() const { return (u16*)(ws + OFF_hp); }
  DI float* ssqg() const { return (float*)(ws + OFF_ssqg); }
};

DI unsigned pk2(float a, float b) { f32x2 v = {a, b}; return __builtin_bit_cast(unsigned, __builtin_convertvector(v, bf2_t)); }
DI u16 f2bf(float a) { return (u16)(pk2(a, 0.f) & 0xffffu); }
DI float bflo(unsigned u) { return __uint_as_float(u << 16); }
DI float bfhi(unsigned u) { return __uint_as_float(u & 0xffff0000u); }
DI int crow(int i, int h) { return (i & 3) + 8 * (i >> 2) + 4 * h; }
DI float fexp2(float x) { return __builtin_amdgcn_exp2f(x); }
DI float flog2(float x) { return __builtin_amdgcn_logf(x); }
DI float frcp(float x) { return __builtin_amdgcn_rcpf(x); }
DI float fexp(float x) { return fexp2(x * 1.44269504088896f); }
DI float sigmoidf_(float x) { return frcp(1.f + fexp(-x)); }
DI float siluf_(float x) { return x * sigmoidf_(x); }
DI unsigned off_b(unsigned row, unsigned ch) { return 256u * row + 16u * (ch ^ (((row & 3) << 2) | ((row >> 2) & 3))); }
DI unsigned off_g(unsigned row, unsigned ch) { return 128u * row + 16u * (ch ^ ((row >> 1) & 7)); }
DI s16x4 tr_read(const char* p) { return __builtin_amdgcn_ds_read_tr16_b64_v4i16((lds_s16x4*)p); }
DI bf16x8 cat4(s16x4 lo, s16x4 hi) { return __builtin_shufflevector(lo, hi, 0, 1, 2, 3, 4, 5, 6, 7); }
DI f32x16 zero16() { f32x16 z;
#pragma unroll
  for (int i = 0; i < 16; ++i) z[i] = 0.f; return z; }
DI bf16x8 pack8(const float* f) {
  u32x4 r; r[0] = pk2(f[0], f[1]); r[1] = pk2(f[2], f[3]); r[2] = pk2(f[4], f[5]); r[3] = pk2(f[6], f[7]);
  return __builtin_bit_cast(bf16x8, r);
}
DI void unpack8(bf16x8 v, float* f) {
  u32x4 r = __builtin_bit_cast(u32x4, v);
#pragma unroll
  for (int i = 0; i < 4; ++i) { f[2 * i] = bflo(r[i]); f[2 * i + 1] = bfhi(r[i]); }
}
DI bf16x8 ldg8(const u16* p) { return *(const bf16x8*)p; }
DI float red16(float v) {
  v += __shfl_xor(v, 1); v += __shfl_xor(v, 2); v += __shfl_xor(v, 4); v += __shfl_xor(v, 8); return v;
}
DI void wave_lds_fence() { __builtin_amdgcn_fence(__ATOMIC_RELEASE, "wavefront"); __builtin_amdgcn_wave_barrier(); __builtin_amdgcn_fence(__ATOMIC_ACQUIRE, "wavefront"); }

DI float row_rstd(const float* part, int row) {
  const f32x4* p = (const f32x4*)(part + (size_t)row * 8);
  f32x4 a = p[0], b = p[1];
  float s = a[0] + a[1] + a[2] + a[3] + b[0] + b[1] + b[2] + b[3];
  return __builtin_amdgcn_rsqf(s * (1.f / 1024.f) + EPS);
}

template <class AL, class EP>
DI void gemm_tile(int tid, char* smem, const AL& al, const u16* __restrict__ Bt, int ldb, int K, int row0, int col0, const EP& ep) {
  const int w = tid >> 6, l = tid & 63, r = l & 31, h = l >> 5;
  char* As = smem;
  char* Bs = smem + 32768;
  f32x16 acc[2][4];
#pragma unroll
  for (int mi = 0; mi < 2; ++mi)
#pragma unroll
    for (int ni = 0; ni < 4; ++ni) acc[mi][ni] = zero16();
  const int lrow = tid >> 3, lch = tid & 7;
  bf16x8 ra[8], rb[4];
  const unsigned boff = ((unsigned)(col0 + lrow) * (unsigned)ldb + lch * 8) * 2u;
  const unsigned bstep = 64u * (unsigned)ldb;
  auto gload = [&](int k0) {
    const char* ab = al.base(k0);
    unsigned ao = al.off(row0 + lrow, k0 + lch * 8);
    unsigned st = al.step32(k0), bs = bstep, bo = boff + 2u * k0;
    asm volatile("" : "+s"(st), "+s"(bs));
    asm volatile("" : "+v"(ao), "+v"(bo));
#pragma unroll
    for (int i = 0; i < 8; ++i) ra[i] = *(const bf16x8*)(ab + (ao + i * st));
#pragma unroll
    for (int i = 0; i < 4; ++i) rb[i] = *(const bf16x8*)((const char*)Bt + (bo + i * bs));
  };
  const unsigned wbase = off_g(lrow, lch);
  unsigned xo[4];
#pragma unroll
  for (int s = 0; s < 4; ++s) xo[s] = 16u * ((2 * s + h) ^ ((r >> 1) & 7));
  const unsigned abase = 128u * (64 * w + r), bbase = 32768u + 128u * r;
  gload(0);
  for (int k0 = 0; k0 < K; k0 += 64) {
    if constexpr (AL::kRowScale) {
      float* rsl = (float*)(smem + 49152);
      if ((k0 & 255) == 0) {
        rsl[tid] = al.rowscale(row0 + tid, k0 >> 8);
        __syncthreads();
      }
#pragma unroll
      for (int i = 0; i < 8; ++i) {
        const float sc = rsl[lrow + 32 * i];
        float f[8]; unpack8(ra[i], f);
#pragma unroll
        for (int j = 0; j < 8; ++j) f[j] *= sc;
        ra[i] = pack8(f);
      }
    }
#pragma unroll
    for (int i = 0; i < 8; ++i) *(bf16x8*)(As + wbase + 4096 * i) = ra[i];
#pragma unroll
    for (int i = 0; i < 4; ++i) *(bf16x8*)(Bs + wbase + 4096 * i) = rb[i];
    __syncthreads();
    if (k0 + 64 < K) gload(k0 + 64);
#pragma unroll
    for (int s = 0; s < 4; ++s) {
      bf16x8 a[2], b[4];
#pragma unroll
      for (int mi = 0; mi < 2; ++mi) a[mi] = *(const bf16x8*)(smem + abase + 4096 * mi + xo[s]);
#pragma unroll
      for (int ni = 0; ni < 4; ++ni) b[ni] = *(const bf16x8*)(smem + bbase + 4096 * ni + xo[s]);
#pragma unroll
      for (int mi = 0; mi < 2; ++mi)
#pragma unroll
        for (int ni = 0; ni < 4; ++ni) acc[mi][ni] = MFMA(a[mi], b[ni], acc[mi][ni]);
      __builtin_amdgcn_sched_barrier(0);
    }
    __syncthreads();
  }
  float* stg = (float*)(smem + w * 16896);
#pragma unroll
  for (int mi = 0; mi < 2; ++mi) {
#pragma unroll
    for (int ni = 0; ni < 4; ++ni)
#pragma unroll
      for (int i = 0; i < 16; ++i) stg[crow(i, h) * 132 + 32 * ni + r] = acc[mi][ni][i];
    wave_lds_fence();
#pragma unroll
    for (int ps = 0; ps < 8; ++ps) {
      const int rr = 4 * ps + (l >> 4), cc = (l & 15) * 8;
      float v[8];
      f32x4 v0 = *(const f32x4*)(stg + rr * 132 + cc), v1 = *(const f32x4*)(stg + rr * 132 + cc + 4);
#pragma unroll
      for (int j = 0; j < 4; ++j) { v[j] = v0[j]; v[4 + j] = v1[j]; }
      ep(row0 + 64 * w + 32 * mi + rr, col0 + cc, v, l, 1.f);
    }
    wave_lds_fence();
  }
  __syncthreads();
}

#define WAIT_V(n) asm volatile("s_waitcnt vmcnt(%0)" ::"n"(n) : "memory")
#define RAW_BARRIER() do { asm volatile("s_waitcnt lgkmcnt(0)" ::: "memory"); __builtin_amdgcn_s_barrier(); } while (0)
template <class AL, class EP>
DI void gemm_tile_dma(int tid, char* smem, const AL& al, const u16* __restrict__ Bt, int ldb, int K, int row0, int col0, const EP& ep, int variant = 0) {
  typedef __attribute__((ext_vector_type(4))) float f32x4v;
  const int w = tid >> 6, l = tid & 63, r16 = l & 15, q4 = l >> 4;
  f32x4v acc[4][8];
#pragma unroll
  for (int mi = 0; mi < 4; ++mi)
#pragma unroll
    for (int ni = 0; ni < 8; ++ni) { acc[mi][ni][0] = 0.f; acc[mi][ni][1] = 0.f; acc[mi][ni][2] = 0.f; acc[mi][ni][3] = 0.f; }
  auto Gf = [](int x) -> int { return (0x78 >> (2 * x)) & 3; };
  const int lch = (l & 3) ^ Gf((l >> 4) & 3);
  const unsigned boff = ((unsigned)(col0 + 32 * w + (l >> 2)) * (unsigned)ldb + lch * 8) * 2u;
  const unsigned bstep = 32u * (unsigned)ldb;
  auto stage = [&](int buf, int kt) {
    const int k0 = kt * 32;
    const char* ab = al.base(k0);
    unsigned ao = al.off(row0 + 64 * w + (l >> 2), k0 + lch * 8);
    unsigned st = al.step32(k0) >> 1, bs = bstep, bo = boff + 2u * k0;
    asm volatile("" : "+s"(st), "+s"(bs));
    asm volatile("" : "+v"(ao), "+v"(bo));
    char* sa = smem + buf * 24576 + w * 4096;
    char* sb = smem + buf * 24576 + 16384 + w * 2048;
#pragma unroll
    for (int i = 0; i < 4; ++i)
      __builtin_amdgcn_global_load_lds((const unsigned*)(ab + (ao + i * st)), (unsigned*)(sa + i * 1024), 16, 0, 0);
#pragma unroll
    for (int i = 0; i < 2; ++i)
      __builtin_amdgcn_global_load_lds((const unsigned*)((const char*)Bt + (bo + i * bs)), (unsigned*)(sb + i * 1024), 16, 0, 0);
  };
  const unsigned xo = 16u * (unsigned)(q4 ^ Gf((r16 >> 2) & 3));
  const unsigned fbase = 64u * r16 + xo;
  const unsigned wofs = 4096u * (unsigned)__builtin_amdgcn_readfirstlane(w);
  const int nt = K >> 5;
  float* rtab = (float*)(smem + 73728);
  if constexpr (EP::kRstd) rtab[tid] = row_rstd(ep.part, row0 + tid);
  stage(0, 0);
  stage(1, 1);
  WAIT_V(6);
  RAW_BARRIER();
  bf16x8 xa[4], xb[4], ya[4], yb[4];
  auto rdA = [&](bf16x8 (&fa)[4], unsigned bufoff) {
#pragma unroll
    for (int mi = 0; mi < 4; ++mi) fa[mi] = *(const bf16x8*)(smem + (bufoff + wofs + 1024u * mi) + fbase);
  };
  auto rdB = [&](bf16x8 (&fb)[4], unsigned bufoff, int hf) {
#pragma unroll
    for (int ni = 0; ni < 4; ++ni) fb[ni] = *(const bf16x8*)(smem + (bufoff + 16384u + 1024u * (4 * hf + ni)) + fbase);
  };
  int cur = 0;
  auto slice = [&](int t, bf16x8 (&fa)[4], bf16x8 (&fb0)[4], bf16x8 (&fan)[4], bf16x8 (&fb0n)[4]) {
    const int nxt = (cur == 2) ? 0 : cur + 1, nn = (nxt == 2) ? 0 : nxt + 1;
    bf16x8 fb1[4];
    stage(nn, t + 2 < nt ? t + 2 : nt - 1);
    __builtin_amdgcn_sched_barrier(0);
    rdB(fb1, (unsigned)cur * 24576u, 1);
    __builtin_amdgcn_sched_barrier(0);
#pragma unroll
    for (int ni = 0; ni < 4; ++ni)
#pragma unroll
      for (int mi = 0; mi < 4; ++mi) acc[mi][ni] = __builtin_amdgcn_mfma_f32_16x16x32_bf16(fa[mi], fb0[ni], acc[mi][ni], 0, 0, 0);
    __builtin_amdgcn_sched_barrier(0);
    WAIT_V(6);
    RAW_BARRIER();
    rdB(fb0n, (unsigned)nxt * 24576u, 0);
    __builtin_amdgcn_sched_barrier(0);
#pragma unroll
    for (int ni = 0; ni < 2; ++ni)
#pragma unroll
      for (int mi = 0; mi < 4; ++mi) acc[mi][4 + ni] = __builtin_amdgcn_mfma_f32_16x16x32_bf16(fa[mi], fb1[ni], acc[mi][4 + ni], 0, 0, 0);
    __builtin_amdgcn_sched_barrier(0);
    rdA(fan, (unsigned)nxt * 24576u);
    __builtin_amdgcn_sched_barrier(0);
#pragma unroll
    for (int ni = 2; ni < 4; ++ni)
#pragma unroll
      for (int mi = 0; mi < 4; ++mi) acc[mi][4 + ni] = __builtin_amdgcn_mfma_f32_16x16x32_bf16(fa[mi], fb1[ni], acc[mi][4 + ni], 0, 0, 0);
    __builtin_amdgcn_sched_barrier(0);
    cur = nxt;
  };
  rdA(xa, 0u);
  rdB(xb, 0u, 0);
  for (int t = 0; t < nt; t += 2) {
    slice(t, xa, xb, ya, yb);
    slice(t + 1, ya, yb, xa, xb);
  }
  WAIT_V(0);
  RAW_BARRIER();
  float* stg = (float*)(smem + w * 16896);
  EP e = ep;
  e.begin(col0 + (l & 15) * 8);
#pragma unroll
  for (int hm = 0; hm < 2; ++hm) {
#pragma unroll
    for (int m2 = 0; m2 < 2; ++m2)
#pragma unroll
      for (int ni = 0; ni < 8; ++ni)
#pragma unroll
        for (int i = 0; i < 4; ++i) stg[(16 * m2 + 4 * q4 + i) * 132 + 16 * ni + r16] = acc[2 * hm + m2][ni][i];
    wave_lds_fence();
#pragma unroll
    for (int ps = 0; ps < 8; ++ps) {
      const int rr = 4 * ps + (l >> 4), cc = (l & 15) * 8;
      float v[8];
      f32x4 v0 = *(const f32x4*)(stg + rr * 132 + cc), v1 = *(const f32x4*)(stg + rr * 132 + cc + 4);
#pragma unroll
      for (int jj = 0; jj < 4; ++jj) { v[jj] = v0[jj]; v[4 + jj] = v1[jj]; }
      float rs = 1.f;
      if constexpr (EP::kRstd) rs = rtab[64 * w + 32 * hm + rr];
      e(row0 + 64 * w + 32 * hm + rr, col0 + cc, v, l, rs);
    }
    wave_lds_fence();
  }
  __syncthreads();
}

struct ALPlain {
  static constexpr bool kRowScale = false;
  const u16* base_; int ld; int kseg; int off0; int off1;
  DI const char* base(int) const { return (const char*)base_; }
  DI unsigned off(int row, int k) const { return ((unsigned)row * (unsigned)ld + k + (k < kseg ? off0 : off1)) * 2u; }
  DI unsigned step32(int) const { return 64u * (unsigned)ld; }
  DI float rowscale(int, int) const { return 1.f; }
};
struct ALGlaOut {
  static constexpr bool kRowScale = true;
  const u16* base_; const float* ssq;
  DI const char* base(int) const { return (const char*)base_; }
  DI unsigned off(int row, int k) const { return ((unsigned)row * LDO + 1024 + k) * 2u; }
  DI unsigned step32(int) const { return 64u * LDO; }
  DI float rowscale(int row, int hd) const {
    const f32x4* p = (const f32x4*)(ssq + (size_t)row * 32 + hd * 8);
    f32x4 a = p[0], b = p[1];
    float s = a[0] + a[1] + a[2] + a[3] + b[0] + b[1] + b[2] + b[3];
    return __builtin_amdgcn_rsqf(s * (1.f / 256.f) + EPS);
  }
};
struct ALS5 {
  static constexpr bool kRowScale = false;
  const u16* proj; const u16* hp; int g;
  DI const char* base(int k0) const { return (const char*)(k0 < 512 ? proj : hp); }
  DI unsigned off(int row, int k) const {
    if (k < 512) return ((unsigned)(row * 32 + (k >> 4)) * LDE + 4096 + g * 16 + (k & 15)) * 2u;
    return (((unsigned)row * 32 + g) * 128 + (k - 512)) * 2u;
  }
  DI unsigned step32(int k) const { return k < 512 ? 2u * 32 * 32 * LDE : 2u * 32 * 32 * 128; }
  DI float rowscale(int, int) const { return 1.f; }
};

struct EPEvenIn {
  static constexpr bool kRstd = true;
  const float* part; u16* proj; const float* qg; const float* kg;
  float gsc[8];
  DI void begin(int col) {
    const float* g = (col < 1024 ? qg : kg) + (col & 127);
    const float sc = (col < 1024 ? 0.08838834764831845f * 1.44269504088896f : 1.f);
#pragma unroll
    for (int j = 0; j < 8; ++j) gsc[j] = (col < 2048) ? sc * g[j] : 1.f;
  }
  DI void operator()(int row, int col, float* v, int, float rs) const {
#pragma unroll
    for (int j = 0; j < 8; ++j) v[j] *= rs;
    if (col < 2048) {
      float s = 0.f;
#pragma unroll
      for (int j = 0; j < 8; ++j) s += v[j] * v[j];
      s = red16(s);
      const float rn = __builtin_amdgcn_rsqf(s * (1.f / 128.f) + EPS);
#pragma unroll
      for (int j = 0; j < 8; ++j) v[j] *= rn * gsc[j];
    }
    *(bf16x8*)((char*)proj + ((unsigned)row * LDE + col) * 2u) = pack8(v);
  }
};
struct EPOddIn {
  static constexpr bool kRstd = true;
  const float* part; u16* proj;
  DI void begin(int) {}
  DI void operator()(int row, int col, float* v, int, float rs) const {
#pragma unroll
    for (int j = 0; j < 8; ++j) v[j] *= rs;
    *(bf16x8*)((char*)proj + ((unsigned)row * LDO + col) * 2u) = pack8(v);
  }
};
struct EPOut {
  static constexpr bool kRstd = false;
  const float* xin; float* xout; u16* xb; float* part; bool dry;
  DI void begin(int) {}
  DI void operator()(int row, int col, float* v, int lane, float) const {
    const f32x4* xi = (const f32x4*)(xin + (size_t)row * 1024 + col);
    f32x4 a = xi[0], b = xi[1];
#pragma unroll
    for (int j = 0; j < 4; ++j) { v[j] += a[j]; v[4 + j] += b[j]; }
    if (dry) return;
    f32x4* xo = (f32x4*)(xout + (size_t)row * 1024 + col);
    f32x4 o0 = {v[0], v[1], v[2], v[3]}, o1 = {v[4], v[5], v[6], v[7]};
    xo[0] = o0; xo[1] = o1;
    *(bf16x8*)(xb + (size_t)row * LDX + col) = pack8(v);
    float s = 0.f;
#pragma unroll
    for (int j = 0; j < 8; ++j) s += v[j] * v[j];
    s = red16(s);
    if ((lane & 15) == 0) part[(size_t)row * 8 + (col >> 7)] = s;
  }
};
struct EPS5P {
  static constexpr bool kRstd = false;
  float* Sc; int g;
  DI void begin(int) {}
  DI void operator()(int row, int col, float* v, int, float) const {
    f32x4* o = (f32x4*)(Sc + ((size_t)row * 32 + g) * 128 + col);
    f32x4 o0 = {v[0], v[1], v[2], v[3]}, o1 = {v[4], v[5], v[6], v[7]};
    o[0] = o0; o[1] = o1;
  }
};
DI float gelu_tanh(float y) {
  const float u = 0.7978845608028654f * (y + 0.044715f * y * y * y);
  const float t = 1.f - 2.f * frcp(1.f + fexp(2.f * u));
  return 0.5f * y * (1.f + t);
}
struct EPS5Y {
  static constexpr bool kRstd = false;
  const u16* proj; u16* yb; const float* dsk; int g;
  DI void begin(int) {}
  DI void operator()(int row, int col, float* v, int, float) const {
    const int tok = row * 32 + (col >> 4), ch = g * 16 + (col & 15);
    float u[8]; unpack8(ldg8(proj + (size_t)tok * LDE + 4096 + ch), u);
#pragma unroll
    for (int j = 0; j < 8; ++j) v[j] = gelu_tanh(v[j] + dsk[ch + j] * u[j]);
    *(bf16x8*)(yb + (size_t)tok * LDY + ch) = pack8(v);
  }
};
struct EPGlu {
  static constexpr bool kRstd = false;
  u16* proj; const u16* yb; const float* bg; bool dry;
  DI void begin(int) {}
  DI void operator()(int row, int col, float* v, int, float) const {
    float y[8], z[8];
    unpack8(ldg8(yb + (size_t)row * LDY + col), y);
    u16* zp = proj + (size_t)row * LDE + 4608 + col;
    unpack8(ldg8(zp), z);
#pragma unroll
    for (int j = 0; j < 8; ++j) v[j] = y[j] * sigmoidf_(v[j] + bg[col + j]) * siluf_(z[j]);
    if (!dry) *(bf16x8*)zp = pack8(v);
  }
};

DI void transpose_tile(int tid, char* smem, const float* __restrict__ src, u16* __restrict__ dst, int K, int N, int ldk, int kt, int nt,
                       const float* scale, int smask) {
  float* t = (float*)smem;
  const int k0 = kt * 64, n0 = nt * 64;
#pragma unroll
  for (int i = 0; i < 16; ++i) {
    const int kk = (tid >> 6) + 4 * i, nn = tid & 63;
    float v = 0.f;
    if (n0 + nn < N) v = src[(size_t)(k0 + kk) * N + n0 + nn] * (scale ? scale[(k0 + kk) & smask] : 1.f);
    t[kk * 65 + nn] = v;
  }
  __syncthreads();
#pragma unroll
  for (int i = 0; i < 2; ++i) {
    const int c = tid + 256 * i;
    const int nn = c >> 3, k8 = (c & 7) * 8;
    float f[8];
#pragma unroll
    for (int j = 0; j < 8; ++j) f[j] = t[(k8 + j) * 65 + nn];
    *(bf16x8*)(dst + (size_t)(n0 + nn) * ldk + k0 + k8) = pack8(f);
  }
  __syncthreads();
}

DI void s5_setup(int tid, const Params& p, char* smem, int lg) {
  float* pw_re = (float*)smem;
  float* pw_im = pw_re + 33 * 64;
  float* bb_re = pw_im + 33 * 64;
  float* bb_im = bb_re + 1024;
  float* cc_re = bb_im + 1024;
  float* cc_im = cc_re + 1024;
  float* f_re = cc_im + 1024;
  float* f_im = f_re + 64;
  float* Kt = f_im + 64;
  if (tid < 64) {
    const float lr = p.lam_re[lg * 64 + tid], li = p.lam_im[lg * 64 + tid];
    const float dt = expf(p.log_dt[lg]);
    const float mag = expf(lr * dt);
    float sn, cs; sincosf(li * dt, &sn, &cs);
    const float br = mag * cs, bi = mag * sn;
    float pr = 1.f, pi = 0.f;
    for (int t = 0; t <= 32; ++t) {
      pw_re[t * 64 + tid] = pr; pw_im[t * 64 + tid] = pi;
      const float nr = pr * br - pi * bi, ni = pr * bi + pi * br;
      pr = nr; pi = ni;
    }
    p.LT()[(lg * 64 + tid) * 2] = pw_re[32 * 64 + tid];
    p.LT()[(lg * 64 + tid) * 2 + 1] = pw_im[32 * 64 + tid];
    const float nr = br - 1.f, ni = bi, den = 1.f / (lr * lr + li * li);
    f_re[tid] = (nr * lr + ni * li) * den;
    f_im[tid] = (ni * lr - nr * li) * den;
  }
  __syncthreads();
  for (int e = tid; e < 1024; e += 256) {
    const int n = e >> 4;
    const float br = p.b_re[(size_t)lg * 1024 + e], bi = p.b_im[(size_t)lg * 1024 + e];
    bb_re[e] = f_re[n] * br - f_im[n] * bi;
    bb_im[e] = f_re[n] * bi + f_im[n] * br;
    cc_re[e] = p.c_re[(size_t)lg * 1024 + e];
    cc_im[e] = p.c_im[(size_t)lg * 1024 + e];
  }
  __syncthreads();
  {
    const int pp = tid >> 4, pq = tid & 15;
    for (int t = 0; t < 32; ++t) {
      float s = 0.f;
      for (int n = 0; n < 64; ++n) {
        const float cr = cc_re[pp * 64 + n], ci = cc_im[pp * 64 + n];
        const float wr = pw_re[t * 64 + n], wi = pw_im[t * 64 + n];
        const float xr = cr * wr - ci * wi, xi = cr * wi + ci * wr;
        s += xr * bb_re[n * 16 + pq] - xi * bb_im[n * 16 + pq];
      }
      Kt[t * 256 + tid] = s;
    }
  }
  __syncthreads();
  u16* mq = p.WtMQ() + (size_t)lg * 512 * LDK6;
  for (int c = tid; c < 512 * 80; c += 256) {
    const int no = c / 80, k8 = (c % 80) * 8;
    const int t = no >> 4, pp = no & 15;
    float f[8];
    if (k8 < 512) {
      const int s = k8 >> 4, q0 = k8 & 15;
#pragma unroll
      for (int j = 0; j < 8; ++j) f[j] = (s <= t) ? Kt[(t - s) * 256 + pp * 16 + q0 + j] : 0.f;
    } else if (k8 < 576) {
      const int n0 = k8 - 512;
#pragma unroll
      for (int j = 0; j < 8; ++j) {
        const int n = n0 + j;
        f[j] = cc_re[pp * 64 + n] * pw_re[(t + 1) * 64 + n] - cc_im[pp * 64 + n] * pw_im[(t + 1) * 64 + n];
      }
    } else {
      const int n0 = k8 - 576;
#pragma unroll
      for (int j = 0; j < 8; ++j) {
        const int n = n0 + j;
        f[j] = -(cc_re[pp * 64 + n] * pw_im[(t + 1) * 64 + n] + cc_im[pp * 64 + n] * pw_re[(t + 1) * 64 + n]);
      }
    }
    *(bf16x8*)(mq + (size_t)no * LDK6 + k8) = pack8(f);
  }
  u16* wp = p.WtP() + (size_t)lg * 128 * LDK5;
  for (int c = tid; c < 128 * 64; c += 256) {
    const int nn = c >> 6, k8 = (c & 63) * 8;
    const int n = nn & 63, s = k8 >> 4, q0 = k8 & 15;
    const float wr = pw_re[(31 - s) * 64 + n], wi = pw_im[(31 - s) * 64 + n];
    float f[8];
#pragma unroll
    for (int j = 0; j < 8; ++j) {
      const float br = bb_re[n * 16 + q0 + j], bi = bb_im[n * 16 + q0 + j];
      f[j] = (nn < 64) ? (wr * br - wi * bi) : (wr * bi + wi * br);
    }
    *(bf16x8*)(wp + (size_t)nn * LDK5 + k8) = pack8(f);
  }
  __syncthreads();
}

DI void phase_prologue(int tid, int bid, const Params& p, char* smem) {
  const int nb = gridDim.x;
  const bool s5blk = (nb >= 128) && (bid >= nb - 64);
  if (nb >= 128) { if (s5blk) s5_setup(tid, p, smem, bid - (nb - 64)); }
  else for (int it = bid; it < 64; it += nb) s5_setup(tid, p, smem, it);
  const int nbw = (nb >= 128) ? nb - 64 : nb;
  if (s5blk) return;
  for (int lyr = 0; lyr < 2; ++lyr) {
    struct TJ { const float* src; u16* dst; int K, N, Npad, ldk; const float* sc; int smask; };
    const TJ jobs[5] = {
        {p.even_w_in + (size_t)lyr * 1024 * 5120, p.WtEin() + (size_t)lyr * 5120 * LDK1, 1024, 5120, 5120, LDK1, p.even_norm_g + lyr * 1024, 1023},
        {p.even_w_out + (size_t)lyr * 1536 * 1024, p.WtEout() + (size_t)lyr * 1024 * LDK15, 1536, 1024, 1024, LDK15, nullptr, 0},
        {p.w_glu + (size_t)lyr * 512 * 512, p.WtGlu() + (size_t)lyr * 512 * LDK5, 512, 512, 512, LDK5, nullptr, 0},
        {p.odd_w_in + (size_t)lyr * 1024 * 3088, p.WtOin() + (size_t)lyr * 3200 * LDK1, 1024, 3088, 3200, LDK1, p.odd_norm_g + lyr * 1024, 1023},
        {p.odd_w_out + (size_t)lyr * 1024 * 1024, p.WtOout() + (size_t)lyr * 1024 * LDK1, 1024, 1024, 1024, LDK1, p.gla_o_g + lyr * 256, 255}};
#pragma unroll
    for (int j = 0; j < 5; ++j) {
      const int nkt = jobs[j].K / 64, nnt = jobs[j].Npad / 64;
      for (int t = bid; t < nkt * nnt; t += nbw)
        transpose_tile(tid, smem, jobs[j].src, jobs[j].dst, jobs[j].K, jobs[j].N, jobs[j].ldk, t % nkt, t / nkt, jobs[j].sc, jobs[j].smask);
    }
    for (int e = bid * 256 + tid; e < 512 * 16; e += nbw * 256) {
      const int c = e >> 4, k = e & 15;
      p.WgT()[(size_t)lyr * 8192 + e] = f2bf(p.gla_w_gate[(size_t)lyr * 8192 + k * 512 + c]);
    }
  }
  const int w = tid >> 6, l = tid & 63;
  for (int row0 = (bid * 4 + w) * 4; row0 < NTOK; row0 += nbw * 16) {
    f32x4 va[4][4];
#pragma unroll
    for (int rr = 0; rr < 4; ++rr) {
      const f32x4* xr = (const f32x4*)(p.x + (size_t)(row0 + rr) * 1024);
#pragma unroll
      for (int i = 0; i < 2; ++i) { va[rr][2 * i] = xr[(l + 64 * i) * 2]; va[rr][2 * i + 1] = xr[(l + 64 * i) * 2 + 1]; }
    }
#pragma unroll
    for (int rr = 0; rr < 4; ++rr) {
      float s = 0.f;
#pragma unroll
      for (int i = 0; i < 2; ++i) {
        f32x4 a = va[rr][2 * i], b = va[rr][2 * i + 1];
        float f[8] = {a[0], a[1], a[2], a[3], b[0], b[1], b[2], b[3]};
#pragma unroll
        for (int j = 0; j < 8; ++j) s += f[j] * f[j];
        *(bf16x8*)(p.xb() + (size_t)(row0 + rr) * LDX + (l + 64 * i) * 8) = pack8(f);
      }
#pragma unroll
      for (int m = 1; m < 64; m <<= 1) s += __shfl_xor(s, m);
      if (l < 8) p.part()[(size_t)(row0 + rr) * 8 + l] = (l == 0) ? s : 0.f;
    }
  }
}

DI void attn_item(int tid, const Params& p, char* smem, int b, int hh, int qb, bool dry) {
  const int w = tid >> 6, l = tid & 63, r = l & 31, h = l >> 5;
  char* Ks = smem;
  char* Vs = smem + 16384;
  char* Qs = smem + 32768 + w * 8192;
  float* flags = (float*)(smem + 65536);
  float* stg = (float*)(smem + w * 8704);
  const u16* base = p.proj() + (size_t)b * SEQ * LDE;
  const int q0 = qb * 128, qw0 = q0 + 32 * w;
  {
    const u16* qp = base + (size_t)(qw0 + r) * LDE + hh * 128 + 8 * h;
#pragma unroll
    for (int s = 0; s < 8; ++s) *(bf16x8*)(Qs + off_b(r, 2 * s + h)) = ldg8(qp + 16 * s);
  }
  f32x16 ot[4];
#pragma unroll
  for (int d = 0; d < 4; ++d) ot[d] = zero16();
  float carry = 1.f, wmax = 1.f;
  const int lrow = tid >> 4, lch = tid & 15;
  bf16x8 rk[4], rv[4];
  auto gload = [&](int jt) {
    const u16* kp = base + (size_t)(jt * 64 + lrow) * LDE + 1024 + hh * 128 + lch * 8;
#pragma unroll
    for (int i = 0; i < 4; ++i) { rk[i] = ldg8(kp + (size_t)(16 * i) * LDE); rv[i] = ldg8(kp + (size_t)(16 * i) * LDE + 1024); }
  };
  const int trq = (l & 15) >> 2, trp = l & 3, trblk = (l >> 4) & 1;
  const unsigned fr = ((r & 3) << 2) | ((r >> 2) & 3);
  unsigned xs[8];
#pragma unroll
  for (int s = 0; s < 8; ++s) xs[s] = 16u * ((2 * s + h) ^ fr);
  const char* kbase = Ks + 256 * r;
  const char* qbase = Qs + 256 * r;
  const unsigned fv = (trq << 2) | h;
  unsigned vo[4];
#pragma unroll
  for (int d = 0; d < 4; ++d) vo[d] = 16u * ((4 * d + 2 * trblk + (trp >> 1)) ^ fv) + 8u * (trp & 1);
  const char* vbase = Vs + 256 * (4 * h + trq);
  int jt = 2 * qb + 1;
  gload(jt);
  for (; jt >= 0; --jt) {
#pragma unroll
    for (int i = 0; i < 4; ++i) {
      *(bf16x8*)(Ks + off_b(lrow + 16 * i, lch)) = rk[i];
      *(bf16x8*)(Vs + off_b(lrow + 16 * i, lch)) = rv[i];
    }
    RAW_BARRIER();
    if (jt > 0) gload(jt - 1);
    const int k0 = jt * 64;
    if (k0 <= qw0 && wmax >= 1e-30f) {
      f32x16 st[2];
      st[0] = zero16(); st[1] = zero16();
#pragma unroll
      for (int s = 0; s < 8; ++s) {
        const bf16x8 qf = *(const bf16x8*)(qbase + xs[s]);
#pragma unroll
        for (int kt = 0; kt < 2; ++kt) {
          bf16x8 a = *(const bf16x8*)(kbase + 8192 * kt + xs[s]);
          st[kt] = MFMA(a, qf, st[kt]);
        }
      }
      const bool need_mask = (k0 + 63 >= qw0);
      const int tq = qw0 + r;
      float running = carry;
#pragma unroll
      for (int kt = 1; kt >= 0; --kt) {
        float bt[16];
#pragma unroll
        for (int i = 0; i < 16; ++i) {
          float z2 = fminf(fmaxf(st[kt][i], -100.f), 100.f);
          float e = fexp2(-z2);
          float be = frcp(1.f + e);
          float om = e * be;
          if (need_mask && (k0 + 32 * kt + crow(i, h) >= tq)) { be = 0.f; om = 1.f; }
          bt[i] = be; st[kt][i] = om;
        }
#pragma unroll
        for (int rg = 3; rg >= 0; --rg) {
          const int i0 = 4 * rg;
          const float s2 = st[kt][i0 + 3], s1 = s2 * st[kt][i0 + 2], s0 = s1 * st[kt][i0 + 1], T = s0 * st[kt][i0];
          const float To = __shfl_xor(T, 32);
          const float off = running * (h ? 1.f : To);
          st[kt][i0 + 3] = bt[i0 + 3] * off;
          st[kt][i0 + 2] = bt[i0 + 2] * off * s2;
          st[kt][i0 + 1] = bt[i0 + 1] * off * s1;
          st[kt][i0] = bt[i0] * off * s0;
          running = off * T * (h ? To : 1.f);
        }
      }
      carry = running;
#pragma unroll
      for (int ks = 0; ks < 4; ++ks) {
        float wv[8];
#pragma unroll
        for (int j = 0; j < 8; ++j) wv[j] = st[ks >> 1][8 * (ks & 1) + j];
        const bf16x8 bw = pack8(wv);
#pragma unroll
        for (int d = 0; d < 4; ++d) {
          s16x4 lo = tr_read(vbase + 4096 * ks + vo[d]);
          s16x4 hi = tr_read(vbase + 4096 * ks + 2048 + (vo[d] ^ 32u));
          ot[d] = MFMA(cat4(lo, hi), bw, ot[d]);
        }
      }
    }
    {
      float m = carry;
#pragma unroll
      for (int s = 1; s < 64; s <<= 1) m = fmaxf(m, __shfl_xor(m, s));
      if (l == 0) flags[w] = m;
      wmax = m;
    }
    RAW_BARRIER();
    const float mx = fmaxf(fmaxf(flags[0], flags[1]), fmaxf(flags[2], flags[3]));
    if (mx < 1e-30f) break;
  }
#pragma unroll
  for (int hf = 0; hf < 2; ++hf) {
#pragma unroll
    for (int dd = 0; dd < 2; ++dd)
#pragma unroll
      for (int rg = 0; rg < 4; ++rg) {
        f32x4 v = {ot[2 * hf + dd][4 * rg], ot[2 * hf + dd][4 * rg + 1], ot[2 * hf + dd][4 * rg + 2], ot[2 * hf + dd][4 * rg + 3]};
        *(f32x4*)(stg + r * 68 + 32 * dd + 8 * rg + 4 * h) = v;
      }
    wave_lds_fence();
#pragma unroll
    for (int ps = 0; ps < 4; ++ps) {
      const int id = l + 64 * ps, rr = id >> 3, c8 = (id & 7) * 8;
      f32x4 v0 = *(const f32x4*)(stg + rr * 68 + c8), v1 = *(const f32x4*)(stg + rr * 68 + c8 + 4);
      u16* zp = p.proj() + ((size_t)b * SEQ + qw0 + rr) * LDE + 3072 + hh * 128 + 64 * hf + c8;
      float z[8], o[8];
      unpack8(ldg8(zp), z);
#pragma unroll
      for (int j = 0; j < 4; ++j) { o[j] = v0[j] * siluf_(z[j]); o[4 + j] = v1[j] * siluf_(z[4 + j]); }
      if (!dry) *(bf16x8*)zp = pack8(o);
    }
    wave_lds_fence();
  }
  __syncthreads();
}

DI void gla_g1(int tid, const Params& p, char* smem, int lyr, int b, int n, int hh) {
  const int w = tid >> 6, l = tid & 63, r = l & 31, h = l >> 5;
  float* Ef = (float*)smem;
  u16* base = p.proj() + (size_t)b * SEQ * LDO;
  const bf16x8 wgf = ldg8(p.WgT() + (size_t)lyr * 8192 + (hh * 128 + 32 * w + r) * 16 + 8 * h);
  const float gbias = p.gla_b_gate[lyr * 512 + hh * 128 + 32 * w + r];
  bf16x8 rf[2], rq[4], rkk[4];
  const int erow = tid >> 4, ech = tid & 15;
#pragma unroll
  for (int mt = 0; mt < 2; ++mt) rf[mt] = ldg8(base + (size_t)(n * 64 + 32 * mt + r) * LDO + 3072 + 8 * h);
#pragma unroll
  for (int i = 0; i < 4; ++i) {
    const u16* rp = base + (size_t)(n * 64 + erow + 16 * i) * LDO + hh * 128 + ech * 8;
    rq[i] = ldg8(rp); rkk[i] = ldg8(rp + 512);
  }
  {
    f32x16 ga[2];
#pragma unroll
    for (int mt = 0; mt < 2; ++mt) ga[mt] = MFMA(rf[mt], wgf, zero16());
    float running = 0.f;
#pragma unroll
    for (int mt = 0; mt < 2; ++mt)
#pragma unroll
      for (int rg = 0; rg < 4; ++rg) {
        float c[4];
#pragma unroll
        for (int j = 0; j < 4; ++j) {
          const float x = ga[mt][4 * rg + j] + gbias;
          const float sp = fmaxf(-x, 0.f) + 0.6931471805599453f * flog2(1.f + fexp(-fabsf(x)));
          c[j] = -sp * (1.f / 16.f);
        }
        c[1] += c[0]; c[2] += c[1]; c[3] += c[2];
        const float T = c[3], To = __shfl_xor(T, 32);
        const float off = running + (h ? To : 0.f);
#pragma unroll
        for (int j = 0; j < 4; ++j) Ef[(32 * mt + 8 * rg + 4 * h + j) * 128 + 32 * w + r] = fexp(off + c[j]);
        running = off + T + (h ? 0.f : To);
      }
  }
  __syncthreads();
#pragma unroll
  for (int i = 0; i < 4; ++i) {
    const int t = erow + 16 * i;
    const f32x4* ep = (const f32x4*)(Ef + t * 128 + ech * 8);
    f32x4 e0 = ep[0], e1 = ep[1];
    float e[8] = {e0[0], e0[1], e0[2], e0[3], e1[0], e1[1], e1[2], e1[3]};
    float q[8], k[8];
    unpack8(rq[i], q); unpack8(rkk[i], k);
#pragma unroll
    for (int j = 0; j < 8; ++j) { q[j] *= e[j] * 0.08838834764831845f; k[j] *= frcp(e[j]); }
    u16* rp = base + (size_t)(n * 64 + t) * LDO + hh * 128 + ech * 8;
    *(bf16x8*)rp = pack8(q);
    *(bf16x8*)(rp + 512) = pack8(k);
  }
  if (tid < 128) p.Sc()[(((size_t)b * 64 + n) * 4 + hh) * 128 + tid] = Ef[63 * 128 + tid];
  __syncthreads();
}

DI void gla_item(int tid, const Params& p, char* smem, int lyr, int b, int hh, int sl, bool dry) {
  const int w = tid >> 6, l = tid & 63, r = l & 31, h = l >> 5;
  char* vs = smem + 65536;
  char* sT = smem + 69632;
  u16* base = p.proj() + (size_t)b * SEQ * LDO;
  const float* elast = p.Sc() + ((size_t)b * 64 * 4 + hh) * 128;
  const int trq = (l & 15) >> 2, trp = l & 3, trblk = (l >> 4) & 1;
  const unsigned fr = ((r & 3) << 2) | ((r >> 2) & 3);
  auto xsf = [&](int s8) -> unsigned { unsigned v = 16u * ((2 * s8 + h) ^ fr); asm volatile("" : "+v"(v)); return v; };
  const unsigned rowb = 256u * r;
  const unsigned fk = (trq << 2) | (2 * h);
  const unsigned kb2 = 256u * (8 * h + trq);
  f32x16 sacc[2];
  sacc[0] = zero16(); sacc[1] = zero16();
  for (int e = tid; e < 2048; e += 256) ((unsigned*)sT)[e] = 0u;
  bf16x8 rvv;
  auto load_v = [&](int n) {
    rvv = ldg8(base + (size_t)(n * 64 + (tid >> 2)) * LDO + 1024 + hh * 256 + sl * 32 + (tid & 3) * 8);
  };
  auto dma_qk = [&](int n, int buf) {
    char* dq = smem + buf * 32768 + w * 4096;
#pragma unroll
    for (int i = 0; i < 4; ++i) {
      const int j = 4 * w + i;
      const int ch = (l & 15) ^ (((l >> 4) << 2) | (j & 3));
      const u16* src = base + (size_t)(n * 64 + 4 * j + (l >> 4)) * LDO + hh * 128 + ch * 8;
      __builtin_amdgcn_global_load_lds((const unsigned*)src, (unsigned*)(dq + i * 1024), 16, 0, 0);
      __builtin_amdgcn_global_load_lds((const unsigned*)(src + 512), (unsigned*)(dq + 16384 + i * 1024), 16, 0, 0);
    }
  };
  float el[2] = {1.f, 1.f};
  auto load_el = [&](int n) {
    if (w >= 2) {
#pragma unroll
      for (int ci = 0; ci < 2; ++ci) el[ci] = elast[(size_t)n * 512 + 32 * (2 * (w - 2) + ci) + r];
    }
  };
  u32x2 zreg[4];
  auto load_z = [&](int n) {
    const u16* zp = base + (size_t)(n * 64 + 32 * (w & 1) + r) * LDO + 2048 + hh * 256 + sl * 32 + 4 * h;
#pragma unroll
    for (int rg = 0; rg < 4; ++rg) zreg[rg] = *(const u32x2*)(zp + 8 * rg);
  };
  dma_qk(0, 0);
  load_v(0);
  load_el(0);
  dma_qk(1, 1);
  __builtin_amdgcn_sched_barrier(0);
  for (int n = 0; n < 64; ++n) {
    const char* qd = smem + (n & 1) * 32768;
    const char* ki = qd + 16384;
    {
      *(bf16x8*)(vs + (tid >> 2) * 64 + (tid & 3) * 16) = rvv;
      if (w >= 2 && n > 0 && !(dry && (PROBE_VARIANT == 12 || PROBE_VARIANT == 13))) {
        const int cb = 2 * (w - 2);
#pragma unroll
        for (int ci = 0; ci < 2; ++ci) {
          const int c = 32 * (cb + ci) + r;
#pragma unroll
          for (int i = 0; i < 16; ++i) *(u16*)(sT + off_b(crow(i, h), c >> 3) + (c & 7) * 2) = f2bf(sacc[ci][i]);
        }
      }
    }
    const float el0 = el[0], el1 = el[1];
    if (n + 1 < 64) WAIT_V(8); else WAIT_V(0);
    RAW_BARRIER();
    if (n + 1 < 64) { load_v(n + 1); load_el(n + 1); }
    const bool skip_o = dry && (PROBE_VARIANT == 11 || PROBE_VARIANT == 13), skip_s = dry && (PROBE_VARIANT == 12 || PROBE_VARIANT == 13);
    if (w < 2 ? skip_o : skip_s) {
    } else if (w < 2) {
      const int tt = w;
      load_z(n);
      f32x16 oa = zero16();
#pragma unroll
      for (int st = 0; st < 2; ++st) {
        if (st <= tt) {
          f32x16 sc = zero16();
#pragma unroll
          for (int hb = 0; hb < 2; ++hb) {
            bf16x8 af[4], bf[4];
#pragma unroll
            for (int q4 = 0; q4 < 4; ++q4) {
              af[q4] = *(const bf16x8*)(ki + rowb + 8192 * st + xsf(4 * hb + q4));
              bf[q4] = *(const bf16x8*)(qd + rowb + 8192 * tt + xsf(4 * hb + q4));
            }
            __builtin_amdgcn_sched_barrier(0);
#pragma unroll
            for (int q4 = 0; q4 < 4; ++q4) sc = MFMA(af[q4], bf[q4], sc);
            __builtin_amdgcn_sched_barrier(0);
          }
          if (st == tt) {
#pragma unroll
            for (int i = 0; i < 16; ++i)
              if (crow(i, h) > r) sc[i] = 0.f;
          }
          s16x4 vlo[2], vhi[2];
#pragma unroll
          for (int ks = 0; ks < 2; ++ks) {
            const int row0 = 32 * st + 16 * ks + 4 * h + trq;
            vlo[ks] = tr_read(vs + row0 * 64 + 32 * trblk + 8 * trp);
            vhi[ks] = tr_read(vs + (row0 + 8) * 64 + 32 * trblk + 8 * trp);
          }
#pragma unroll
          for (int ks = 0; ks < 2; ++ks) {
            float wv[8];
#pragma unroll
            for (int j = 0; j < 8; ++j) wv[j] = sc[8 * ks + j];
            oa = MFMA(cat4(vlo[ks], vhi[ks]), pack8(wv), oa);
          }
        }
      }
#pragma unroll
      for (int hb = 0; hb < 2; ++hb) {
        bf16x8 sf[4], bf[4];
#pragma unroll
        for (int q4 = 0; q4 < 4; ++q4) {
          sf[q4] = *(const bf16x8*)(sT + rowb + xsf(4 * hb + q4));
          bf[q4] = *(const bf16x8*)(qd + rowb + 8192 * tt + xsf(4 * hb + q4));
        }
        __builtin_amdgcn_sched_barrier(0);
#pragma unroll
        for (int q4 = 0; q4 < 4; ++q4) oa = MFMA(sf[q4], bf[q4], oa);
        __builtin_amdgcn_sched_barrier(0);
      }
      const size_t tok = (size_t)b * SEQ + n * 64 + 32 * tt + r;
      float ss = 0.f;
#pragma unroll
      for (int i = 0; i < 16; ++i) ss += oa[i] * oa[i];
      ss += __shfl_xor(ss, 32);
      if (h == 0 && !dry) p.ssqg()[tok * 32 + hh * 8 + sl] = ss;
      u16* rowp = p.proj() + tok * LDO + hh * 256 + sl * 32;
#pragma unroll
      for (int rg = 0; rg < 4; ++rg) {
        const int dv0 = 8 * rg + 4 * h;
        const u32x2 zz = zreg[rg];
        float z0 = bflo(zz[0]), z1 = bfhi(zz[0]), z2 = bflo(zz[1]), z3 = bfhi(zz[1]);
        u32x2 o;
        o[0] = pk2(oa[4 * rg] * siluf_(z0), oa[4 * rg + 1] * siluf_(z1));
        o[1] = pk2(oa[4 * rg + 2] * siluf_(z2), oa[4 * rg + 3] * siluf_(z3));
        if (!dry) *(u32x2*)(rowp + 1024 + dv0) = o;
      }
    } else {
      const int cb = 2 * (w - 2);
#pragma unroll
      for (int ks = 0; ks < 4; ++ks) {
        const int row0 = 16 * ks + 8 * h + trq;
        s16x4 lo = tr_read(vs + row0 * 64 + 32 * trblk + 8 * trp);
        s16x4 hi = tr_read(vs + (row0 + 4) * 64 + 32 * trblk + 8 * trp);
        const bf16x8 av = cat4(lo, hi);
#pragma unroll
        for (int ci = 0; ci < 2; ++ci) {
          const unsigned ko = 16u * ((4 * (cb + ci) + 2 * trblk + (trp >> 1)) ^ fk) + 8u * (trp & 1);
          s16x4 blo = tr_read(ki + kb2 + 4096 * ks + ko);
          s16x4 bhi = tr_read(ki + kb2 + 4096 * ks + 1024 + (ko ^ 16u));
          sacc[ci] = MFMA(av, cat4(blo, bhi), sacc[ci]);
        }
      }
#pragma unroll
      for (int ci = 0; ci < 2; ++ci)
#pragma unroll
        for (int i = 0; i < 16; ++i) sacc[ci][i] *= (ci ? el1 : el0);
    }
    RAW_BARRIER();
    __builtin_amdgcn_sched_barrier(0);
    if (n + 2 < 64) dma_qk(n + 2, n & 1);
    __builtin_amdgcn_sched_barrier(0);
  }
  __syncthreads();
}

#define FOR_TILES_XCD4(MT, NT, mt, nt)                                                           \
  for (int s_ = (bid >> 3), mt = 0, nt = 0;                                                       \
       s_ < ((MT) >> 3) * (NT) &&                                                                 \
       (mt = (bid & 7) + 8 * (4 * (s_ / (4 * (NT))) + (s_ & 3)), nt = (s_ % (4 * (NT))) >> 2, true); s_ += (nb >> 3))
#define FOR_TILES_XCD(MT, NT, mt, nt)                                                          \
  for (int s_ = (bid >> 3), mt = 0, nt = 0;                                                     \
       s_ < ((MT) >> 3) * (NT) && (mt = (bid & 7) + 8 * (s_ / (NT)), nt = s_ % (NT), true); s_ += (nb >> 3))
DI void run_phase(const Params& p, char* smem, int ph, bool dry) {
  int tid = threadIdx.x, bid = blockIdx.x;
  asm volatile("" : "+v"(tid));
  asm volatile("" : "+s"(bid));
  const int nb = gridDim.x;
#ifdef ONLY
  if (ph != ONLY) return;
#endif
  if (ph == 0) { phase_prologue(tid, bid, p, smem); return; }
  const int q = ph - 1, cyc = q / 10, rem = q % 10;
  const int li = cyc;
  if (rem < 6) {
    const int lyr = li;
    switch (rem) {
      case 0: {
        ALPlain al{p.xb(), LDX, 1 << 30, 0, 0};
        EPEvenIn ep{p.part(), p.proj(), p.sb_q_g + lyr * 128, p.sb_k_g + lyr * 128};
        const u16* Bt = p.WtEin() + (size_t)lyr * 5120 * LDK1;
        FOR_TILES_XCD4(256, 40, mt, nt) gemm_tile_dma(tid, smem, al, Bt, LDK1, 1024, mt * 256, nt * 128, ep, dry ? PROBE_VARIANT : 0);
      } break;
      case 1: {
        for (int it = bid; it < 4096; it += nb) {
          const int qb = 31 - (it >> 7), bh = it & 127;
          attn_item(tid, p, smem, bh >> 3, bh & 7, qb, dry);
        }
        asm volatile("" : "+v"(tid));
        for (int t = bid; t < 256; t += nb) {
          const int g = t >> 3, mt = t & 7;
          ALS5 al{p.proj(), p.hp(), g};
          EPS5P ep{p.Sc(), g};
          gemm_tile_dma(tid, smem, al, p.WtP() + ((size_t)lyr * 32 + g) * 128 * LDK5, LDK5, 512, mt * 256, 0, ep);
        }
      } break;
      case 2: {
        for (int idx = bid * 256 + tid; idx < 16 * 32 * 64; idx += nb * 256) {
          const int n = idx & 63, g = (idx >> 6) & 31, b = idx >> 11;
          const float lr = p.LT()[((lyr * 32 + g) * 64 + n) * 2], lim = p.LT()[((lyr * 32 + g) * 64 + n) * 2 + 1];
          float hr = 0.f, hi = 0.f;
          for (int c0 = 0; c0 < 128; c0 += 16) {
            float sr[16], si[16];
#pragma unroll
            for (int j = 0; j < 16; ++j) {
              const size_t o = ((size_t)(b * 128 + c0 + j) * 32 + g) * 128;
              sr[j] = p.Sc()[o + n]; si[j] = p.Sc()[o + 64 + n];
            }
#pragma unroll
            for (int j = 0; j < 16; ++j) {
              const size_t o = ((size_t)(b * 128 + c0 + j) * 32 + g) * 128;
              p.hp()[o + n] = f2bf(hr); p.hp()[o + 64 + n] = f2bf(hi);
              const float nr = lr * hr - lim * hi + sr[j], ni = lr * hi + lim * hr + si[j];
              hr = nr; hi = ni;
            }
          }
        }
      } break;
      case 3: {
        for (int t = bid; t < 1024; t += nb) {
          const int g = t >> 5, mt = (t >> 2) & 7, nt = t & 3;
          ALS5 al{p.proj(), p.hp(), g};
          EPS5Y ep{p.proj(), p.yb(), p.s5_d + lyr * 512, g};
          gemm_tile_dma(tid, smem, al, p.WtMQ() + ((size_t)lyr * 32 + g) * 512 * LDK6, LDK6, 640, mt * 256, nt * 128, ep);
        }
      } break;
      case 4: {
        ALPlain al{p.yb(), LDY, 1 << 30, 0, 0};
        EPGlu ep{p.proj(), p.yb(), p.b_glu + lyr * 512, dry};
        const u16* Bt = p.WtGlu() + (size_t)lyr * 512 * LDK5;
        FOR_TILES_XCD(256, 4, mt, nt) gemm_tile_dma(tid, smem, al, Bt, LDK5, 512, mt * 256, nt * 128, ep);
      } break;
      default: {
        ALPlain al{p.proj(), LDE, 1024, 3072, 3584};
        EPOut ep{cyc == 0 ? p.x : p.out, p.out, p.xb(), p.part(), dry};
        const u16* Bt = p.WtEout() + (size_t)lyr * 1024 * LDK15;
        FOR_TILES_XCD(256, 8, mt, nt) gemm_tile_dma(tid, smem, al, Bt, LDK15, 1536, mt * 256, nt * 128, ep);
      } break;
    }
  } else {
    const int lyr = li;
    switch (rem - 6) {
      case 0: {
        ALPlain al{p.xb(), LDX, 1 << 30, 0, 0};
        EPOddIn ep{p.part(), p.proj()};
        const u16* Bt = p.WtOin() + (size_t)lyr * 3200 * LDK1;
        FOR_TILES_XCD4(256, 25, mt, nt) gemm_tile_dma(tid, smem, al, Bt, LDK1, 1024, mt * 256, nt * 128, ep);
      } break;
      case 1: {
        if (!dry) for (int it = bid; it < 4096; it += nb) gla_g1(tid, p, smem, lyr, it >> 8, (it >> 2) & 63, it & 3);
      } break;
      case 2: {
        for (int it = bid; it < 512; it += nb) {
          const int xcd = it & 7, j = it >> 3, bh = xcd * 8 + (j >> 3), slc = j & 7;
          gla_item(tid, p, smem, lyr, bh >> 2, bh & 3, slc, dry);
        }
      } break;
      default: {
        ALGlaOut al{p.proj(), p.ssqg()};
        EPOut ep{p.out, p.out, p.xb(), p.part(), dry};
        const u16* Bt = p.WtOout() + (size_t)lyr * 1024 * LDK1;
        FOR_TILES_XCD(256, 8, mt, nt) gemm_tile(tid, smem, al, Bt, LDK1, 1024, mt * 256, nt * 128, ep);
      } break;
    }
  }
}


#define XB_TMO      128
#define XB_XCNT(j)  (256  + 64 * (j))
#define XB_XSUB(j)  (1280 + 64 * (j))
#define XB_XGEN(j)  (2304 + 64 * (j))
#define XB_TOP      3328
#define XB_TOPGEN   3392
#define XCD_BAR_WORDS 3456
#define XB_SPIN_CAP (1u << 18)
#define LAS __attribute__((address_space(3)))
DI unsigned xb_ld(unsigned* p) { return __hip_atomic_load(p, __ATOMIC_RELAXED, __HIP_MEMORY_SCOPE_AGENT); }
DI unsigned xb_add(unsigned* p, unsigned v) { return __hip_atomic_fetch_add(p, v, __ATOMIC_RELAXED, __HIP_MEMORY_SCOPE_AGENT); }
DI unsigned xb_xcc_id() { return (unsigned)__builtin_amdgcn_s_getreg((3 << 11) | 20) & 0xFu; }
#define XB_SPIN(cond, bar) do { unsigned _sp = 0; while (cond) { __builtin_amdgcn_s_sleep(1); \
    if ((++_sp & 255u) == 0u) { if (xb_ld(&(bar)[XB_TMO])) break; if (_sp > XB_SPIN_CAP) { atomicAdd(&(bar)[XB_TMO], 1u); break; } } } } while (0)
struct XcdBarrier { unsigned* bar; unsigned x; volatile LAS unsigned* st; };
DI XcdBarrier xcd_barrier_post(unsigned* bar, volatile LAS unsigned* st) {
  XcdBarrier b; b.bar = bar; b.x = xb_xcc_id(); b.st = st;
  if (threadIdx.x == 0) (void)xb_add(&bar[XB_XCNT(b.x)], 1u);
  return b;
}
DI void xcd_barrier_complete(unsigned* bar, unsigned x, unsigned& nloc, unsigned& nx) {
  const unsigned G = gridDim.x * gridDim.y * gridDim.z;
  unsigned sum, cnt, mine, sp = 0u;
  for (;;) {
    sum = 0u; cnt = 0u; mine = 0u;
#pragma unroll
    for (unsigned j = 0; j < 16; ++j) { const unsigned c = xb_ld(&bar[XB_XCNT(j)]); sum += c; cnt += (c > 0u) ? 1u : 0u; mine = (j == x) ? c : mine; }
    if (sum == G) break;
    __builtin_amdgcn_s_sleep(1);
    if ((++sp & 255u) == 0u) { if (xb_ld(&bar[XB_TMO])) break; if (sp > XB_SPIN_CAP) { atomicAdd(&bar[XB_TMO], 1u); break; } }
  }
  nloc = mine > 0u ? mine : 1u; nx = cnt > 0u ? cnt : 1u;
}
DI void xcd_barrier(const XcdBarrier& b) {
  asm volatile("s_waitcnt vmcnt(0)" ::: "memory");
  __syncthreads();
  if (threadIdx.x == 0) {
    unsigned* bar = b.bar;
    __builtin_amdgcn_s_waitcnt(0);
    unsigned nloc = b.st[0], nx = b.st[1];
    if (nloc == 0u) { xcd_barrier_complete(bar, b.x, nloc, nx); b.st[0] = nloc; b.st[1] = nx; }
    const unsigned old = xb_add(&bar[XB_XSUB(b.x)], 1u);
    const unsigned gen = old / nloc;
    if (old + 1u == (gen + 1u) * nloc) {
      __builtin_amdgcn_fence(__ATOMIC_RELEASE, "agent");
      asm volatile("s_waitcnt vmcnt(0)" ::: "memory");
      const unsigned og = xb_add(&bar[XB_TOP], 1u);
      const unsigned tg = og / nx;
      if (og + 1u == (tg + 1u) * nx) xb_add(&bar[XB_TOPGEN], 1u);
      else XB_SPIN(xb_ld(&bar[XB_TOPGEN]) == tg, bar);
      __builtin_amdgcn_fence(__ATOMIC_ACQUIRE, "agent");
      xb_add(&bar[XB_XGEN(b.x)], 1u);
      asm volatile("s_waitcnt vmcnt(0)" ::: "memory");
    } else {
      XB_SPIN(xb_ld(&bar[XB_XGEN(b.x)]) == gen, bar);
      __builtin_amdgcn_fence(__ATOMIC_ACQUIRE, "agent");
      asm volatile("s_waitcnt vmcnt(0)" ::: "memory");
    }
  }
  __syncthreads();
}

constexpr int NPHASE = 21;

#ifndef PROBE_MASK
#define PROBE_MASK 0
#endif
DI int phase_kind(int ph) { if (ph == 0) return 0; const int rem = (ph - 1) % 10; return 1 + rem; }

#ifndef PROBE_SEL
#define PROBE_SEL -1
#endif
__global__ void __launch_bounds__(256, 2) fwd_kernel(Params p, int ph_lo, int ph_hi, int probe_mask, int probe_sel) {
  __shared__ __attribute__((aligned(16))) char smem[SMEM_BYTES];
  __shared__ uint4 xb_words;
  if (threadIdx.x == 0) xb_words = make_uint4(0u, 0u, 0u, 0u);
  __syncthreads();
  (void)xcd_barrier_post((unsigned*)(p.ws + OFF_bar), (volatile LAS unsigned*)&xb_words);
  for (int ph = ph_lo; ph < ph_hi; ++ph) {
    if (ph > ph_lo) {
      XcdBarrier xb;
      unsigned* bar_ = (unsigned*)(p.ws + OFF_bar);
      asm volatile("" : "+s"(bar_));
      xb.bar = bar_; xb.x = xb_xcc_id(); xb.st = (volatile LAS unsigned*)&xb_words;
      xcd_barrier(xb);
    }
    if (probe_mask < 0) cg::this_grid().sync();
    run_phase(p, smem, ph, false);
  }
}

extern "C" void kernel_launch(void* const* d_in, const int* in_sizes, int n_in, void* d_out, int out_size, void* d_ws,
                              size_t ws_size, hipStream_t stream) {
  Params p{};
  const float** fp = (const float**)&p;
  for (int i = 0; i < 22; ++i) fp[i] = (const float*)d_in[i];
  p.out = (float*)d_out;
  p.ws = (char*)d_ws;
  if (WS_TOTAL > ws_size) { fprintf(stderr, "workspace too small: have %zu\n", ws_size); return; }

  static int grid_blocks = 0;
  if (!grid_blocks) {
    int dev = 0, cus = 0, per_cu = 0;
    hipGetDevice(&dev);
    hipDeviceGetAttribute(&cus, hipDeviceAttributeMultiprocessorCount, dev);
    hipOccupancyMaxActiveBlocksPerMultiprocessor(&per_cu, fwd_kernel, 256, 0);
    if (per_cu > 2) per_cu = 2;
    grid_blocks = cus * per_cu;
    if (grid_blocks <= 0) grid_blocks = 256;
  }
#if COOP
  hipMemsetAsync(p.ws + OFF_bar, 0, (size_t)XCD_BAR_WORDS * 4, stream);
  int lo = 0, hi = NPHASE, pm = PROBE_MASK, psel = PROBE_SEL;
  void* args[] = {&p, &lo, &hi, &pm, &psel};
  hipError_t e = hipLaunchCooperativeKernel((void*)fwd_kernel, dim3(grid_blocks), dim3(256), args, 0, stream);
  if (e != hipSuccess) fprintf(stderr, "cooperative launch failed: %s (grid %d)\n", hipGetErrorString(e), grid_blocks);
#else
  for (int ph = 0; ph < NPHASE; ++ph) hipLaunchKernelGGL(fwd_kernel, dim3(grid_blocks), dim3(256), 0, stream, p, ph, ph + 1, 0, -1);
#endif
}
```

```cpp
#include <hip/hip_runtime.h>
#include <hip/hip_cooperative_groups.h>
#include <cstdio>
namespace cg = cooperative_groups;

#ifndef COOP
#define COOP 1
#endif

#ifndef PROBE_VARIANT
#define PROBE_VARIANT 0
#endif
#define DI __device__ __forceinline__
typedef unsigned short u16;
typedef __attribute__((ext_vector_type(8))) short bf16x8;
typedef __attribute__((ext_vector_type(4))) short s16x4;
typedef __attribute__((ext_vector_type(16))) float f32x16;
typedef __attribute__((ext_vector_type(4))) float f32x4;
typedef __attribute__((ext_vector_type(2))) float f32x2;
typedef __attribute__((ext_vector_type(4))) unsigned u32x4;
typedef __attribute__((ext_vector_type(2))) unsigned u32x2;
typedef __bf16 bf2_t __attribute__((ext_vector_type(2)));
typedef __attribute__((address_space(3))) s16x4 lds_s16x4;

#define MFMA(a, b, c) __builtin_amdgcn_mfma_f32_32x32x16_bf16((a), (b), (c), 0, 0, 0)

constexpr int NTOK = 65536;
constexpr int SEQ = 4096;
constexpr int LDE = 5184;
constexpr int LDO = 3264;
constexpr int LDX = 1088;
constexpr int LDY = 576;
constexpr int LDK1 = 1088, LDK15 = 1600, LDK5 = 576, LDK6 = 704;
constexpr float EPS = 1e-6f;
constexpr int SMEM_BYTES = 77824;

constexpr size_t al256(size_t x) { return (x + 255) & ~(size_t)255; }
constexpr size_t OFF_WtEin = 0;
constexpr size_t OFF_WtEout = OFF_WtEin + al256((size_t)2 * 5120 * LDK1 * 2);
constexpr size_t OFF_WtGlu = OFF_WtEout + al256((size_t)2 * 1024 * LDK15 * 2);
constexpr size_t OFF_WtOin = OFF_WtGlu + al256((size_t)2 * 512 * LDK5 * 2);
constexpr size_t OFF_WtOout = OFF_WtOin + al256((size_t)2 * 3200 * LDK1 * 2);
constexpr size_t OFF_WgT = OFF_WtOout + al256((size_t)2 * 1024 * LDK1 * 2);
constexpr size_t OFF_WtMQ = OFF_WgT + al256((size_t)2 * 512 * 16 * 2);
constexpr size_t OFF_WtP = OFF_WtMQ + al256((size_t)2 * 32 * 512 * LDK6 * 2);
constexpr size_t OFF_LT = OFF_WtP + al256((size_t)2 * 32 * 128 * LDK5 * 2);
constexpr size_t OFF_xb = OFF_LT + al256((size_t)2 * 32 * 64 * 2 * 4);
constexpr size_t OFF_part = OFF_xb + al256((size_t)NTOK * LDX * 2);
constexpr size_t OFF_proj = OFF_part + al256((size_t)NTOK * 8 * 4);
constexpr size_t OFF_yb = OFF_proj + al256((size_t)NTOK * LDE * 2);
constexpr size_t OFF_Sc = OFF_yb + al256((size_t)NTOK * LDY * 2);
constexpr size_t OFF_hp = OFF_Sc + al256((size_t)2048 * 32 * 128 * 4);
constexpr size_t OFF_ssqg = OFF_hp + al256((size_t)2048 * 32 * 128 * 2);
constexpr size_t OFF_bar = OFF_ssqg + al256((size_t)NTOK * 32 * 4);
constexpr size_t WS_TOTAL = OFF_bar + al256((size_t)3456 * 4);

struct Params {
  const float *x, *even_norm_g, *even_w_in, *sb_q_g, *sb_k_g, *lam_re, *lam_im, *log_dt, *b_re, *b_im, *c_re, *c_im,
      *s5_d, *w_glu, *b_glu, *even_w_out, *odd_norm_g, *odd_w_in, *gla_w_gate, *gla_b_gate, *gla_o_g, *odd_w_out;
  float* out;
  char* ws;
  DI u16* WtEin() const { return (u16*)(ws + OFF_WtEin); }
  DI u16* WtEout() const { return (u16*)(ws + OFF_WtEout); }
  DI u16* WtGlu() const { return (u16*)(ws + OFF_WtGlu); }
  DI u16* WtOin() const { return (u16*)(ws + OFF_WtOin); }
  DI u16* WtOout() const { return (u16*)(ws + OFF_WtOout); }
  DI u16* WgT() const { return (u16*)(ws + OFF_WgT); }
  DI u16* WtMQ() const { return (u16*)(ws + OFF_WtMQ); }
  DI u16* WtP() const { return (u16*)(ws + OFF_WtP); }
  DI float* LT() const { return (float*)(ws + OFF_LT); }
  DI u16* xb() const { return (u16*)(ws + OFF_xb); }
  DI float* part() const { return (float*)(ws + OFF_part); }
  DI u16* proj() const { return (u16*)(ws + OFF_proj); }
  DI u16* yb() const { return (u16*)(ws + OFF_yb); }
  DI float* Sc() const { return (float*)(ws + OFF_Sc); }
  DI u16* hp() const { return (u16*)(ws + OFF_hp); }
  DI float* ssqg() const { return (float*)(ws + OFF_ssqg); }
};

DI unsigned pk2(float a, float b) { f32x2 v = {a, b}; return __builtin_bit_cast(unsigned, __builtin_convertvector(v, bf2_t)); }
DI u16 f2bf(float a) { return (u16)(pk2(a, 0.f) & 0xffffu); }
DI float bflo(unsigned u) { return __uint_as_float(u << 16); }
DI float bfhi(unsigned u) { return __uint_as_float(u & 0xffff0000u); }
DI int crow(int i, int h) { return (i & 3) + 8 * (i >> 2) + 4 * h; }
DI float fexp2(float x) { return __builtin_amdgcn_exp2f(x); }
DI float flog2(float x) { return __builtin_amdgcn_logf(x); }
DI float frcp(float x) { return __builtin_amdgcn_rcpf(x); }
DI float fexp(float x) { return fexp2(x * 1.44269504088896f); }
DI float sigmoidf_(float x) { return frcp(1.f + fexp(-x)); }
DI float siluf_(float x) { return x * sigmoidf_(x); }
DI unsigned off_b(unsigned row, unsigned ch) { return 256u * row + 16u * (ch ^ (((row & 3) << 2) | ((row >> 2) & 3))); }
DI unsigned off_g(unsigned row, unsigned ch) { return 128u * row + 16u * (ch ^ ((row >> 1) & 7)); }
DI s16x4 tr_read(const char* p) { return __builtin_amdgcn_ds_read_tr16_b64_v4i16((lds_s16x4*)p); }
DI bf16x8 cat4(s16x4 lo, s16x4 hi) { return __builtin_shufflevector(lo, hi, 0, 1, 2, 3, 4, 5, 6, 7); }
DI f32x16 zero16() { f32x16 z;
#pragma unroll
  for (int i = 0; i < 16; ++i) z[i] = 0.f; return z; }
DI bf16x8 pack8(const float* f) {
  u32x4 r; r[0] = pk2(f[0], f[1]); r[1] = pk2(f[2], f[3]); r[2] = pk2(f[4], f[5]); r[3] = pk2(f[6], f[7]);
  return __builtin_bit_cast(bf16x8, r);
}
DI void unpack8(bf16x8 v, float* f) {
  u32x4 r = __builtin_bit_cast(u32x4, v);
#pragma unroll
  for (int i = 0; i < 4; ++i) { f[2 * i] = bflo(r[i]); f[2 * i + 1] = bfhi(r[i]); }
}
DI bf16x8 ldg8(const u16* p) { return *(const bf16x8*)p; }
template <int CTRL> DI float dpp_mov(float v) {
  return __int_as_float(__builtin_amdgcn_update_dpp(0, __float_as_int(v), CTRL, 0xF, 0xF, true));
}
DI float red16(float v) {
  v += dpp_mov<0xB1>(v);
  v += dpp_mov<0x4E>(v);
  v += dpp_mov<0x141>(v);
  v += dpp_mov<0x140>(v);
  return v;
}
DI void wave_lds_fence() { __builtin_amdgcn_fence(__ATOMIC_RELEASE, "wavefront"); __builtin_amdgcn_wave_barrier(); __builtin_amdgcn_fence(__ATOMIC_ACQUIRE, "wavefront"); }

DI float row_rstd(const float* part, int row) {
  const f32x4* p = (const f32x4*)(part + (size_t)row * 8);
  f32x4 a = p[0], b = p[1];
  float s = a[0] + a[1] + a[2] + a[3] + b[0] + b[1] + b[2] + b[3];
  return __builtin_amdgcn_rsqf(s * (1.f / 1024.f) + EPS);
}

template <class AL, class EP>
DI void gemm_tile(int tid, char* smem, const AL& al, const u16* __restrict__ Bt, int ldb, int K, int row0, int col0, const EP& ep) {
  const int w = tid >> 6, l = tid & 63, r = l & 31, h = l >> 5;
  char* As = smem;
  char* Bs = smem + 32768;
  f32x16 acc[2][4];
#pragma unroll
  for (int mi = 0; mi < 2; ++mi)
#pragma unroll
    for (int ni = 0; ni < 4; ++ni) acc[mi][ni] = zero16();
  const int lrow = tid >> 3, lch = tid & 7;
  bf16x8 ra[8], rb[4];
  const unsigned boff = ((unsigned)(col0 + lrow) * (unsigned)ldb + lch * 8) * 2u;
  const unsigned bstep = 64u * (unsigned)ldb;
  auto gload = [&](int k0) {
    const char* ab = al.base(k0);
    unsigned ao = al.off(row0 + lrow, k0 + lch * 8);
    unsigned st = al.step32(k0), bs = bstep, bo = boff + 2u * k0;
    asm volatile("" : "+s"(st), "+s"(bs));
    asm volatile("" : "+v"(ao), "+v"(bo));
#pragma unroll
    for (int i = 0; i < 8; ++i) ra[i] = *(const bf16x8*)(ab + (ao + i * st));
#pragma unroll
    for (int i = 0; i < 4; ++i) rb[i] = *(const bf16x8*)((const char*)Bt + (bo + i * bs));
  };
  const unsigned wbase = off_g(lrow, lch);
  unsigned xo[4];
#pragma unroll
  for (int s = 0; s < 4; ++s) xo[s] = 16u * ((2 * s + h) ^ ((r >> 1) & 7));
  const unsigned abase = 128u * (64 * w + r), bbase = 32768u + 128u * r;
  gload(0);
  for (int k0 = 0; k0 < K; k0 += 64) {
    if constexpr (AL::kRowScale) {
      float* rsl = (float*)(smem + 49152);
      if ((k0 & 255) == 0) {
        rsl[tid] = al.rowscale(row0 + tid, k0 >> 8);
        __syncthreads();
      }
#pragma unroll
      for (int i = 0; i < 8; ++i) {
        const float sc = rsl[lrow + 32 * i];
        float f[8]; unpack8(ra[i], f);
#pragma unroll
        for (int j = 0; j < 8; ++j) f[j] *= sc;
        ra[i] = pack8(f);
      }
    }
#pragma unroll
    for (int i = 0; i < 8; ++i) *(bf16x8*)(As + wbase + 4096 * i) = ra[i];
#pragma unroll
    for (int i = 0; i < 4; ++i) *(bf16x8*)(Bs + wbase + 4096 * i) = rb[i];
    __syncthreads();
    if (k0 + 64 < K) gload(k0 + 64);
#pragma unroll
    for (int s = 0; s < 4; ++s) {
      bf16x8 a[2], b[4];
#pragma unroll
      for (int mi = 0; mi < 2; ++mi) a[mi] = *(const bf16x8*)(smem + abase + 4096 * mi + xo[s]);
#pragma unroll
      for (int ni = 0; ni < 4; ++ni) b[ni] = *(const bf16x8*)(smem + bbase + 4096 * ni + xo[s]);
#pragma unroll
      for (int mi = 0; mi < 2; ++mi)
#pragma unroll
        for (int ni = 0; ni < 4; ++ni) acc[mi][ni] = MFMA(a[mi], b[ni], acc[mi][ni]);
      __builtin_amdgcn_sched_barrier(0);
    }
    __syncthreads();
  }
  float* stg = (float*)(smem + w * 16896);
#pragma unroll
  for (int mi = 0; mi < 2; ++mi) {
#pragma unroll
    for (int ni = 0; ni < 4; ++ni)
#pragma unroll
      for (int i = 0; i < 16; ++i) stg[crow(i, h) * 132 + 32 * ni + r] = acc[mi][ni][i];
    wave_lds_fence();
#pragma unroll
    for (int ps = 0; ps < 8; ++ps) {
      const int rr = 4 * ps + (l >> 4), cc = (l & 15) * 8;
      float v[8];
      f32x4 v0 = *(const f32x4*)(stg + rr * 132 + cc), v1 = *(const f32x4*)(stg + rr * 132 + cc + 4);
#pragma unroll
      for (int j = 0; j < 4; ++j) { v[j] = v0[j]; v[4 + j] = v1[j]; }
      ep(row0 + 64 * w + 32 * mi + rr, col0 + cc, v, l, 1.f);
    }
    wave_lds_fence();
  }
  __syncthreads();
}

#define WAIT_V(n) asm volatile("s_waitcnt vmcnt(%0)" ::"n"(n) : "memory")
#define RAW_BARRIER() do { asm volatile("s_waitcnt lgkmcnt(0)" ::: "memory"); __builtin_amdgcn_s_barrier(); } while (0)
template <class AL, class EP>
DI void gemm_tile_dma(int tid, char* smem, const AL& al, const u16* __restrict__ Bt, int ldb, int K, int row0, int col0, const EP& ep, int variant = 0) {
  typedef __attribute__((ext_vector_type(4))) float f32x4v;
  const int w = tid >> 6, l = tid & 63, r16 = l & 15, q4 = l >> 4;
  f32x4v acc[4][8];
#pragma unroll
  for (int mi = 0; mi < 4; ++mi)
#pragma unroll
    for (int ni = 0; ni < 8; ++ni) { acc[mi][ni][0] = 0.f; acc[mi][ni][1] = 0.f; acc[mi][ni][2] = 0.f; acc[mi][ni][3] = 0.f; }
  auto Gf = [](int x) -> int { return (0x78 >> (2 * x)) & 3; };
  const int lch = (l & 3) ^ Gf((l >> 4) & 3);
  const unsigned boff = ((unsigned)(col0 + 32 * w + (l >> 2)) * (unsigned)ldb + lch * 8) * 2u;
  const unsigned bstep = 32u * (unsigned)ldb;
  auto stage = [&](int buf, int kt) {
    const int k0 = kt * 32;
    const char* ab = al.base(k0);
    unsigned ao = al.off(row0 + 64 * w + (l >> 2), k0 + lch * 8);
    unsigned st = al.step32(k0) >> 1, bs = bstep, bo = boff + 2u * k0;
    asm volatile("" : "+s"(st), "+s"(bs));
    asm volatile("" : "+v"(ao), "+v"(bo));
    char* sa = smem + buf * 24576 + w * 4096;
    char* sb = smem + buf * 24576 + 16384 + w * 2048;
#pragma unroll
    for (int i = 0; i < 4; ++i)
      __builtin_amdgcn_global_load_lds((const unsigned*)(ab + (ao + i * st)), (unsigned*)(sa + i * 1024), 16, 0, 0);
#pragma unroll
    for (int i = 0; i < 2; ++i)
      __builtin_amdgcn_global_load_lds((const unsigned*)((const char*)Bt + (bo + i * bs)), (unsigned*)(sb + i * 1024), 16, 0, 0);
  };
  const unsigned xo = 16u * (unsigned)(q4 ^ Gf((r16 >> 2) & 3));
  const unsigned fbase = 64u * r16 + xo;
  const unsigned wofs = 4096u * (unsigned)__builtin_amdgcn_readfirstlane(w);
  const int nt = K >> 5;
  float* rtab = (float*)(smem + 73728);
  if constexpr (EP::kRstd) rtab[tid] = row_rstd(ep.part, row0 + tid);
  stage(0, 0);
  stage(1, 1);
  WAIT_V(6);
  RAW_BARRIER();
  bf16x8 xa[4], xb[4], ya[4], yb[4];
  auto rdA = [&](bf16x8 (&fa)[4], unsigned bufoff) {
#pragma unroll
    for (int mi = 0; mi < 4; ++mi) fa[mi] = *(const bf16x8*)(smem + (bufoff + wofs + 1024u * mi) + fbase);
  };
  auto rdB = [&](bf16x8 (&fb)[4], unsigned bufoff, int hf) {
#pragma unroll
    for (int ni = 0; ni < 4; ++ni) fb[ni] = *(const bf16x8*)(smem + (bufoff + 16384u + 1024u * (4 * hf + ni)) + fbase);
  };
  int cur = 0;
  auto slice = [&](int t, bf16x8 (&fa)[4], bf16x8 (&fb0)[4], bf16x8 (&fan)[4], bf16x8 (&fb0n)[4]) {
    const int nxt = (cur == 2) ? 0 : cur + 1, nn = (nxt == 2) ? 0 : nxt + 1;
    bf16x8 fb1[4];
    stage(nn, t + 2 < nt ? t + 2 : nt - 1);
    __builtin_amdgcn_sched_barrier(0);
    rdB(fb1, (unsigned)cur * 24576u, 1);
    __builtin_amdgcn_sched_barrier(0);
#pragma unroll
    for (int ni = 0; ni < 4; ++ni)
#pragma unroll
      for (int mi = 0; mi < 4; ++mi) acc[mi][ni] = __builtin_amdgcn_mfma_f32_16x16x32_bf16(fa[mi], fb0[ni], acc[mi][ni], 0, 0, 0);
    __builtin_amdgcn_sched_barrier(0);
    WAIT_V(6);
    RAW_BARRIER();
    rdB(fb0n, (unsigned)nxt * 24576u, 0);
    __builtin_amdgcn_sched_barrier(0);
#pragma unroll
    for (int ni = 0; ni < 2; ++ni)
#pragma unroll
      for (int mi = 0; mi < 4; ++mi) acc[mi][4 + ni] = __builtin_amdgcn_mfma_f32_16x16x32_bf16(fa[mi], fb1[ni], acc[mi][4 + ni], 0, 0, 0);
    __builtin_amdgcn_sched_barrier(0);
    rdA(fan, (unsigned)nxt * 24576u);
    __builtin_amdgcn_sched_barrier(0);
#pragma unroll
    for (int ni = 2; ni < 4; ++ni)
#pragma unroll
      for (int mi = 0; mi < 4; ++mi) acc[mi][4 + ni] = __builtin_amdgcn_mfma_f32_16x16x32_bf16(fa[mi], fb1[ni], acc[mi][4 + ni], 0, 0, 0);
    __builtin_amdgcn_sched_barrier(0);
    cur = nxt;
  };
  rdA(xa, 0u);
  rdB(xb, 0u, 0);
  for (int t = 0; t < nt; t += 2) {
    slice(t, xa, xb, ya, yb);
    slice(t + 1, ya, yb, xa, xb);
  }
  WAIT_V(0);
  RAW_BARRIER();
  float* stg = (float*)(smem + w * 16896);
  EP e = ep;
  e.begin(col0 + (l & 15) * 8);
#pragma unroll
  for (int hm = 0; hm < 2; ++hm) {
#pragma unroll
    for (int m2 = 0; m2 < 2; ++m2)
#pragma unroll
      for (int ni = 0; ni < 8; ++ni)
#pragma unroll
        for (int i = 0; i < 4; ++i) stg[(16 * m2 + 4 * q4 + i) * 132 + 16 * ni + r16] = acc[2 * hm + m2][ni][i];
    wave_lds_fence();
#pragma unroll
    for (int ps = 0; ps < 8; ++ps) {
      const int rr = 4 * ps + (l >> 4), cc = (l & 15) * 8;
      float v[8];
      f32x4 v0 = *(const f32x4*)(stg + rr * 132 + cc), v1 = *(const f32x4*)(stg + rr * 132 + cc + 4);
#pragma unroll
      for (int jj = 0; jj < 4; ++jj) { v[jj] = v0[jj]; v[4 + jj] = v1[jj]; }
      float rs = 1.f;
      if constexpr (EP::kRstd) rs = rtab[64 * w + 32 * hm + rr];
      e(row0 + 64 * w + 32 * hm + rr, col0 + cc, v, l, rs);
    }
    wave_lds_fence();
  }
  __syncthreads();
}

struct ALPlain {
  static constexpr bool kRowScale = false;
  const u16* base_; int ld; int kseg; int off0; int off1;
  DI const char* base(int) const { return (const char*)base_; }
  DI unsigned off(int row, int k) const { return ((unsigned)row * (unsigned)ld + k + (k < kseg ? off0 : off1)) * 2u; }
  DI unsigned step32(int) const { return 64u * (unsigned)ld; }
  DI float rowscale(int, int) const { return 1.f; }
};
struct ALGlaOut {
  static constexpr bool kRowScale = true;
  const u16* base_; const float* ssq;
  DI const char* base(int) const { return (const char*)base_; }
  DI unsigned off(int row, int k) const { return ((unsigned)row * LDO + 1024 + k) * 2u; }
  DI unsigned step32(int) const { return 64u * LDO; }
  DI float rowscale(int row, int hd) const {
    const f32x4* p = (const f32x4*)(ssq + (size_t)row * 32 + hd * 8);
    f32x4 a = p[0], b = p[1];
    float s = a[0] + a[1] + a[2] + a[3] + b[0] + b[1] + b[2] + b[3];
    return __builtin_amdgcn_rsqf(s * (1.f / 256.f) + EPS);
  }
};
struct ALS5 {
  static constexpr bool kRowScale = false;
  const u16* proj; const u16* hp; int g;
  DI const char* base(int k0) const { return (const char*)(k0 < 512 ? proj : hp); }
  DI unsigned off(int row, int k) const {
    if (k < 512) return ((unsigned)(row * 32 + (k >> 4)) * LDE + 4096 + g * 16 + (k & 15)) * 2u;
    return (((unsigned)row * 32 + g) * 128 + (k - 512)) * 2u;
  }
  DI unsigned step32(int k) const { return k < 512 ? 2u * 32 * 32 * LDE : 2u * 32 * 32 * 128; }
  DI float rowscale(int, int) const { return 1.f; }
};

struct EPEvenIn {
  static constexpr bool kRstd = true;
  const float* part; u16* proj; const float* qg; const float* kg;
  float gsc[8];
  DI void begin(int col) {
    const float* g = (col < 1024 ? qg : kg) + (col & 127);
    const float sc = (col < 1024 ? 0.08838834764831845f * 1.44269504088896f : 1.f);
#pragma unroll
    for (int j = 0; j < 8; ++j) gsc[j] = (col < 2048) ? sc * g[j] : 1.f;
  }
  DI void operator()(int row, int col, float* v, int, float rs) const {
#pragma unroll
    for (int j = 0; j < 8; ++j) v[j] *= rs;
    if (col < 2048) {
      float s = 0.f;
#pragma unroll
      for (int j = 0; j < 8; ++j) s += v[j] * v[j];
      s = red16(s);
      const float rn = __builtin_amdgcn_rsqf(s * (1.f / 128.f) + EPS);
#pragma unroll
      for (int j = 0; j < 8; ++j) v[j] *= rn * gsc[j];
    }
    *(bf16x8*)((char*)proj + ((unsigned)row * LDE + col) * 2u) = pack8(v);
  }
};
struct EPOddIn {
  static constexpr bool kRstd = true;
  const float* part; u16* proj;
  DI void begin(int) {}
  DI void operator()(int row, int col, float* v, int, float rs) const {
#pragma unroll
    for (int j = 0; j < 8; ++j) v[j] *= rs;
    *(bf16x8*)((char*)proj + ((unsigned)row * LDO + col) * 2u) = pack8(v);
  }
};
struct EPOut {
  static constexpr bool kRstd = false;
  const float* xin; float* xout; u16* xb; float* part; bool dry;
  DI void begin(int) {}
  DI void operator()(int row, int col, float* v, int lane, float) const {
    const f32x4* xi = (const f32x4*)(xin + (size_t)row * 1024 + col);
    f32x4 a = xi[0], b = xi[1];
#pragma unroll
    for (int j = 0; j < 4; ++j) { v[j] += a[j]; v[4 + j] += b[j]; }
    if (dry) return;
    f32x4* xo = (f32x4*)(xout + (size_t)row * 1024 + col);
    f32x4 o0 = {v[0], v[1], v[2], v[3]}, o1 = {v[4], v[5], v[6], v[7]};
    xo[0] = o0; xo[1] = o1;
    *(bf16x8*)(xb + (size_t)row * LDX + col) = pack8(v);
    float s = 0.f;
#pragma unroll
    for (int j = 0; j < 8; ++j) s += v[j] * v[j];
    s = red16(s);
    if ((lane & 15) == 0) part[(size_t)row * 8 + (col >> 7)] = s;
  }
};
struct EPS5P {
  static constexpr bool kRstd = false;
  float* Sc; int g;
  DI void begin(int) {}
  DI void operator()(int row, int col, float* v, int, float) const {
    f32x4* o = (f32x4*)(Sc + ((size_t)row * 32 + g) * 128 + col);
    f32x4 o0 = {v[0], v[1], v[2], v[3]}, o1 = {v[4], v[5], v[6], v[7]};
    o[0] = o0; o[1] = o1;
  }
};
DI float gelu_tanh(float y) {
  const float u = 0.7978845608028654f * (y + 0.044715f * y * y * y);
  const float t = 1.f - 2.f * frcp(1.f + fexp(2.f * u));
  return 0.5f * y * (1.f + t);
}
struct EPS5Y {
  static constexpr bool kRstd = false;
  const u16* proj; u16* yb; const float* dsk; int g;
  DI void begin(int) {}
  DI void operator()(int row, int col, float* v, int, float) const {
    const int tok = row * 32 + (col >> 4), ch = g * 16 + (col & 15);
    float u[8]; unpack8(ldg8(proj + (size_t)tok * LDE + 4096 + ch), u);
#pragma unroll
    for (int j = 0; j < 8; ++j) v[j] = gelu_tanh(v[j] + dsk[ch + j] * u[j]);
    *(bf16x8*)(yb + (size_t)tok * LDY + ch) = pack8(v);
  }
};
struct EPGlu {
  static constexpr bool kRstd = false;
  u16* proj; const u16* yb; const float* bg; bool dry;
  DI void begin(int) {}
  DI void operator()(int row, int col, float* v, int, float) const {
    float y[8], z[8];
    unpack8(ldg8(yb + (size_t)row * LDY + col), y);
    u16* zp = proj + (size_t)row * LDE + 4608 + col;
    unpack8(ldg8(zp), z);
#pragma unroll
    for (int j = 0; j < 8; ++j) v[j] = y[j] * sigmoidf_(v[j] + bg[col + j]) * siluf_(z[j]);
    if (!dry) *(bf16x8*)zp = pack8(v);
  }
};

DI void transpose_tile(int tid, char* smem, const float* __restrict__ src, u16* __restrict__ dst, int K, int N, int ldk, int kt, int nt,
                       const float* scale, int smask) {
  float* t = (float*)smem;
  const int k0 = kt * 64, n0 = nt * 64;
#pragma unroll
  for (int i = 0; i < 16; ++i) {
    const int kk = (tid >> 6) + 4 * i, nn = tid & 63;
    float v = 0.f;
    if (n0 + nn < N) v = src[(size_t)(k0 + kk) * N + n0 + nn] * (scale ? scale[(k0 + kk) & smask] : 1.f);
    t[kk * 65 + nn] = v;
  }
  __syncthreads();
#pragma unroll
  for (int i = 0; i < 2; ++i) {
    const int c = tid + 256 * i;
    const int nn = c >> 3, k8 = (c & 7) * 8;
    float f[8];
#pragma unroll
    for (int j = 0; j < 8; ++j) f[j] = t[(k8 + j) * 65 + nn];
    *(bf16x8*)(dst + (size_t)(n0 + nn) * ldk + k0 + k8) = pack8(f);
  }
  __syncthreads();
}

DI void s5_setup(int tid, const Params& p, char* smem, int lg) {
  float* pw_re = (float*)smem;
  float* pw_im = pw_re + 33 * 64;
  float* bb_re = pw_im + 33 * 64;
  float* bb_im = bb_re + 1024;
  float* cc_re = bb_im + 1024;
  float* cc_im = cc_re + 1024;
  float* f_re = cc_im + 1024;
  float* f_im = f_re + 64;
  float* Kt = f_im + 64;
  if (tid < 64) {
    const float lr = p.lam_re[lg * 64 + tid], li = p.lam_im[lg * 64 + tid];
    const float dt = expf(p.log_dt[lg]);
    const float mag = expf(lr * dt);
    float sn, cs; sincosf(li * dt, &sn, &cs);
    const float br = mag * cs, bi = mag * sn;
    float pr = 1.f, pi = 0.f;
    for (int t = 0; t <= 32; ++t) {
      pw_re[t * 64 + tid] = pr; pw_im[t * 64 + tid] = pi;
      const float nr = pr * br - pi * bi, ni = pr * bi + pi * br;
      pr = nr; pi = ni;
    }
    p.LT()[(lg * 64 + tid) * 2] = pw_re[32 * 64 + tid];
    p.LT()[(lg * 64 + tid) * 2 + 1] = pw_im[32 * 64 + tid];
    const float nr = br - 1.f, ni = bi, den = 1.f / (lr * lr + li * li);
    f_re[tid] = (nr * lr + ni * li) * den;
    f_im[tid] = (ni * lr - nr * li) * den;
  }
  __syncthreads();
  for (int e = tid; e < 1024; e += 256) {
    const int n = e >> 4;
    const float br = p.b_re[(size_t)lg * 1024 + e], bi = p.b_im[(size_t)lg * 1024 + e];
    bb_re[e] = f_re[n] * br - f_im[n] * bi;
    bb_im[e] = f_re[n] * bi + f_im[n] * br;
    cc_re[e] = p.c_re[(size_t)lg * 1024 + e];
    cc_im[e] = p.c_im[(size_t)lg * 1024 + e];
  }
  __syncthreads();
  {
    const int pp = tid >> 4, pq = tid & 15;
    for (int t = 0; t < 32; ++t) {
      float s = 0.f;
      for (int n = 0; n < 64; ++n) {
        const float cr = cc_re[pp * 64 + n], ci = cc_im[pp * 64 + n];
        const float wr = pw_re[t * 64 + n], wi = pw_im[t * 64 + n];
        const float xr = cr * wr - ci * wi, xi = cr * wi + ci * wr;
        s += xr * bb_re[n * 16 + pq] - xi * bb_im[n * 16 + pq];
      }
      Kt[t * 256 + tid] = s;
    }
  }
  __syncthreads();
  u16* mq = p.WtMQ() + (size_t)lg * 512 * LDK6;
  for (int c = tid; c < 512 * 80; c += 256) {
    const int no = c / 80, k8 = (c % 80) * 8;
    const int t = no >> 4, pp = no & 15;
    float f[8];
    if (k8 < 512) {
      const int s = k8 >> 4, q0 = k8 & 15;
#pragma unroll
      for (int j = 0; j < 8; ++j) f[j] = (s <= t) ? Kt[(t - s) * 256 + pp * 16 + q0 + j] : 0.f;
    } else if (k8 < 576) {
      const int n0 = k8 - 512;
#pragma unroll
      for (int j = 0; j < 8; ++j) {
        const int n = n0 + j;
        f[j] = cc_re[pp * 64 + n] * pw_re[(t + 1) * 64 + n] - cc_im[pp * 64 + n] * pw_im[(t + 1) * 64 + n];
      }
    } else {
      const int n0 = k8 - 576;
#pragma unroll
      for (int j = 0; j < 8; ++j) {
        const int n = n0 + j;
        f[j] = -(cc_re[pp * 64 + n] * pw_im[(t + 1) * 64 + n] + cc_im[pp * 64 + n] * pw_re[(t + 1) * 64 + n]);
      }
    }
    *(bf16x8*)(mq + (size_t)no * LDK6 + k8) = pack8(f);
  }
  u16* wp = p.WtP() + (size_t)lg * 128 * LDK5;
  for (int c = tid; c < 128 * 64; c += 256) {
    const int nn = c >> 6, k8 = (c & 63) * 8;
    const int n = nn & 63, s = k8 >> 4, q0 = k8 & 15;
    const float wr = pw_re[(31 - s) * 64 + n], wi = pw_im[(31 - s) * 64 + n];
    float f[8];
#pragma unroll
    for (int j = 0; j < 8; ++j) {
      const float br = bb_re[n * 16 + q0 + j], bi = bb_im[n * 16 + q0 + j];
      f[j] = (nn < 64) ? (wr * br - wi * bi) : (wr * bi + wi * br);
    }
    *(bf16x8*)(wp + (size_t)nn * LDK5 + k8) = pack8(f);
  }
  __syncthreads();
}

DI void phase_prologue(int tid, int bid, const Params& p, char* smem) {
  const int nb = gridDim.x;
  const bool s5blk = (nb >= 128) && (bid >= nb - 64);
  if (nb >= 128) { if (s5blk) s5_setup(tid, p, smem, bid - (nb - 64)); }
  else for (int it = bid; it < 64; it += nb) s5_setup(tid, p, smem, it);
  const int nbw = (nb >= 128) ? nb - 64 : nb;
  if (s5blk) return;
  for (int lyr = 0; lyr < 2; ++lyr) {
    struct TJ { const float* src; u16* dst; int K, N, Npad, ldk; const float* sc; int smask; };
    const TJ jobs[5] = {
        {p.even_w_in + (size_t)lyr * 1024 * 5120, p.WtEin() + (size_t)lyr * 5120 * LDK1, 1024, 5120, 5120, LDK1, p.even_norm_g + lyr * 1024, 1023},
        {p.even_w_out + (size_t)lyr * 1536 * 1024, p.WtEout() + (size_t)lyr * 1024 * LDK15, 1536, 1024, 1024, LDK15, nullptr, 0},
        {p.w_glu + (size_t)lyr * 512 * 512, p.WtGlu() + (size_t)lyr * 512 * LDK5, 512, 512, 512, LDK5, nullptr, 0},
        {p.odd_w_in + (size_t)lyr * 1024 * 3088, p.WtOin() + (size_t)lyr * 3200 * LDK1, 1024, 3088, 3200, LDK1, p.odd_norm_g + lyr * 1024, 1023},
        {p.odd_w_out + (size_t)lyr * 1024 * 1024, p.WtOout() + (size_t)lyr * 1024 * LDK1, 1024, 1024, 1024, LDK1, p.gla_o_g + lyr * 256, 255}};
#pragma unroll
    for (int j = 0; j < 5; ++j) {
      const int nkt = jobs[j].K / 64, nnt = jobs[j].Npad / 64;
      for (int t = bid; t < nkt * nnt; t += nbw)
        transpose_tile(tid, smem, jobs[j].src, jobs[j].dst, jobs[j].K, jobs[j].N, jobs[j].ldk, t % nkt, t / nkt, jobs[j].sc, jobs[j].smask);
    }
    for (int e = bid * 256 + tid; e < 512 * 16; e += nbw * 256) {
      const int c = e >> 4, k = e & 15;
      p.WgT()[(size_t)lyr * 8192 + e] = f2bf(p.gla_w_gate[(size_t)lyr * 8192 + k * 512 + c]);
    }
  }
  const int w = tid >> 6, l = tid & 63;
  for (int row0 = (bid * 4 + w) * 4; row0 < NTOK; row0 += nbw * 16) {
    f32x4 va[4][4];
#pragma unroll
    for (int rr = 0; rr < 4; ++rr) {
      const f32x4* xr = (const f32x4*)(p.x + (size_t)(row0 + rr) * 1024);
#pragma unroll
      for (int i = 0; i < 2; ++i) { va[rr][2 * i] = xr[(l + 64 * i) * 2]; va[rr][2 * i + 1] = xr[(l + 64 * i) * 2 + 1]; }
    }
#pragma unroll
    for (int rr = 0; rr < 4; ++rr) {
      float s = 0.f;
#pragma unroll
      for (int i = 0; i < 2; ++i) {
        f32x4 a = va[rr][2 * i], b = va[rr][2 * i + 1];
        float f[8] = {a[0], a[1], a[2], a[3], b[0], b[1], b[2], b[3]};
#pragma unroll
        for (int j = 0; j < 8; ++j) s += f[j] * f[j];
        *(bf16x8*)(p.xb() + (size_t)(row0 + rr) * LDX + (l + 64 * i) * 8) = pack8(f);
      }
#pragma unroll
      for (int m = 1; m < 64; m <<= 1) s += __shfl_xor(s, m);
      if (l < 8) p.part()[(size_t)(row0 + rr) * 8 + l] = (l == 0) ? s : 0.f;
    }
  }
}

DI void attn_item(int tid, const Params& p, char* smem, int b, int hh, int qb, bool dry) {
  const int w = tid >> 6, l = tid & 63, r = l & 31, h = l >> 5;
  char* Ks = smem;
  char* Vs = smem + 16384;
  char* Qs = smem + 32768 + w * 8192;
  float* flags = (float*)(smem + 65536);
  float* stg = (float*)(smem + w * 8704);
  const u16* base = p.proj() + (size_t)b * SEQ * LDE;
  const int q0 = qb * 128, qw0 = q0 + 32 * w;
  {
    const u16* qp = base + (size_t)(qw0 + r) * LDE + hh * 128 + 8 * h;
#pragma unroll
    for (int s = 0; s < 8; ++s) *(bf16x8*)(Qs + off_b(r, 2 * s + h)) = ldg8(qp + 16 * s);
  }
  f32x16 ot[4];
#pragma unroll
  for (int d = 0; d < 4; ++d) ot[d] = zero16();
  float carry = 1.f, wmax = 1.f;
  const int lrow = tid >> 4, lch = tid & 15;
  bf16x8 rk[4], rv[4];
  auto gload = [&](int jt) {
    const u16* kp = base + (size_t)(jt * 64 + lrow) * LDE + 1024 + hh * 128 + lch * 8;
#pragma unroll
    for (int i = 0; i < 4; ++i) { rk[i] = ldg8(kp + (size_t)(16 * i) * LDE); rv[i] = ldg8(kp + (size_t)(16 * i) * LDE + 1024); }
  };
  const int trq = (l & 15) >> 2, trp = l & 3, trblk = (l >> 4) & 1;
  const unsigned fr = ((r & 3) << 2) | ((r >> 2) & 3);
  unsigned xs[8];
#pragma unroll
  for (int s = 0; s < 8; ++s) xs[s] = 16u * ((2 * s + h) ^ fr);
  const char* kbase = Ks + 256 * r;
  const char* qbase = Qs + 256 * r;
  const unsigned fv = (trq << 2) | h;
  unsigned vo[4];
#pragma unroll
  for (int d = 0; d < 4; ++d) vo[d] = 16u * ((4 * d + 2 * trblk + (trp >> 1)) ^ fv) + 8u * (trp & 1);
  const char* vbase = Vs + 256 * (4 * h + trq);
  int jt = 2 * qb + 1;
  gload(jt);
  for (; jt >= 0; --jt) {
#pragma unroll
    for (int i = 0; i < 4; ++i) {
      *(bf16x8*)(Ks + off_b(lrow + 16 * i, lch)) = rk[i];
      *(bf16x8*)(Vs + off_b(lrow + 16 * i, lch)) = rv[i];
    }
    RAW_BARRIER();
    if (jt > 0) gload(jt - 1);
    const int k0 = jt * 64;
    if (k0 <= qw0 && wmax >= 1e-30f) {
      f32x16 st[2];
      st[0] = zero16(); st[1] = zero16();
#pragma unroll
      for (int s = 0; s < 8; ++s) {
        const bf16x8 qf = *(const bf16x8*)(qbase + xs[s]);
#pragma unroll
        for (int kt = 0; kt < 2; ++kt) {
          bf16x8 a = *(const bf16x8*)(kbase + 8192 * kt + xs[s]);
          st[kt] = MFMA(a, qf, st[kt]);
        }
      }
      const bool need_mask = (k0 + 63 >= qw0);
      const int tq = qw0 + r;
      float running = carry;
#pragma unroll
      for (int kt = 1; kt >= 0; --kt) {
        float bt[16];
#pragma unroll
        for (int i = 0; i < 16; ++i) {
          float z2 = fminf(fmaxf(st[kt][i], -100.f), 100.f);
          float e = fexp2(-z2);
          float be = frcp(1.f + e);
          float om = e * be;
          if (need_mask && (k0 + 32 * kt + crow(i, h) >= tq)) { be = 0.f; om = 1.f; }
          bt[i] = be; st[kt][i] = om;
        }
#pragma unroll
        for (int rg = 3; rg >= 0; --rg) {
          const int i0 = 4 * rg;
          const float s2 = st[kt][i0 + 3], s1 = s2 * st[kt][i0 + 2], s0 = s1 * st[kt][i0 + 1], T = s0 * st[kt][i0];
          const float To = __shfl_xor(T, 32);
          const float off = running * (h ? 1.f : To);
          st[kt][i0 + 3] = bt[i0 + 3] * off;
          st[kt][i0 + 2] = bt[i0 + 2] * off * s2;
          st[kt][i0 + 1] = bt[i0 + 1] * off * s1;
          st[kt][i0] = bt[i0] * off * s0;
          running = off * T * (h ? To : 1.f);
        }
      }
      carry = running;
#pragma unroll
      for (int ks = 0; ks < 4; ++ks) {
        float wv[8];
#pragma unroll
        for (int j = 0; j < 8; ++j) wv[j] = st[ks >> 1][8 * (ks & 1) + j];
        const bf16x8 bw = pack8(wv);
#pragma unroll
        for (int d = 0; d < 4; ++d) {
          s16x4 lo = tr_read(vbase + 4096 * ks + vo[d]);
          s16x4 hi = tr_read(vbase + 4096 * ks + 2048 + (vo[d] ^ 32u));
          ot[d] = MFMA(cat4(lo, hi), bw, ot[d]);
        }
      }
    }
    {
      float m = carry;
#pragma unroll
      for (int s = 1; s < 64; s <<= 1) m = fmaxf(m, __shfl_xor(m, s));
      if (l == 0) flags[w] = m;
      wmax = m;
    }
    RAW_BARRIER();
    const float mx = fmaxf(fmaxf(flags[0], flags[1]), fmaxf(flags[2], flags[3]));
    if (mx < 1e-30f) break;
  }
#pragma unroll
  for (int hf = 0; hf < 2; ++hf) {
#pragma unroll
    for (int dd = 0; dd < 2; ++dd)
#pragma unroll
      for (int rg = 0; rg < 4; ++rg) {
        f32x4 v = {ot[2 * hf + dd][4 * rg], ot[2 * hf + dd][4 * rg + 1], ot[2 * hf + dd][4 * rg + 2], ot[2 * hf + dd][4 * rg + 3]};
        *(f32x4*)(stg + r * 68 + 32 * dd + 8 * rg + 4 * h) = v;
      }
    wave_lds_fence();
#pragma unroll
    for (int ps = 0; ps < 4; ++ps) {
      const int id = l + 64 * ps, rr = id >> 3, c8 = (id & 7) * 8;
      f32x4 v0 = *(const f32x4*)(stg + rr * 68 + c8), v1 = *(const f32x4*)(stg + rr * 68 + c8 + 4);
      u16* zp = p.proj() + ((size_t)b * SEQ + qw0 + rr) * LDE + 3072 + hh * 128 + 64 * hf + c8;
      float z[8], o[8];
      unpack8(ldg8(zp), z);
#pragma unroll
      for (int j = 0; j < 4; ++j) { o[j] = v0[j] * siluf_(z[j]); o[4 + j] = v1[j] * siluf_(z[4 + j]); }
      if (!dry) *(bf16x8*)zp = pack8(o);
    }
    wave_lds_fence();
  }
  __syncthreads();
}

DI void gla_g1(int tid, const Params& p, char* smem, int lyr, int b, int n, int hh) {
  const int w = tid >> 6, l = tid & 63, r = l & 31, h = l >> 5;
  float* Ef = (float*)smem;
  u16* base = p.proj() + (size_t)b * SEQ * LDO;
  const bf16x8 wgf = ldg8(p.WgT() + (size_t)lyr * 8192 + (hh * 128 + 32 * w + r) * 16 + 8 * h);
  const float gbias = p.gla_b_gate[lyr * 512 + hh * 128 + 32 * w + r];
  bf16x8 rf[2], rq[4], rkk[4];
  const int erow = tid >> 4, ech = tid & 15;
#pragma unroll
  for (int mt = 0; mt < 2; ++mt) rf[mt] = ldg8(base + (size_t)(n * 64 + 32 * mt + r) * LDO + 3072 + 8 * h);
#pragma unroll
  for (int i = 0; i < 4; ++i) {
    const u16* rp = base + (size_t)(n * 64 + erow + 16 * i) * LDO + hh * 128 + ech * 8;
    rq[i] = ldg8(rp); rkk[i] = ldg8(rp + 512);
  }
  {
    f32x16 ga[2];
#pragma unroll
    for (int mt = 0; mt < 2; ++mt) ga[mt] = MFMA(rf[mt], wgf, zero16());
    float running = 0.f;
#pragma unroll
    for (int mt = 0; mt < 2; ++mt)
#pragma unroll
      for (int rg = 0; rg < 4; ++rg) {
        float c[4];
#pragma unroll
        for (int j = 0; j < 4; ++j) {
          const float x = ga[mt][4 * rg + j] + gbias;
          const float sp = fmaxf(-x, 0.f) + 0.6931471805599453f * flog2(1.f + fexp(-fabsf(x)));
          c[j] = -sp * (1.f / 16.f);
        }
        c[1] += c[0]; c[2] += c[1]; c[3] += c[2];
        const float T = c[3], To = __shfl_xor(T, 32);
        const float off = running + (h ? To : 0.f);
#pragma unroll
        for (int j = 0; j < 4; ++j) Ef[(32 * mt + 8 * rg + 4 * h + j) * 128 + 32 * w + r] = fexp(off + c[j]);
        running = off + T + (h ? 0.f : To);
      }
  }
  __syncthreads();
#pragma unroll
  for (int i = 0; i < 4; ++i) {
    const int t = erow + 16 * i;
    const f32x4* ep = (const f32x4*)(Ef + t * 128 + ech * 8);
    f32x4 e0 = ep[0], e1 = ep[1];
    float e[8] = {e0[0], e0[1], e0[2], e0[3], e1[0], e1[1], e1[2], e1[3]};
    float q[8], k[8];
    unpack8(rq[i], q); unpack8(rkk[i], k);
#pragma unroll
    for (int j = 0; j < 8; ++j) { q[j] *= e[j] * 0.08838834764831845f; k[j] *= frcp(e[j]); }
    u16* rp = base + (size_t)(n * 64 + t) * LDO + hh * 128 + ech * 8;
    *(bf16x8*)rp = pack8(q);
    *(bf16x8*)(rp + 512) = pack8(k);
  }
  if (tid < 128) p.Sc()[(((size_t)b * 64 + n) * 4 + hh) * 128 + tid] = Ef[63 * 128 + tid];
  __syncthreads();
}

DI void gla_item(int tid, const Params& p, char* smem, int lyr, int b, int hh, int sl, bool dry) {
  const int w = tid >> 6, l = tid & 63, r = l & 31, h = l >> 5;
  char* vs = smem + 65536;
  char* sT = smem + 69632;
  u16* base = p.proj() + (size_t)b * SEQ * LDO;
  const float* elast = p.Sc() + ((size_t)b * 64 * 4 + hh) * 128;
  const int trq = (l & 15) >> 2, trp = l & 3, trblk = (l >> 4) & 1;
  const unsigned fr = ((r & 3) << 2) | ((r >> 2) & 3);
  auto xsf = [&](int s8) -> unsigned { unsigned v = 16u * ((2 * s8 + h) ^ fr); asm volatile("" : "+v"(v)); return v; };
  const unsigned rowb = 256u * r;
  const unsigned fk = (trq << 2) | (2 * h);
  const unsigned kb2 = 256u * (8 * h + trq);
  f32x16 sacc[2];
  sacc[0] = zero16(); sacc[1] = zero16();
  for (int e = tid; e < 2048; e += 256) ((unsigned*)sT)[e] = 0u;
  bf16x8 rvv;
  auto load_v = [&](int n) {
    rvv = ldg8(base + (size_t)(n * 64 + (tid >> 2)) * LDO + 1024 + hh * 256 + sl * 32 + (tid & 3) * 8);
  };
  auto dma_qk = [&](int n, int buf) {
    char* dq = smem + buf * 32768 + w * 4096;
#pragma unroll
    for (int i = 0; i < 4; ++i) {
      const int j = 4 * w + i;
      const int ch = (l & 15) ^ (((l >> 4) << 2) | (j & 3));
      const u16* src = base + (size_t)(n * 64 + 4 * j + (l >> 4)) * LDO + hh * 128 + ch * 8;
      __builtin_amdgcn_global_load_lds((const unsigned*)src, (unsigned*)(dq + i * 1024), 16, 0, 0);
      __builtin_amdgcn_global_load_lds((const unsigned*)(src + 512), (unsigned*)(dq + 16384 + i * 1024), 16, 0, 0);
    }
  };
  float el[2] = {1.f, 1.f};
  auto load_el = [&](int n) {
    if (w >= 2) {
#pragma unroll
      for (int ci = 0; ci < 2; ++ci) el[ci] = elast[(size_t)n * 512 + 32 * (2 * (w - 2) + ci) + r];
    }
  };
  u32x2 zreg[4];
  auto load_z = [&](int n) {
    const u16* zp = base + (size_t)(n * 64 + 32 * (w & 1) + r) * LDO + 2048 + hh * 256 + sl * 32 + 4 * h;
#pragma unroll
    for (int rg = 0; rg < 4; ++rg) zreg[rg] = *(const u32x2*)(zp + 8 * rg);
  };
  dma_qk(0, 0);
  load_v(0);
  load_el(0);
  dma_qk(1, 1);
  __builtin_amdgcn_sched_barrier(0);
  for (int n = 0; n < 64; ++n) {
    const char* qd = smem + (n & 1) * 32768;
    const char* ki = qd + 16384;
    {
      *(bf16x8*)(vs + (tid >> 2) * 64 + (tid & 3) * 16) = rvv;
      if (w >= 2 && n > 0 && !(dry && (PROBE_VARIANT == 12 || PROBE_VARIANT == 13))) {
        const int cb = 2 * (w - 2);
#pragma unroll
        for (int ci = 0; ci < 2; ++ci) {
          const int c = 32 * (cb + ci) + r;
#pragma unroll
          for (int i = 0; i < 16; ++i) *(u16*)(sT + off_b(crow(i, h), c >> 3) + (c & 7) * 2) = f2bf(sacc[ci][i]);
        }
      }
    }
    const float el0 = el[0], el1 = el[1];
    if (n + 1 < 64) WAIT_V(8); else WAIT_V(0);
    RAW_BARRIER();
    if (n + 1 < 64) { load_v(n + 1); load_el(n + 1); }
    const bool skip_o = dry && (PROBE_VARIANT == 11 || PROBE_VARIANT == 13), skip_s = dry && (PROBE_VARIANT == 12 || PROBE_VARIANT == 13);
    if (w < 2 ? skip_o : skip_s) {
    } else if (w < 2) {
      const int tt = w;
      load_z(n);
      f32x16 oa = zero16();
#pragma unroll
      for (int st = 0; st < 2; ++st) {
        if (st <= tt) {
          f32x16 sc = zero16();
#pragma unroll
          for (int hb = 0; hb < 2; ++hb) {
            bf16x8 af[4], bf[4];
#pragma unroll
            for (int q4 = 0; q4 < 4; ++q4) {
              af[q4] = *(const bf16x8*)(ki + rowb + 8192 * st + xsf(4 * hb + q4));
              bf[q4] = *(const bf16x8*)(qd + rowb + 8192 * tt + xsf(4 * hb + q4));
            }
            __builtin_amdgcn_sched_barrier(0);
#pragma unroll
            for (int q4 = 0; q4 < 4; ++q4) sc = MFMA(af[q4], bf[q4], sc);
            __builtin_amdgcn_sched_barrier(0);
          }
          if (st == tt) {
#pragma unroll
            for (int i = 0; i < 16; ++i)
              if (crow(i, h) > r) sc[i] = 0.f;
          }
          s16x4 vlo[2], vhi[2];
#pragma unroll
          for (int ks = 0; ks < 2; ++ks) {
            const int row0 = 32 * st + 16 * ks + 4 * h + trq;
            vlo[ks] = tr_read(vs + row0 * 64 + 32 * trblk + 8 * trp);
            vhi[ks] = tr_read(vs + (row0 + 8) * 64 + 32 * trblk + 8 * trp);
          }
#pragma unroll
          for (int ks = 0; ks < 2; ++ks) {
            float wv[8];
#pragma unroll
            for (int j = 0; j < 8; ++j) wv[j] = sc[8 * ks + j];
            oa = MFMA(cat4(vlo[ks], vhi[ks]), pack8(wv), oa);
          }
        }
      }
#pragma unroll
      for (int hb = 0; hb < 2; ++hb) {
        bf16x8 sf[4], bf[4];
#pragma unroll
        for (int q4 = 0; q4 < 4; ++q4) {
          sf[q4] = *(const bf16x8*)(sT + rowb + xsf(4 * hb + q4));
          bf[q4] = *(const bf16x8*)(qd + rowb + 8192 * tt + xsf(4 * hb + q4));
        }
        __builtin_amdgcn_sched_barrier(0);
#pragma unroll
        for (int q4 = 0; q4 < 4; ++q4) oa = MFMA(sf[q4], bf[q4], oa);
        __builtin_amdgcn_sched_barrier(0);
      }
      const size_t tok = (size_t)b * SEQ + n * 64 + 32 * tt + r;
      float ss = 0.f;
#pragma unroll
      for (int i = 0; i < 16; ++i) ss += oa[i] * oa[i];
      ss += __shfl_xor(ss, 32);
      if (h == 0 && !dry) p.ssqg()[tok * 32 + hh * 8 + sl] = ss;
      u16* rowp = p.proj() + tok * LDO + hh * 256 + sl * 32;
#pragma unroll
      for (int rg = 0; rg < 4; ++rg) {
        const int dv0 = 8 * rg + 4 * h;
        const u32x2 zz = zreg[rg];
        float z0 = bflo(zz[0]), z1 = bfhi(zz[0]), z2 = bflo(zz[1]), z3 = bfhi(zz[1]);
        u32x2 o;
        o[0] = pk2(oa[4 * rg] * siluf_(z0), oa[4 * rg + 1] * siluf_(z1));
        o[1] = pk2(oa[4 * rg + 2] * siluf_(z2), oa[4 * rg + 3] * siluf_(z3));
        if (!dry) *(u32x2*)(rowp + 1024 + dv0) = o;
      }
    } else {
      const int cb = 2 * (w - 2);
#pragma unroll
      for (int ks = 0; ks < 4; ++ks) {
        const int row0 = 16 * ks + 8 * h + trq;
        s16x4 lo = tr_read(vs + row0 * 64 + 32 * trblk + 8 * trp);
        s16x4 hi = tr_read(vs + (row0 + 4) * 64 + 32 * trblk + 8 * trp);
        const bf16x8 av = cat4(lo, hi);
#pragma unroll
        for (int ci = 0; ci < 2; ++ci) {
          const unsigned ko = 16u * ((4 * (cb + ci) + 2 * trblk + (trp >> 1)) ^ fk) + 8u * (trp & 1);
          s16x4 blo = tr_read(ki + kb2 + 4096 * ks + ko);
          s16x4 bhi = tr_read(ki + kb2 + 4096 * ks + 1024 + (ko ^ 16u));
          sacc[ci] = MFMA(av, cat4(blo, bhi), sacc[ci]);
        }
      }
#pragma unroll
      for (int ci = 0; ci < 2; ++ci)
#pragma unroll
        for (int i = 0; i < 16; ++i) sacc[ci][i] *= (ci ? el1 : el0);
    }
    RAW_BARRIER();
    __builtin_amdgcn_sched_barrier(0);
    if (n + 2 < 64) dma_qk(n + 2, n & 1);
    __builtin_amdgcn_sched_barrier(0);
  }
  __syncthreads();
}

#define FOR_TILES_XCD4(MT, NT, mt, nt)                                                           \
  for (int s_ = (bid >> 3), mt = 0, nt = 0;                                                       \
       s_ < ((MT) >> 3) * (NT) &&                                                                 \
       (mt = (bid & 7) + 8 * (4 * (s_ / (4 * (NT))) + (s_ & 3)), nt = (s_ % (4 * (NT))) >> 2, true); s_ += (nb >> 3))
#define FOR_TILES_XCD(MT, NT, mt, nt)                                                          \
  for (int s_ = (bid >> 3), mt = 0, nt = 0;                                                     \
       s_ < ((MT) >> 3) * (NT) && (mt = (bid & 7) + 8 * (s_ / (NT)), nt = s_ % (NT), true); s_ += (nb >> 3))
DI void run_phase(const Params& p, char* smem, int ph, bool dry) {
  int tid = threadIdx.x, bid = blockIdx.x;
  asm volatile("" : "+v"(tid));
  asm volatile("" : "+s"(bid));
  const int nb = gridDim.x;
#ifdef ONLY
  if (ph != ONLY) return;
#endif
  if (ph == 0) { phase_prologue(tid, bid, p, smem); return; }
  const int q = ph - 1, cyc = q / 10, rem = q % 10;
  const int li = cyc;
  if (rem < 6) {
    const int lyr = li;
    switch (rem) {
      case 0: {
        ALPlain al{p.xb(), LDX, 1 << 30, 0, 0};
        EPEvenIn ep{p.part(), p.proj(), p.sb_q_g + lyr * 128, p.sb_k_g + lyr * 128};
        const u16* Bt = p.WtEin() + (size_t)lyr * 5120 * LDK1;
        FOR_TILES_XCD4(256, 40, mt, nt) gemm_tile_dma(tid, smem, al, Bt, LDK1, 1024, mt * 256, nt * 128, ep, dry ? PROBE_VARIANT : 0);
      } break;
      case 1: {
        for (int it = bid; it < 4096; it += nb) {
          const int qb = 31 - (it >> 7), bh = it & 127;
          attn_item(tid, p, smem, bh >> 3, bh & 7, qb, dry);
        }
        asm volatile("" : "+v"(tid));
        for (int t = bid; t < 256; t += nb) {
          const int g = t >> 3, mt = t & 7;
          ALS5 al{p.proj(), p.hp(), g};
          EPS5P ep{p.Sc(), g};
          gemm_tile_dma(tid, smem, al, p.WtP() + ((size_t)lyr * 32 + g) * 128 * LDK5, LDK5, 512, mt * 256, 0, ep);
        }
      } break;
      case 2: {
        for (int idx = bid * 256 + tid; idx < 16 * 32 * 64; idx += nb * 256) {
          const int n = idx & 63, g = (idx >> 6) & 31, b = idx >> 11;
          const float lr = p.LT()[((lyr * 32 + g) * 64 + n) * 2], lim = p.LT()[((lyr * 32 + g) * 64 + n) * 2 + 1];
          float hr = 0.f, hi = 0.f;
          for (int c0 = 0; c0 < 128; c0 += 16) {
            float sr[16], si[16];
#pragma unroll
            for (int j = 0; j < 16; ++j) {
              const size_t o = ((size_t)(b * 128 + c0 + j) * 32 + g) * 128;
              sr[j] = p.Sc()[o + n]; si[j] = p.Sc()[o + 64 + n];
            }
#pragma unroll
            for (int j = 0; j < 16; ++j) {
              const size_t o = ((size_t)(b * 128 + c0 + j) * 32 + g) * 128;
              p.hp()[o + n] = f2bf(hr); p.hp()[o + 64 + n] = f2bf(hi);
              const float nr = lr * hr - lim * hi + sr[j], ni = lr * hi + lim * hr + si[j];
              hr = nr; hi = ni;
            }
          }
        }
      } break;
      case 3: {
        for (int t = bid; t < 1024; t += nb) {
          const int g = t >> 5, mt = (t >> 2) & 7, nt = t & 3;
          ALS5 al{p.proj(), p.hp(), g};
          EPS5Y ep{p.proj(), p.yb(), p.s5_d + lyr * 512, g};
          gemm_tile_dma(tid, smem, al, p.WtMQ() + ((size_t)lyr * 32 + g) * 512 * LDK6, LDK6, 640, mt * 256, nt * 128, ep);
        }
      } break;
      case 4: {
        ALPlain al{p.yb(), LDY, 1 << 30, 0, 0};
        EPGlu ep{p.proj(), p.yb(), p.b_glu + lyr * 512, dry};
        const u16* Bt = p.WtGlu() + (size_t)lyr * 512 * LDK5;
        FOR_TILES_XCD(256, 4, mt, nt) gemm_tile_dma(tid, smem, al, Bt, LDK5, 512, mt * 256, nt * 128, ep);
      } break;
      default: {
        ALPlain al{p.proj(), LDE, 1024, 3072, 3584};
        EPOut ep{cyc == 0 ? p.x : p.out, p.out, p.xb(), p.part(), dry};
        const u16* Bt = p.WtEout() + (size_t)lyr * 1024 * LDK15;
        FOR_TILES_XCD(256, 8, mt, nt) gemm_tile_dma(tid, smem, al, Bt, LDK15, 1536, mt * 256, nt * 128, ep);
      } break;
    }
  } else {
    const int lyr = li;
    switch (rem - 6) {
      case 0: {
        ALPlain al{p.xb(), LDX, 1 << 30, 0, 0};
        EPOddIn ep{p.part(), p.proj()};
        const u16* Bt = p.WtOin() + (size_t)lyr * 3200 * LDK1;
        FOR_TILES_XCD4(256, 25, mt, nt) gemm_tile_dma(tid, smem, al, Bt, LDK1, 1024, mt * 256, nt * 128, ep);
      } break;
      case 1: {
        if (!dry) for (int it = bid; it < 4096; it += nb) gla_g1(tid, p, smem, lyr, it >> 8, (it >> 2) & 63, it & 3);
      } break;
      case 2: {
        for (int it = bid; it < 512; it += nb) {
          const int xcd = it & 7, j = it >> 3, bh = xcd * 8 + (j >> 3), slc = j & 7;
          gla_item(tid, p, smem, lyr, bh >> 2, bh & 3, slc, dry);
        }
      } break;
      default: {
        ALGlaOut al{p.proj(), p.ssqg()};
        EPOut ep{p.out, p.out, p.xb(), p.part(), dry};
        const u16* Bt = p.WtOout() + (size_t)lyr * 1024 * LDK1;
        FOR_TILES_XCD(256, 8, mt, nt) gemm_tile(tid, smem, al, Bt, LDK1, 1024, mt * 256, nt * 128, ep);
      } break;
    }
  }
}


#define XB_TMO      128
#define XB_XCNT(j)  (256  + 64 * (j))
#define XB_XSUB(j)  (1280 + 64 * (j))
#define XB_XGEN(j)  (2304 + 64 * (j))
#define XB_TOP      3328
#define XB_TOPGEN   3392
#define XCD_BAR_WORDS 3456
#define XB_SPIN_CAP (1u << 18)
#define LAS __attribute__((address_space(3)))
DI unsigned xb_ld(unsigned* p) { return __hip_atomic_load(p, __ATOMIC_RELAXED, __HIP_MEMORY_SCOPE_AGENT); }
DI unsigned xb_add(unsigned* p, unsigned v) { return __hip_atomic_fetch_add(p, v, __ATOMIC_RELAXED, __HIP_MEMORY_SCOPE_AGENT); }
DI unsigned xb_xcc_id() { return (unsigned)__builtin_amdgcn_s_getreg((3 << 11) | 20) & 0xFu; }
#define XB_SPIN(cond, bar) do { unsigned _sp = 0; while (cond) { __builtin_amdgcn_s_sleep(1); \
    if ((++_sp & 255u) == 0u) { if (xb_ld(&(bar)[XB_TMO])) break; if (_sp > XB_SPIN_CAP) { atomicAdd(&(bar)[XB_TMO], 1u); break; } } } } while (0)
struct XcdBarrier { unsigned* bar; unsigned x; volatile LAS unsigned* st; };
DI XcdBarrier xcd_barrier_post(unsigned* bar, volatile LAS unsigned* st) {
  XcdBarrier b; b.bar = bar; b.x = xb_xcc_id(); b.st = st;
  if (threadIdx.x == 0) (void)xb_add(&bar[XB_XCNT(b.x)], 1u);
  return b;
}
DI void xcd_barrier_complete(unsigned* bar, unsigned x, unsigned& nloc, unsigned& nx) {
  const unsigned G = gridDim.x * gridDim.y * gridDim.z;
  unsigned sum, cnt, mine, sp = 0u;
  for (;;) {
    sum = 0u; cnt = 0u; mine = 0u;
#pragma unroll
    for (unsigned j = 0; j < 16; ++j) { const unsigned c = xb_ld(&bar[XB_XCNT(j)]); sum += c; cnt += (c > 0u) ? 1u : 0u; mine = (j == x) ? c : mine; }
    if (sum == G) break;
    __builtin_amdgcn_s_sleep(1);
    if ((++sp & 255u) == 0u) { if (xb_ld(&bar[XB_TMO])) break; if (sp > XB_SPIN_CAP) { atomicAdd(&bar[XB_TMO], 1u); break; } }
  }
  nloc = mine > 0u ? mine : 1u; nx = cnt > 0u ? cnt : 1u;
}
DI void xcd_barrier(const XcdBarrier& b) {
  asm volatile("s_waitcnt vmcnt(0)" ::: "memory");
  __syncthreads();
  if (threadIdx.x == 0) {
    unsigned* bar = b.bar;
    __builtin_amdgcn_s_waitcnt(0);
    unsigned nloc = b.st[0], nx = b.st[1];
    if (nloc == 0u) { xcd_barrier_complete(bar, b.x, nloc, nx); b.st[0] = nloc; b.st[1] = nx; }
    const unsigned old = xb_add(&bar[XB_XSUB(b.x)], 1u);
    const unsigned gen = old / nloc;
    if (old + 1u == (gen + 1u) * nloc) {
      __builtin_amdgcn_fence(__ATOMIC_RELEASE, "agent");
      asm volatile("s_waitcnt vmcnt(0)" ::: "memory");
      const unsigned og = xb_add(&bar[XB_TOP], 1u);
      const unsigned tg = og / nx;
      if (og + 1u == (tg + 1u) * nx) xb_add(&bar[XB_TOPGEN], 1u);
      else XB_SPIN(xb_ld(&bar[XB_TOPGEN]) == tg, bar);
      __builtin_amdgcn_fence(__ATOMIC_ACQUIRE, "agent");
      xb_add(&bar[XB_XGEN(b.x)], 1u);
      asm volatile("s_waitcnt vmcnt(0)" ::: "memory");
    } else {
      XB_SPIN(xb_ld(&bar[XB_XGEN(b.x)]) == gen, bar);
      __builtin_amdgcn_fence(__ATOMIC_ACQUIRE, "agent");
      asm volatile("s_waitcnt vmcnt(0)" ::: "memory");
    }
  }
  __syncthreads();
}

constexpr int NPHASE = 21;

#ifndef PROBE_MASK
#define PROBE_MASK 0
#endif
DI int phase_kind(int ph) { if (ph == 0) return 0; const int rem = (ph - 1) % 10; return 1 + rem; }

#ifndef PROBE_SEL
#define PROBE_SEL -1
#endif
__global__ void __launch_bounds__(256, 2) fwd_kernel(Params p, int ph_lo, int ph_hi, int probe_mask, int probe_sel) {
  __shared__ __attribute__((aligned(16))) char smem[SMEM_BYTES];
  __shared__ uint4 xb_words;
  if (threadIdx.x == 0) xb_words = make_uint4(0u, 0u, 0u, 0u);
  __syncthreads();
  (void)xcd_barrier_post((unsigned*)(p.ws + OFF_bar), (volatile LAS unsigned*)&xb_words);
  for (int ph = ph_lo; ph < ph_hi; ++ph) {
    if (ph > ph_lo) {
      XcdBarrier xb;
      unsigned* bar_ = (unsigned*)(p.ws + OFF_bar);
      asm volatile("" : "+s"(bar_));
      xb.bar = bar_; xb.x = xb_xcc_id(); xb.st = (volatile LAS unsigned*)&xb_words;
      xcd_barrier(xb);
    }
    if (probe_mask < 0) cg::this_grid().sync();
    run_phase(p, smem, ph, false);
  }
}

extern "C" void kernel_launch(void* const* d_in, const int* in_sizes, int n_in, void* d_out, int out_size, void* d_ws,
                              size_t ws_size, hipStream_t stream) {
  Params p{};
  const float** fp = (const float**)&p;
  for (int i = 0; i < 22; ++i) fp[i] = (const float*)d_in[i];
  p.out = (float*)d_out;
  p.ws = (char*)d_ws;
  if (WS_TOTAL > ws_size) { fprintf(stderr, "workspace too small: have %zu\n", ws_size); return; }

  static int grid_blocks = 0;
  if (!grid_blocks) {
    int dev = 0, cus = 0, per_cu = 0;
    hipGetDevice(&dev);
    hipDeviceGetAttribute(&cus, hipDeviceAttributeMultiprocessorCount, dev);
    hipOccupancyMaxActiveBlocksPerMultiprocessor(&per_cu, fwd_kernel, 256, 0);
    if (per_cu > 2) per_cu = 2;
    grid_blocks = cus * per_cu;
    if (grid_blocks <= 0) grid_blocks = 256;
  }
#if COOP
  hipMemsetAsync(p.ws + OFF_bar, 0, (size_t)XCD_BAR_WORDS * 4, stream);
  int lo = 0, hi = NPHASE, pm = PROBE_MASK, psel = PROBE_SEL;
  void* args[] = {&p, &lo, &hi, &pm, &psel};
  hipError_t e = hipLaunchCooperativeKernel((void*)fwd_kernel, dim3(grid_blocks), dim3(256), args, 0, stream);
  if (e != hipSuccess) fprintf(stderr, "cooperative launch failed: %s (grid %d)\n", hipGetErrorString(e), grid_blocks);
#else
  for (int ph = 0; ph < NPHASE; ++ph) hipLaunchKernelGGL(fwd_kernel, dim3(grid_blocks), dim3(256), 0, stream, p, ph, ph + 1, 0, -1);
#endif
}
```

```cpp
#include <hip/hip_runtime.h>
#include <hip/hip_cooperative_groups.h>
#include <cstdio>
namespace cg = cooperative_groups;

#ifndef COOP
#define COOP 1
#endif

#ifndef PROBE_VARIANT
#define PROBE_VARIANT 0
#endif
#define DI __device__ __forceinline__
typedef unsigned short u16;
typedef __attribute__((ext_vector_type(8))) short bf16x8;
typedef __attribute__((ext_vector_type(4))) short s16x4;
typedef __attribute__((ext_vector_type(16))) float f32x16;
typedef __attribute__((ext_vector_type(4))) float f32x4;
typedef __attribute__((ext_vector_type(2))) float f32x2;
typedef __attribute__((ext_vector_type(4))) unsigned u32x4;
typedef __attribute__((ext_vector_type(2))) unsigned u32x2;
typedef __bf16 bf2_t __attribute__((ext_vector_type(2)));
typedef __attribute__((address_space(3))) s16x4 lds_s16x4;

#define MFMA(a, b, c) __builtin_amdgcn_mfma_f32_32x32x16_bf16((a), (b), (c), 0, 0, 0)

constexpr int NTOK = 65536;
constexpr int SEQ = 4096;
constexpr int LDE = 5184;
constexpr int LDO = 3264;
constexpr int LDX = 1088;
constexpr int LDY = 576;
constexpr int LDK1 = 1088, LDK15 = 1600, LDK5 = 576, LDK6 = 704;
constexpr float EPS = 1e-6f;
constexpr int SMEM_BYTES = 77824;

constexpr size_t al256(size_t x) { return (x + 255) & ~(size_t)255; }
constexpr size_t OFF_WtEin = 0;
constexpr size_t OFF_WtEout = OFF_WtEin + al256((size_t)2 * 5120 * LDK1 * 2);
constexpr size_t OFF_WtGlu = OFF_WtEout + al256((size_t)2 * 1024 * LDK15 * 2);
constexpr size_t OFF_WtOin = OFF_WtGlu + al256((size_t)2 * 512 * LDK5 * 2);
constexpr size_t OFF_WtOout = OFF_WtOin + al256((size_t)2 * 3200 * LDK1 * 2);
constexpr size_t OFF_WgT = OFF_WtOout + al256((size_t)2 * 1024 * LDK1 * 2);
constexpr size_t OFF_WtMQ = OFF_WgT + al256((size_t)2 * 512 * 16 * 2);
constexpr size_t OFF_WtP = OFF_WtMQ + al256((size_t)2 * 32 * 512 * LDK6 * 2);
constexpr size_t OFF_LT = OFF_WtP + al256((size_t)2 * 32 * 128 * LDK5 * 2);
constexpr size_t OFF_xb = OFF_LT + al256((size_t)2 * 32 * 64 * 2 * 4);
constexpr size_t OFF_part = OFF_xb + al256((size_t)NTOK * LDX * 2);
constexpr size_t OFF_proj = OFF_part + al256((size_t)NTOK * 8 * 4);
constexpr size_t OFF_yb = OFF_proj + al256((size_t)NTOK * LDE * 2);
constexpr size_t OFF_Sc = OFF_yb + al256((size_t)NTOK * LDY * 2);
constexpr size_t OFF_hp = OFF_Sc + al256((size_t)2048 * 32 * 128 * 4);
constexpr size_t OFF_ssqg = OFF_hp + al256((size_t)2048 * 32 * 128 * 2);
constexpr size_t OFF_bar = OFF_ssqg + al256((size_t)NTOK * 32 * 4);
constexpr size_t WS_TOTAL = OFF_bar + al256((size_t)3456 * 4);

struct Params {
  const float *x, *even_norm_g, *even_w_in, *sb_q_g, *sb_k_g, *lam_re, *lam_im, *log_dt, *b_re, *b_im, *c_re, *c_im,
      *s5_d, *w_glu, *b_glu, *even_w_out, *odd_norm_g, *odd_w_in, *gla_w_gate, *gla_b_gate, *gla_o_g, *odd_w_out;
  float* out;
  char* ws;
  DI u16* WtEin() const { return (u16*)(ws + OFF_WtEin); }
  DI u16* WtEout() const { return (u16*)(ws + OFF_WtEout); }
  DI u16* WtGlu() const { return (u16*)(ws + OFF_WtGlu); }
  DI u16* WtOin() const { return (u16*)(ws + OFF_WtOin); }
  DI u16* WtOout() const { return (u16*)(ws + OFF_WtOout); }
  DI u16* WgT() const { return (u16*)(ws + OFF_WgT); }
  DI u16* WtMQ() const { return (u16*)(ws + OFF_WtMQ); }
  DI u16* WtP() const { return (u16*)(ws + OFF_WtP); }
  DI float* LT() const { return (float*)(ws + OFF_LT); }
  DI u16* xb() const { return (u16*)(ws + OFF_xb); }
  DI float* part() const { return (float*)(ws + OFF_part); }
  DI u16* proj() const { return (u16*)(ws + OFF_proj); }
  DI u16* yb() const { return (u16*)(ws + OFF_yb); }
  DI float* Sc() const { return (float*)(ws + OFF_Sc); }
  DI u16* hp() const { return (u16*)(ws + OFF_hp); }
  DI float* ssqg() const { return (float*)(ws + OFF_ssqg); }
};

DI unsigned pk2(float a, float b) { f32x2 v = {a, b}; return __builtin_bit_cast(unsigned, __builtin_convertvector(v, bf2_t)); }
DI u16 f2bf(float a) { return (u16)(pk2(a, 0.f) & 0xffffu); }
DI float bflo(unsigned u) { return __uint_as_float(u << 16); }
DI float bfhi(unsigned u) { return __uint_as_float(u & 0xffff0000u); }
DI int crow(int i, int h) { return (i & 3) + 8 * (i >> 2) + 4 * h; }
DI float fexp2(float x) { return __builtin_amdgcn_exp2f(x); }
DI float flog2(float x) { return __builtin_amdgcn_logf(x); }
DI float frcp(float x) { return __builtin_amdgcn_rcpf(x); }
DI float fexp(float x) { return fexp2(x * 1.44269504088896f); }
DI float sigmoidf_(float x) { return frcp(1.f + fexp(-x)); }
DI float siluf_(float x) { return x * sigmoidf_(x); }
DI unsigned off_b(unsigned row, unsigned ch) { return 256u * row + 16u * (ch ^ (((row & 3) << 2) | ((row >> 2) & 3))); }
DI unsigned off_g(unsigned row, unsigned ch) { return 128u * row + 16u * (ch ^ ((row >> 1) & 7)); }
DI s16x4 tr_read(const char* p) { return __builtin_amdgcn_ds_read_tr16_b64_v4i16((lds_s16x4*)p); }
DI bf16x8 cat4(s16x4 lo, s16x4 hi) { return __builtin_shufflevector(lo, hi, 0, 1, 2, 3, 4, 5, 6, 7); }
DI f32x16 zero16() { f32x16 z;
#pragma unroll
  for (int i = 0; i < 16; ++i) z[i] = 0.f; return z; }
DI bf16x8 pack8(const float* f) {
  u32x4 r; r[0] = pk2(f[0], f[1]); r[1] = pk2(f[2], f[3]); r[2] = pk2(f[4], f[5]); r[3] = pk2(f[6], f[7]);
  return __builtin_bit_cast(bf16x8, r);
}
DI void unpack8(bf16x8 v, float* f) {
  u32x4 r = __builtin_bit_cast(u32x4, v);
#pragma unroll
  for (int i = 0; i < 4; ++i) { f[2 * i] = bflo(r[i]); f[2 * i + 1] = bfhi(r[i]); }
}
DI bf16x8 ldg8(const u16* p) { return *(const bf16x8*)p; }
template <int CTRL> DI float dpp_mov(float v) {
  return __int_as_float(__builtin_amdgcn_update_dpp(0, __float_as_int(v), CTRL, 0xF, 0xF, true));
}
DI float red16(float v) {
  v += dpp_mov<0xB1>(v);
  v += dpp_mov<0x4E>(v);
  v += dpp_mov<0x141>(v);
  v += dpp_mov<0x140>(v);
  return v;
}
typedef unsigned u32x2v __attribute__((ext_vector_type(2)));
DI float xor32(float v, int h) {
  const u32x2v r = __builtin_amdgcn_permlane32_swap(__float_as_uint(v), __float_as_uint(v), false, false);
  return __uint_as_float(h ? r[0] : r[1]);
}
DI void wave_lds_fence() { __builtin_amdgcn_fence(__ATOMIC_RELEASE, "wavefront"); __builtin_amdgcn_wave_barrier(); __builtin_amdgcn_fence(__ATOMIC_ACQUIRE, "wavefront"); }

DI float row_rstd(const float* part, int row) {
  const f32x4* p = (const f32x4*)(part + (size_t)row * 8);
  f32x4 a = p[0], b = p[1];
  float s = a[0] + a[1] + a[2] + a[3] + b[0] + b[1] + b[2] + b[3];
  return __builtin_amdgcn_rsqf(s * (1.f / 1024.f) + EPS);
}

template <class AL, class EP>
DI void gemm_tile(int tid, char* smem, const AL& al, const u16* __restrict__ Bt, int ldb, int K, int row0, int col0, const EP& ep) {
  const int w = tid >> 6, l = tid & 63, r = l & 31, h = l >> 5;
  char* As = smem;
  char* Bs = smem + 32768;
  f32x16 acc[2][4];
#pragma unroll
  for (int mi = 0; mi < 2; ++mi)
#pragma unroll
    for (int ni = 0; ni < 4; ++ni) acc[mi][ni] = zero16();
  const int lrow = tid >> 3, lch = tid & 7;
  bf16x8 ra[8], rb[4];
  const unsigned boff = ((unsigned)(col0 + lrow) * (unsigned)ldb + lch * 8) * 2u;
  const unsigned bstep = 64u * (unsigned)ldb;
  auto gload = [&](int k0) {
    const char* ab = al.base(k0);
    unsigned ao = al.off(row0 + lrow, k0 + lch * 8);
    unsigned st = al.step32(k0), bs = bstep, bo = boff + 2u * k0;
    asm volatile("" : "+s"(st), "+s"(bs));
    asm volatile("" : "+v"(ao), "+v"(bo));
#pragma unroll
    for (int i = 0; i < 8; ++i) ra[i] = *(const bf16x8*)(ab + (ao + i * st));
#pragma unroll
    for (int i = 0; i < 4; ++i) rb[i] = *(const bf16x8*)((const char*)Bt + (bo + i * bs));
  };
  const unsigned wbase = off_g(lrow, lch);
  unsigned xo[4];
#pragma unroll
  for (int s = 0; s < 4; ++s) xo[s] = 16u * ((2 * s + h) ^ ((r >> 1) & 7));
  const unsigned abase = 128u * (64 * w + r), bbase = 32768u + 128u * r;
  gload(0);
  for (int k0 = 0; k0 < K; k0 += 64) {
    if constexpr (AL::kRowScale) {
      float* rsl = (float*)(smem + 49152);
      if ((k0 & 255) == 0) {
        rsl[tid] = al.rowscale(row0 + tid, k0 >> 8);
        __syncthreads();
      }
#pragma unroll
      for (int i = 0; i < 8; ++i) {
        const float sc = rsl[lrow + 32 * i];
        float f[8]; unpack8(ra[i], f);
#pragma unroll
        for (int j = 0; j < 8; ++j) f[j] *= sc;
        ra[i] = pack8(f);
      }
    }
#pragma unroll
    for (int i = 0; i < 8; ++i) *(bf16x8*)(As + wbase + 4096 * i) = ra[i];
#pragma unroll
    for (int i = 0; i < 4; ++i) *(bf16x8*)(Bs + wbase + 4096 * i) = rb[i];
    __syncthreads();
    if (k0 + 64 < K) gload(k0 + 64);
#pragma unroll
    for (int s = 0; s < 4; ++s) {
      bf16x8 a[2], b[4];
#pragma unroll
      for (int mi = 0; mi < 2; ++mi) a[mi] = *(const bf16x8*)(smem + abase + 4096 * mi + xo[s]);
#pragma unroll
      for (int ni = 0; ni < 4; ++ni) b[ni] = *(const bf16x8*)(smem + bbase + 4096 * ni + xo[s]);
#pragma unroll
      for (int mi = 0; mi < 2; ++mi)
#pragma unroll
        for (int ni = 0; ni < 4; ++ni) acc[mi][ni] = MFMA(a[mi], b[ni], acc[mi][ni]);
      __builtin_amdgcn_sched_barrier(0);
    }
    __syncthreads();
  }
  float* stg = (float*)(smem + w * 16896);
#pragma unroll
  for (int mi = 0; mi < 2; ++mi) {
#pragma unroll
    for (int ni = 0; ni < 4; ++ni)
#pragma unroll
      for (int i = 0; i < 16; ++i) stg[crow(i, h) * 132 + 32 * ni + r] = acc[mi][ni][i];
    wave_lds_fence();
#pragma unroll
    for (int ps = 0; ps < 8; ++ps) {
      const int rr = 4 * ps + (l >> 4), cc = (l & 15) * 8;
      float v[8];
      f32x4 v0 = *(const f32x4*)(stg + rr * 132 + cc), v1 = *(const f32x4*)(stg + rr * 132 + cc + 4);
#pragma unroll
      for (int j = 0; j < 4; ++j) { v[j] = v0[j]; v[4 + j] = v1[j]; }
      ep(row0 + 64 * w + 32 * mi + rr, col0 + cc, v, l, 1.f);
    }
    wave_lds_fence();
  }
  __syncthreads();
}

#define WAIT_V(n) asm volatile("s_waitcnt vmcnt(%0)" ::"n"(n) : "memory")
#define RAW_BARRIER() do { asm volatile("s_waitcnt lgkmcnt(0)" ::: "memory"); __builtin_amdgcn_s_barrier(); } while (0)
template <class AL, class EP>
DI void gemm_tile_dma(int tid, char* smem, const AL& al, const u16* __restrict__ Bt, int ldb, int K, int row0, int col0, const EP& ep, int variant = 0) {
  typedef __attribute__((ext_vector_type(4))) float f32x4v;
  const int w = tid >> 6, l = tid & 63, r16 = l & 15, q4 = l >> 4;
  f32x4v acc[4][8];
#pragma unroll
  for (int mi = 0; mi < 4; ++mi)
#pragma unroll
    for (int ni = 0; ni < 8; ++ni) { acc[mi][ni][0] = 0.f; acc[mi][ni][1] = 0.f; acc[mi][ni][2] = 0.f; acc[mi][ni][3] = 0.f; }
  auto Gf = [](int x) -> int { return (0x78 >> (2 * x)) & 3; };
  const int lch = (l & 3) ^ Gf((l >> 4) & 3);
  const unsigned boff = ((unsigned)(col0 + 32 * w + (l >> 2)) * (unsigned)ldb + lch * 8) * 2u;
  const unsigned bstep = 32u * (unsigned)ldb;
  auto stage = [&](int buf, int kt) {
    const int k0 = kt * 32;
    const char* ab = al.base(k0);
    unsigned ao = al.off(row0 + 64 * w + (l >> 2), k0 + lch * 8);
    unsigned st = al.step32(k0) >> 1, bs = bstep, bo = boff + 2u * k0;
    asm volatile("" : "+s"(st), "+s"(bs));
    asm volatile("" : "+v"(ao), "+v"(bo));
    char* sa = smem + buf * 24576 + w * 4096;
    char* sb = smem + buf * 24576 + 16384 + w * 2048;
#pragma unroll
    for (int i = 0; i < 4; ++i)
      __builtin_amdgcn_global_load_lds((const unsigned*)(ab + (ao + i * st)), (unsigned*)(sa + i * 1024), 16, 0, 0);
#pragma unroll
    for (int i = 0; i < 2; ++i)
      __builtin_amdgcn_global_load_lds((const unsigned*)((const char*)Bt + (bo + i * bs)), (unsigned*)(sb + i * 1024), 16, 0, 0);
  };
  const unsigned xo = 16u * (unsigned)(q4 ^ Gf((r16 >> 2) & 3));
  const unsigned fbase = 64u * r16 + xo;
  const unsigned wofs = 4096u * (unsigned)__builtin_amdgcn_readfirstlane(w);
  const int nt = K >> 5;
  float* rtab = (float*)(smem + 73728);
  if constexpr (EP::kRstd) rtab[tid] = row_rstd(ep.part, row0 + tid);
  stage(0, 0);
  stage(1, 1);
  WAIT_V(6);
  RAW_BARRIER();
  bf16x8 xa[4], xb[4], ya[4], yb[4];
  auto rdA = [&](bf16x8 (&fa)[4], unsigned bufoff) {
#pragma unroll
    for (int mi = 0; mi < 4; ++mi) fa[mi] = *(const bf16x8*)(smem + (bufoff + wofs + 1024u * mi) + fbase);
  };
  auto rdB = [&](bf16x8 (&fb)[4], unsigned bufoff, int hf) {
#pragma unroll
    for (int ni = 0; ni < 4; ++ni) fb[ni] = *(const bf16x8*)(smem + (bufoff + 16384u + 1024u * (4 * hf + ni)) + fbase);
  };
  int cur = 0;
  auto slice = [&](int t, bf16x8 (&fa)[4], bf16x8 (&fb0)[4], bf16x8 (&fan)[4], bf16x8 (&fb0n)[4]) {
    const int nxt = (cur == 2) ? 0 : cur + 1, nn = (nxt == 2) ? 0 : nxt + 1;
    bf16x8 fb1[4];
    stage(nn, t + 2 < nt ? t + 2 : nt - 1);
    __builtin_amdgcn_sched_barrier(0);
    rdB(fb1, (unsigned)cur * 24576u, 1);
    __builtin_amdgcn_sched_barrier(0);
#pragma unroll
    for (int ni = 0; ni < 4; ++ni)
#pragma unroll
      for (int mi = 0; mi < 4; ++mi) acc[mi][ni] = __builtin_amdgcn_mfma_f32_16x16x32_bf16(fa[mi], fb0[ni], acc[mi][ni], 0, 0, 0);
    __builtin_amdgcn_sched_barrier(0);
    WAIT_V(6);
    RAW_BARRIER();
    rdB(fb0n, (unsigned)nxt * 24576u, 0);
    __builtin_amdgcn_sched_barrier(0);
#pragma unroll
    for (int ni = 0; ni < 2; ++ni)
#pragma unroll
      for (int mi = 0; mi < 4; ++mi) acc[mi][4 + ni] = __builtin_amdgcn_mfma_f32_16x16x32_bf16(fa[mi], fb1[ni], acc[mi][4 + ni], 0, 0, 0);
    __builtin_amdgcn_sched_barrier(0);
    rdA(fan, (unsigned)nxt * 24576u);
    __builtin_amdgcn_sched_barrier(0);
#pragma unroll
    for (int ni = 2; ni < 4; ++ni)
#pragma unroll
      for (int mi = 0; mi < 4; ++mi) acc[mi][4 + ni] = __builtin_amdgcn_mfma_f32_16x16x32_bf16(fa[mi], fb1[ni], acc[mi][4 + ni], 0, 0, 0);
    __builtin_amdgcn_sched_barrier(0);
    cur = nxt;
  };
  rdA(xa, 0u);
  rdB(xb, 0u, 0);
  for (int t = 0; t < nt; t += 2) {
    slice(t, xa, xb, ya, yb);
    slice(t + 1, ya, yb, xa, xb);
  }
  WAIT_V(0);
  RAW_BARRIER();
  float* stg = (float*)(smem + w * 16896);
  EP e = ep;
  e.begin(col0 + (l & 15) * 8);
#pragma unroll
  for (int hm = 0; hm < 2; ++hm) {
#pragma unroll
    for (int m2 = 0; m2 < 2; ++m2)
#pragma unroll
      for (int ni = 0; ni < 8; ++ni)
#pragma unroll
        for (int i = 0; i < 4; ++i) stg[(16 * m2 + 4 * q4 + i) * 132 + 16 * ni + r16] = acc[2 * hm + m2][ni][i];
    wave_lds_fence();
#pragma unroll
    for (int ps = 0; ps < 8; ++ps) {
      const int rr = 4 * ps + (l >> 4), cc = (l & 15) * 8;
      float v[8];
      f32x4 v0 = *(const f32x4*)(stg + rr * 132 + cc), v1 = *(const f32x4*)(stg + rr * 132 + cc + 4);
#pragma unroll
      for (int jj = 0; jj < 4; ++jj) { v[jj] = v0[jj]; v[4 + jj] = v1[jj]; }
      float rs = 1.f;
      if constexpr (EP::kRstd) rs = rtab[64 * w + 32 * hm + rr];
      e(row0 + 64 * w + 32 * hm + rr, col0 + cc, v, l, rs);
    }
    wave_lds_fence();
  }
  __syncthreads();
}

struct ALPlain {
  static constexpr bool kRowScale = false;
  const u16* base_; int ld; int kseg; int off0; int off1;
  DI const char* base(int) const { return (const char*)base_; }
  DI unsigned off(int row, int k) const { return ((unsigned)row * (unsigned)ld + k + (k < kseg ? off0 : off1)) * 2u; }
  DI unsigned step32(int) const { return 64u * (unsigned)ld; }
  DI float rowscale(int, int) const { return 1.f; }
};
struct ALGlaOut {
  static constexpr bool kRowScale = true;
  const u16* base_; const float* ssq;
  DI const char* base(int) const { return (const char*)base_; }
  DI unsigned off(int row, int k) const { return ((unsigned)row * LDO + 1024 + k) * 2u; }
  DI unsigned step32(int) const { return 64u * LDO; }
  DI float rowscale(int row, int hd) const {
    const f32x4* p = (const f32x4*)(ssq + (size_t)row * 32 + hd * 8);
    f32x4 a = p[0], b = p[1];
    float s = a[0] + a[1] + a[2] + a[3] + b[0] + b[1] + b[2] + b[3];
    return __builtin_amdgcn_rsqf(s * (1.f / 256.f) + EPS);
  }
};
struct ALS5 {
  static constexpr bool kRowScale = false;
  const u16* proj; const u16* hp; int g;
  DI const char* base(int k0) const { return (const char*)(k0 < 512 ? proj : hp); }
  DI unsigned off(int row, int k) const {
    if (k < 512) return ((unsigned)(row * 32 + (k >> 4)) * LDE + 4096 + g * 16 + (k & 15)) * 2u;
    return (((unsigned)row * 32 + g) * 128 + (k - 512)) * 2u;
  }
  DI unsigned step32(int k) const { return k < 512 ? 2u * 32 * 32 * LDE : 2u * 32 * 32 * 128; }
  DI float rowscale(int, int) const { return 1.f; }
};

struct EPEvenIn {
  static constexpr bool kRstd = true;
  const float* part; u16* proj; const float* qg; const float* kg;
  float gsc[8];
  DI void begin(int col) {
    const float* g = (col < 1024 ? qg : kg) + (col & 127);
    const float sc = (col < 1024 ? 0.08838834764831845f * 1.44269504088896f : 1.f);
#pragma unroll
    for (int j = 0; j < 8; ++j) gsc[j] = (col < 2048) ? sc * g[j] : 1.f;
  }
  DI void operator()(int row, int col, float* v, int, float rs) const {
#pragma unroll
    for (int j = 0; j < 8; ++j) v[j] *= rs;
    if (col < 2048) {
      float s = 0.f;
#pragma unroll
      for (int j = 0; j < 8; ++j) s += v[j] * v[j];
      s = red16(s);
      const float rn = __builtin_amdgcn_rsqf(s * (1.f / 128.f) + EPS);
#pragma unroll
      for (int j = 0; j < 8; ++j) v[j] *= rn * gsc[j];
    }
    *(bf16x8*)((char*)proj + ((unsigned)row * LDE + col) * 2u) = pack8(v);
  }
};
struct EPOddIn {
  static constexpr bool kRstd = true;
  const float* part; u16* proj;
  DI void begin(int) {}
  DI void operator()(int row, int col, float* v, int, float rs) const {
#pragma unroll
    for (int j = 0; j < 8; ++j) v[j] *= rs;
    *(bf16x8*)((char*)proj + ((unsigned)row * LDO + col) * 2u) = pack8(v);
  }
};
struct EPOut {
  static constexpr bool kRstd = false;
  const float* xin; float* xout; u16* xb; float* part; bool dry;
  DI void begin(int) {}
  DI void operator()(int row, int col, float* v, int lane, float) const {
    const f32x4* xi = (const f32x4*)(xin + (size_t)row * 1024 + col);
    f32x4 a = xi[0], b = xi[1];
#pragma unroll
    for (int j = 0; j < 4; ++j) { v[j] += a[j]; v[4 + j] += b[j]; }
    if (dry) return;
    f32x4* xo = (f32x4*)(xout + (size_t)row * 1024 + col);
    f32x4 o0 = {v[0], v[1], v[2], v[3]}, o1 = {v[4], v[5], v[6], v[7]};
    xo[0] = o0; xo[1] = o1;
    *(bf16x8*)(xb + (size_t)row * LDX + col) = pack8(v);
    float s = 0.f;
#pragma unroll
    for (int j = 0; j < 8; ++j) s += v[j] * v[j];
    s = red16(s);
    if ((lane & 15) == 0) part[(size_t)row * 8 + (col >> 7)] = s;
  }
};
struct EPS5P {
  static constexpr bool kRstd = false;
  float* Sc; int g;
  DI void begin(int) {}
  DI void operator()(int row, int col, float* v, int, float) const {
    f32x4* o = (f32x4*)(Sc + ((size_t)row * 32 + g) * 128 + col);
    f32x4 o0 = {v[0], v[1], v[2], v[3]}, o1 = {v[4], v[5], v[6], v[7]};
    o[0] = o0; o[1] = o1;
  }
};
DI float gelu_tanh(float y) {
  const float u = 0.7978845608028654f * (y + 0.044715f * y * y * y);
  const float t = 1.f - 2.f * frcp(1.f + fexp(2.f * u));
  return 0.5f * y * (1.f + t);
}
struct EPS5Y {
  static constexpr bool kRstd = false;
  const u16* proj; u16* yb; const float* dsk; int g;
  DI void begin(int) {}
  DI void operator()(int row, int col, float* v, int, float) const {
    const int tok = row * 32 + (col >> 4), ch = g * 16 + (col & 15);
    float u[8]; unpack8(ldg8(proj + (size_t)tok * LDE + 4096 + ch), u);
#pragma unroll
    for (int j = 0; j < 8; ++j) v[j] = gelu_tanh(v[j] + dsk[ch + j] * u[j]);
    *(bf16x8*)(yb + (size_t)tok * LDY + ch) = pack8(v);
  }
};
struct EPGlu {
  static constexpr bool kRstd = false;
  u16* proj; const u16* yb; const float* bg; bool dry;
  DI void begin(int) {}
  DI void operator()(int row, int col, float* v, int, float) const {
    float y[8], z[8];
    unpack8(ldg8(yb + (size_t)row * LDY + col), y);
    u16* zp = proj + (size_t)row * LDE + 4608 + col;
    unpack8(ldg8(zp), z);
#pragma unroll
    for (int j = 0; j < 8; ++j) v[j] = y[j] * sigmoidf_(v[j] + bg[col + j]) * siluf_(z[j]);
    if (!dry) *(bf16x8*)zp = pack8(v);
  }
};

DI void transpose_tile(int tid, char* smem, const float* __restrict__ src, u16* __restrict__ dst, int K, int N, int ldk, int kt, int nt,
                       const float* scale, int smask) {
  float* t = (float*)smem;
  const int k0 = kt * 64, n0 = nt * 64;
#pragma unroll
  for (int i = 0; i < 16; ++i) {
    const int kk = (tid >> 6) + 4 * i, nn = tid & 63;
    float v = 0.f;
    if (n0 + nn < N) v = src[(size_t)(k0 + kk) * N + n0 + nn] * (scale ? scale[(k0 + kk) & smask] : 1.f);
    t[kk * 65 + nn] = v;
  }
  __syncthreads();
#pragma unroll
  for (int i = 0; i < 2; ++i) {
    const int c = tid + 256 * i;
    const int nn = c >> 3, k8 = (c & 7) * 8;
    float f[8];
#pragma unroll
    for (int j = 0; j < 8; ++j) f[j] = t[(k8 + j) * 65 + nn];
    *(bf16x8*)(dst + (size_t)(n0 + nn) * ldk + k0 + k8) = pack8(f);
  }
  __syncthreads();
}

DI void s5_setup(int tid, const Params& p, char* smem, int lg) {
  float* pw_re = (float*)smem;
  float* pw_im = pw_re + 33 * 64;
  float* bb_re = pw_im + 33 * 64;
  float* bb_im = bb_re + 1024;
  float* cc_re = bb_im + 1024;
  float* cc_im = cc_re + 1024;
  float* f_re = cc_im + 1024;
  float* f_im = f_re + 64;
  float* Kt = f_im + 64;
  if (tid < 64) {
    const float lr = p.lam_re[lg * 64 + tid], li = p.lam_im[lg * 64 + tid];
    const float dt = expf(p.log_dt[lg]);
    const float mag = expf(lr * dt);
    float sn, cs; sincosf(li * dt, &sn, &cs);
    const float br = mag * cs, bi = mag * sn;
    float pr = 1.f, pi = 0.f;
    for (int t = 0; t <= 32; ++t) {
      pw_re[t * 64 + tid] = pr; pw_im[t * 64 + tid] = pi;
      const float nr = pr * br - pi * bi, ni = pr * bi + pi * br;
      pr = nr; pi = ni;
    }
    p.LT()[(lg * 64 + tid) * 2] = pw_re[32 * 64 + tid];
    p.LT()[(lg * 64 + tid) * 2 + 1] = pw_im[32 * 64 + tid];
    const float nr = br - 1.f, ni = bi, den = 1.f / (lr * lr + li * li);
    f_re[tid] = (nr * lr + ni * li) * den;
    f_im[tid] = (ni * lr - nr * li) * den;
  }
  __syncthreads();
  for (int e = tid; e < 1024; e += 256) {
    const int n = e >> 4;
    const float br = p.b_re[(size_t)lg * 1024 + e], bi = p.b_im[(size_t)lg * 1024 + e];
    bb_re[e] = f_re[n] * br - f_im[n] * bi;
    bb_im[e] = f_re[n] * bi + f_im[n] * br;
    cc_re[e] = p.c_re[(size_t)lg * 1024 + e];
    cc_im[e] = p.c_im[(size_t)lg * 1024 + e];
  }
  __syncthreads();
  {
    const int pp = tid >> 4, pq = tid & 15;
    for (int t = 0; t < 32; ++t) {
      float s = 0.f;
      for (int n = 0; n < 64; ++n) {
        const float cr = cc_re[pp * 64 + n], ci = cc_im[pp * 64 + n];
        const float wr = pw_re[t * 64 + n], wi = pw_im[t * 64 + n];
        const float xr = cr * wr - ci * wi, xi = cr * wi + ci * wr;
        s += xr * bb_re[n * 16 + pq] - xi * bb_im[n * 16 + pq];
      }
      Kt[t * 256 + tid] = s;
    }
  }
  __syncthreads();
  u16* mq = p.WtMQ() + (size_t)lg * 512 * LDK6;
  for (int c = tid; c < 512 * 80; c += 256) {
    const int no = c / 80, k8 = (c % 80) * 8;
    const int t = no >> 4, pp = no & 15;
    float f[8];
    if (k8 < 512) {
      const int s = k8 >> 4, q0 = k8 & 15;
#pragma unroll
      for (int j = 0; j < 8; ++j) f[j] = (s <= t) ? Kt[(t - s) * 256 + pp * 16 + q0 + j] : 0.f;
    } else if (k8 < 576) {
      const int n0 = k8 - 512;
#pragma unroll
      for (int j = 0; j < 8; ++j) {
        const int n = n0 + j;
        f[j] = cc_re[pp * 64 + n] * pw_re[(t + 1) * 64 + n] - cc_im[pp * 64 + n] * pw_im[(t + 1) * 64 + n];
      }
    } else {
      const int n0 = k8 - 576;
#pragma unroll
      for (int j = 0; j < 8; ++j) {
        const int n = n0 + j;
        f[j] = -(cc_re[pp * 64 + n] * pw_im[(t + 1) * 64 + n] + cc_im[pp * 64 + n] * pw_re[(t + 1) * 64 + n]);
      }
    }
    *(bf16x8*)(mq + (size_t)no * LDK6 + k8) = pack8(f);
  }
  u16* wp = p.WtP() + (size_t)lg * 128 * LDK5;
  for (int c = tid; c < 128 * 64; c += 256) {
    const int nn = c >> 6, k8 = (c & 63) * 8;
    const int n = nn & 63, s = k8 >> 4, q0 = k8 & 15;
    const float wr = pw_re[(31 - s) * 64 + n], wi = pw_im[(31 - s) * 64 + n];
    float f[8];
#pragma unroll
    for (int j = 0; j < 8; ++j) {
      const float br = bb_re[n * 16 + q0 + j], bi = bb_im[n * 16 + q0 + j];
      f[j] = (nn < 64) ? (wr * br - wi * bi) : (wr * bi + wi * br);
    }
    *(bf16x8*)(wp + (size_t)nn * LDK5 + k8) = pack8(f);
  }
  __syncthreads();
}

DI void phase_prologue(int tid, int bid, const Params& p, char* smem) {
  const int nb = gridDim.x;
  const bool s5blk = (nb >= 128) && (bid >= nb - 64);
  if (nb >= 128) { if (s5blk) s5_setup(tid, p, smem, bid - (nb - 64)); }
  else for (int it = bid; it < 64; it += nb) s5_setup(tid, p, smem, it);
  const int nbw = (nb >= 128) ? nb - 64 : nb;
  if (s5blk) return;
  for (int lyr = 0; lyr < 2; ++lyr) {
    struct TJ { const float* src; u16* dst; int K, N, Npad, ldk; const float* sc; int smask; };
    const TJ jobs[5] = {
        {p.even_w_in + (size_t)lyr * 1024 * 5120, p.WtEin() + (size_t)lyr * 5120 * LDK1, 1024, 5120, 5120, LDK1, p.even_norm_g + lyr * 1024, 1023},
        {p.even_w_out + (size_t)lyr * 1536 * 1024, p.WtEout() + (size_t)lyr * 1024 * LDK15, 1536, 1024, 1024, LDK15, nullptr, 0},
        {p.w_glu + (size_t)lyr * 512 * 512, p.WtGlu() + (size_t)lyr * 512 * LDK5, 512, 512, 512, LDK5, nullptr, 0},
        {p.odd_w_in + (size_t)lyr * 1024 * 3088, p.WtOin() + (size_t)lyr * 3200 * LDK1, 1024, 3088, 3200, LDK1, p.odd_norm_g + lyr * 1024, 1023},
        {p.odd_w_out + (size_t)lyr * 1024 * 1024, p.WtOout() + (size_t)lyr * 1024 * LDK1, 1024, 1024, 1024, LDK1, p.gla_o_g + lyr * 256, 255}};
#pragma unroll
    for (int j = 0; j < 5; ++j) {
      const int nkt = jobs[j].K / 64, nnt = jobs[j].Npad / 64;
      for (int t = bid; t < nkt * nnt; t += nbw)
        transpose_tile(tid, smem, jobs[j].src, jobs[j].dst, jobs[j].K, jobs[j].N, jobs[j].ldk, t % nkt, t / nkt, jobs[j].sc, jobs[j].smask);
    }
    for (int e = bid * 256 + tid; e < 512 * 16; e += nbw * 256) {
      const int c = e >> 4, k = e & 15;
      p.WgT()[(size_t)lyr * 8192 + e] = f2bf(p.gla_w_gate[(size_t)lyr * 8192 + k * 512 + c]);
    }
  }
  const int w = tid >> 6, l = tid & 63;
  for (int row0 = (bid * 4 + w) * 4; row0 < NTOK; row0 += nbw * 16) {
    f32x4 va[4][4];
#pragma unroll
    for (int rr = 0; rr < 4; ++rr) {
      const f32x4* xr = (const f32x4*)(p.x + (size_t)(row0 + rr) * 1024);
#pragma unroll
      for (int i = 0; i < 2; ++i) { va[rr][2 * i] = xr[(l + 64 * i) * 2]; va[rr][2 * i + 1] = xr[(l + 64 * i) * 2 + 1]; }
    }
#pragma unroll
    for (int rr = 0; rr < 4; ++rr) {
      float s = 0.f;
#pragma unroll
      for (int i = 0; i < 2; ++i) {
        f32x4 a = va[rr][2 * i], b = va[rr][2 * i + 1];
        float f[8] = {a[0], a[1], a[2], a[3], b[0], b[1], b[2], b[3]};
#pragma unroll
        for (int j = 0; j < 8; ++j) s += f[j] * f[j];
        *(bf16x8*)(p.xb() + (size_t)(row0 + rr) * LDX + (l + 64 * i) * 8) = pack8(f);
      }
#pragma unroll
      for (int m = 1; m < 64; m <<= 1) s += __shfl_xor(s, m);
      if (l < 8) p.part()[(size_t)(row0 + rr) * 8 + l] = (l == 0) ? s : 0.f;
    }
  }
}

DI void attn_item(int tid, const Params& p, char* smem, int b, int hh, int qb, bool dry) {
  const int w = tid >> 6, l = tid & 63, r = l & 31, h = l >> 5;
  char* Ks = smem;
  char* Vs = smem + 16384;
  char* Qs = smem + 32768 + w * 8192;
  float* flags = (float*)(smem + 65536);
  float* stg = (float*)(smem + w * 8704);
  const u16* base = p.proj() + (size_t)b * SEQ * LDE;
  const int q0 = qb * 128, qw0 = q0 + 32 * w;
  {
    const u16* qp = base + (size_t)(qw0 + r) * LDE + hh * 128 + 8 * h;
#pragma unroll
    for (int s = 0; s < 8; ++s) *(bf16x8*)(Qs + off_b(r, 2 * s + h)) = ldg8(qp + 16 * s);
  }
  f32x16 ot[4];
#pragma unroll
  for (int d = 0; d < 4; ++d) ot[d] = zero16();
  float carry = 1.f, wmax = 1.f;
  const int lrow = tid >> 4, lch = tid & 15;
  bf16x8 rk[4], rv[4];
  auto gload = [&](int jt) {
    const u16* kp = base + (size_t)(jt * 64 + lrow) * LDE + 1024 + hh * 128 + lch * 8;
#pragma unroll
    for (int i = 0; i < 4; ++i) { rk[i] = ldg8(kp + (size_t)(16 * i) * LDE); rv[i] = ldg8(kp + (size_t)(16 * i) * LDE + 1024); }
  };
  const int trq = (l & 15) >> 2, trp = l & 3, trblk = (l >> 4) & 1;
  const unsigned fr = ((r & 3) << 2) | ((r >> 2) & 3);
  unsigned xs[8];
#pragma unroll
  for (int s = 0; s < 8; ++s) xs[s] = 16u * ((2 * s + h) ^ fr);
  const char* kbase = Ks + 256 * r;
  const char* qbase = Qs + 256 * r;
  const unsigned fv = (trq << 2) | h;
  unsigned vo[4];
#pragma unroll
  for (int d = 0; d < 4; ++d) vo[d] = 16u * ((4 * d + 2 * trblk + (trp >> 1)) ^ fv) + 8u * (trp & 1);
  const char* vbase = Vs + 256 * (4 * h + trq);
  int jt = 2 * qb + 1;
  gload(jt);
  for (; jt >= 0; --jt) {
#pragma unroll
    for (int i = 0; i < 4; ++i) {
      *(bf16x8*)(Ks + off_b(lrow + 16 * i, lch)) = rk[i];
      *(bf16x8*)(Vs + off_b(lrow + 16 * i, lch)) = rv[i];
    }
    RAW_BARRIER();
    if (jt > 0) gload(jt - 1);
    const int k0 = jt * 64;
    if (k0 <= qw0 && wmax >= 1e-30f) {
      f32x16 st[2];
      st[0] = zero16(); st[1] = zero16();
#pragma unroll
      for (int s = 0; s < 8; ++s) {
        const bf16x8 qf = *(const bf16x8*)(qbase + xs[s]);
#pragma unroll
        for (int kt = 0; kt < 2; ++kt) {
          bf16x8 a = *(const bf16x8*)(kbase + 8192 * kt + xs[s]);
          st[kt] = MFMA(a, qf, st[kt]);
        }
      }
      const bool need_mask = (k0 + 63 >= qw0);
      const int tq = qw0 + r;
      float running = carry;
#pragma unroll
      for (int kt = 1; kt >= 0; --kt) {
        float bt[16];
#pragma unroll
        for (int i = 0; i < 16; ++i) {
          float z2 = fminf(fmaxf(st[kt][i], -100.f), 100.f);
          float e = fexp2(-z2);
          float be = frcp(1.f + e);
          float om = e * be;
          if (need_mask && (k0 + 32 * kt + crow(i, h) >= tq)) { be = 0.f; om = 1.f; }
          bt[i] = be; st[kt][i] = om;
        }
#pragma unroll
        for (int rg = 3; rg >= 0; --rg) {
          const int i0 = 4 * rg;
          const float s2 = st[kt][i0 + 3], s1 = s2 * st[kt][i0 + 2], s0 = s1 * st[kt][i0 + 1], T = s0 * st[kt][i0];
          const float To = xor32(T, h);
          const float off = running * (h ? 1.f : To);
          st[kt][i0 + 3] = bt[i0 + 3] * off;
          st[kt][i0 + 2] = bt[i0 + 2] * off * s2;
          st[kt][i0 + 1] = bt[i0 + 1] * off * s1;
          st[kt][i0] = bt[i0] * off * s0;
          running = off * T * (h ? To : 1.f);
        }
      }
      carry = running;
#pragma unroll
      for (int ks = 0; ks < 4; ++ks) {
        float wv[8];
#pragma unroll
        for (int j = 0; j < 8; ++j) wv[j] = st[ks >> 1][8 * (ks & 1) + j];
        const bf16x8 bw = pack8(wv);
#pragma unroll
        for (int d = 0; d < 4; ++d) {
          s16x4 lo = tr_read(vbase + 4096 * ks + vo[d]);
          s16x4 hi = tr_read(vbase + 4096 * ks + 2048 + (vo[d] ^ 32u));
          ot[d] = MFMA(cat4(lo, hi), bw, ot[d]);
        }
      }
    }
    {
      float m = carry;
#pragma unroll
      for (int s = 1; s < 64; s <<= 1) m = fmaxf(m, __shfl_xor(m, s));
      if (l == 0) flags[w] = m;
      wmax = m;
    }
    RAW_BARRIER();
    const float mx = fmaxf(fmaxf(flags[0], flags[1]), fmaxf(flags[2], flags[3]));
    if (mx < 1e-30f) break;
  }
#pragma unroll
  for (int hf = 0; hf < 2; ++hf) {
#pragma unroll
    for (int dd = 0; dd < 2; ++dd)
#pragma unroll
      for (int rg = 0; rg < 4; ++rg) {
        f32x4 v = {ot[2 * hf + dd][4 * rg], ot[2 * hf + dd][4 * rg + 1], ot[2 * hf + dd][4 * rg + 2], ot[2 * hf + dd][4 * rg + 3]};
        *(f32x4*)(stg + r * 68 + 32 * dd + 8 * rg + 4 * h) = v;
      }
    wave_lds_fence();
#pragma unroll
    for (int ps = 0; ps < 4; ++ps) {
      const int id = l + 64 * ps, rr = id >> 3, c8 = (id & 7) * 8;
      f32x4 v0 = *(const f32x4*)(stg + rr * 68 + c8), v1 = *(const f32x4*)(stg + rr * 68 + c8 + 4);
      u16* zp = p.proj() + ((size_t)b * SEQ + qw0 + rr) * LDE + 3072 + hh * 128 + 64 * hf + c8;
      float z[8], o[8];
      unpack8(ldg8(zp), z);
#pragma unroll
      for (int j = 0; j < 4; ++j) { o[j] = v0[j] * siluf_(z[j]); o[4 + j] = v1[j] * siluf_(z[4 + j]); }
      if (!dry) *(bf16x8*)zp = pack8(o);
    }
    wave_lds_fence();
  }
  __syncthreads();
}

DI void gla_g1(int tid, const Params& p, char* smem, int lyr, int b, int n, int hh) {
  const int w = tid >> 6, l = tid & 63, r = l & 31, h = l >> 5;
  float* Ef = (float*)smem;
  u16* base = p.proj() + (size_t)b * SEQ * LDO;
  const bf16x8 wgf = ldg8(p.WgT() + (size_t)lyr * 8192 + (hh * 128 + 32 * w + r) * 16 + 8 * h);
  const float gbias = p.gla_b_gate[lyr * 512 + hh * 128 + 32 * w + r];
  bf16x8 rf[2], rq[4], rkk[4];
  const int erow = tid >> 4, ech = tid & 15;
#pragma unroll
  for (int mt = 0; mt < 2; ++mt) rf[mt] = ldg8(base + (size_t)(n * 64 + 32 * mt + r) * LDO + 3072 + 8 * h);
#pragma unroll
  for (int i = 0; i < 4; ++i) {
    const u16* rp = base + (size_t)(n * 64 + erow + 16 * i) * LDO + hh * 128 + ech * 8;
    rq[i] = ldg8(rp); rkk[i] = ldg8(rp + 512);
  }
  {
    f32x16 ga[2];
#pragma unroll
    for (int mt = 0; mt < 2; ++mt) ga[mt] = MFMA(rf[mt], wgf, zero16());
    float running = 0.f;
#pragma unroll
    for (int mt = 0; mt < 2; ++mt)
#pragma unroll
      for (int rg = 0; rg < 4; ++rg) {
        float c[4];
#pragma unroll
        for (int j = 0; j < 4; ++j) {
          const float x = ga[mt][4 * rg + j] + gbias;
          const float sp = fmaxf(-x, 0.f) + 0.6931471805599453f * flog2(1.f + fexp(-fabsf(x)));
          c[j] = -sp * (1.f / 16.f);
        }
        c[1] += c[0]; c[2] += c[1]; c[3] += c[2];
        const float T = c[3], To = xor32(T, h);
        const float off = running + (h ? To : 0.f);
#pragma unroll
        for (int j = 0; j < 4; ++j) Ef[(32 * mt + 8 * rg + 4 * h + j) * 128 + 32 * w + r] = fexp(off + c[j]);
        running = off + T + (h ? 0.f : To);
      }
  }
  __syncthreads();
#pragma unroll
  for (int i = 0; i < 4; ++i) {
    const int t = erow + 16 * i;
    const f32x4* ep = (const f32x4*)(Ef + t * 128 + ech * 8);
    f32x4 e0 = ep[0], e1 = ep[1];
    float e[8] = {e0[0], e0[1], e0[2], e0[3], e1[0], e1[1], e1[2], e1[3]};
    float q[8], k[8];
    unpack8(rq[i], q); unpack8(rkk[i], k);
#pragma unroll
    for (int j = 0; j < 8; ++j) { q[j] *= e[j] * 0.08838834764831845f; k[j] *= frcp(e[j]); }
    u16* rp = base + (size_t)(n * 64 + t) * LDO + hh * 128 + ech * 8;
    *(bf16x8*)rp = pack8(q);
    *(bf16x8*)(rp + 512) = pack8(k);
  }
  if (tid < 128) p.Sc()[(((size_t)b * 64 + n) * 4 + hh) * 128 + tid] = Ef[63 * 128 + tid];
  __syncthreads();
}

DI void gla_item(int tid, const Params& p, char* smem, int lyr, int b, int hh, int sl, bool dry) {
  const int w = tid >> 6, l = tid & 63, r = l & 31, h = l >> 5;
  char* vs = smem + 65536;
  char* sT = smem + 69632;
  u16* base = p.proj() + (size_t)b * SEQ * LDO;
  const float* elast = p.Sc() + ((size_t)b * 64 * 4 + hh) * 128;
  const int trq = (l & 15) >> 2, trp = l & 3, trblk = (l >> 4) & 1;
  const unsigned fr = ((r & 3) << 2) | ((r >> 2) & 3);
  auto xsf = [&](int s8) -> unsigned { unsigned v = 16u * ((2 * s8 + h) ^ fr); asm volatile("" : "+v"(v)); return v; };
  const unsigned rowb = 256u * r;
  const unsigned fk = (trq << 2) | (2 * h);
  const unsigned kb2 = 256u * (8 * h + trq);
  f32x16 sacc[2];
  sacc[0] = zero16(); sacc[1] = zero16();
  for (int e = tid; e < 2048; e += 256) ((unsigned*)sT)[e] = 0u;
  bf16x8 rvv;
  auto load_v = [&](int n) {
    rvv = ldg8(base + (size_t)(n * 64 + (tid >> 2)) * LDO + 1024 + hh * 256 + sl * 32 + (tid & 3) * 8);
  };
  auto dma_qk = [&](int n, int buf) {
    char* dq = smem + buf * 32768 + w * 4096;
#pragma unroll
    for (int i = 0; i < 4; ++i) {
      const int j = 4 * w + i;
      const int ch = (l & 15) ^ (((l >> 4) << 2) | (j & 3));
      const u16* src = base + (size_t)(n * 64 + 4 * j + (l >> 4)) * LDO + hh * 128 + ch * 8;
      __builtin_amdgcn_global_load_lds((const unsigned*)src, (unsigned*)(dq + i * 1024), 16, 0, 0);
      __builtin_amdgcn_global_load_lds((const unsigned*)(src + 512), (unsigned*)(dq + 16384 + i * 1024), 16, 0, 0);
    }
  };
  float el[2] = {1.f, 1.f};
  auto load_el = [&](int n) {
    if (w >= 2) {
#pragma unroll
      for (int ci = 0; ci < 2; ++ci) el[ci] = elast[(size_t)n * 512 + 32 * (2 * (w - 2) + ci) + r];
    }
  };
  u32x2 zreg[4];
  auto load_z = [&](int n) {
    const u16* zp = base + (size_t)(n * 64 + 32 * (w & 1) + r) * LDO + 2048 + hh * 256 + sl * 32 + 4 * h;
#pragma unroll
    for (int rg = 0; rg < 4; ++rg) zreg[rg] = *(const u32x2*)(zp + 8 * rg);
  };
  dma_qk(0, 0);
  load_v(0);
  load_el(0);
  dma_qk(1, 1);
  __builtin_amdgcn_sched_barrier(0);
  for (int n = 0; n < 64; ++n) {
    const char* qd = smem + (n & 1) * 32768;
    const char* ki = qd + 16384;
    {
      *(bf16x8*)(vs + (tid >> 2) * 64 + (tid & 3) * 16) = rvv;
      if (w >= 2 && n > 0 && !(dry && (PROBE_VARIANT == 12 || PROBE_VARIANT == 13))) {
        const int cb = 2 * (w - 2);
#pragma unroll
        for (int ci = 0; ci < 2; ++ci) {
          const int c = 32 * (cb + ci) + r;
#pragma unroll
          for (int i = 0; i < 16; ++i) *(u16*)(sT + off_b(crow(i, h), c >> 3) + (c & 7) * 2) = f2bf(sacc[ci][i]);
        }
      }
    }
    const float el0 = el[0], el1 = el[1];
    if (n + 1 < 64) WAIT_V(8); else WAIT_V(0);
    RAW_BARRIER();
    if (n + 1 < 64) { load_v(n + 1); load_el(n + 1); }
    const bool skip_o = dry && (PROBE_VARIANT == 11 || PROBE_VARIANT == 13), skip_s = dry && (PROBE_VARIANT == 12 || PROBE_VARIANT == 13);
    if (w < 2 ? skip_o : skip_s) {
    } else if (w < 2) {
      const int tt = w;
      load_z(n);
      f32x16 oa = zero16();
#pragma unroll
      for (int st = 0; st < 2; ++st) {
        if (st <= tt) {
          f32x16 sc = zero16();
#pragma unroll
          for (int hb = 0; hb < 2; ++hb) {
            bf16x8 af[4], bf[4];
#pragma unroll
            for (int q4 = 0; q4 < 4; ++q4) {
              af[q4] = *(const bf16x8*)(ki + rowb + 8192 * st + xsf(4 * hb + q4));
              bf[q4] = *(const bf16x8*)(qd + rowb + 8192 * tt + xsf(4 * hb + q4));
            }
            __builtin_amdgcn_sched_barrier(0);
#pragma unroll
            for (int q4 = 0; q4 < 4; ++q4) sc = MFMA(af[q4], bf[q4], sc);
            __builtin_amdgcn_sched_barrier(0);
          }
          if (st == tt) {
#pragma unroll
            for (int i = 0; i < 16; ++i)
              if (crow(i, h) > r) sc[i] = 0.f;
          }
          s16x4 vlo[2], vhi[2];
#pragma unroll
          for (int ks = 0; ks < 2; ++ks) {
            const int row0 = 32 * st + 16 * ks + 4 * h + trq;
            vlo[ks] = tr_read(vs + row0 * 64 + 32 * trblk + 8 * trp);
            vhi[ks] = tr_read(vs + (row0 + 8) * 64 + 32 * trblk + 8 * trp);
          }
#pragma unroll
          for (int ks = 0; ks < 2; ++ks) {
            float wv[8];
#pragma unroll
            for (int j = 0; j < 8; ++j) wv[j] = sc[8 * ks + j];
            oa = MFMA(cat4(vlo[ks], vhi[ks]), pack8(wv), oa);
          }
        }
      }
#pragma unroll
      for (int hb = 0; hb < 2; ++hb) {
        bf16x8 sf[4], bf[4];
#pragma unroll
        for (int q4 = 0; q4 < 4; ++q4) {
          sf[q4] = *(const bf16x8*)(sT + rowb + xsf(4 * hb + q4));
          bf[q4] = *(const bf16x8*)(qd + rowb + 8192 * tt + xsf(4 * hb + q4));
        }
        __builtin_amdgcn_sched_barrier(0);
#pragma unroll
        for (int q4 = 0; q4 < 4; ++q4) oa = MFMA(sf[q4], bf[q4], oa);
        __builtin_amdgcn_sched_barrier(0);
      }
      const size_t tok = (size_t)b * SEQ + n * 64 + 32 * tt + r;
      float ss = 0.f;
#pragma unroll
      for (int i = 0; i < 16; ++i) ss += oa[i] * oa[i];
      ss += xor32(ss, h);
      if (h == 0 && !dry) p.ssqg()[tok * 32 + hh * 8 + sl] = ss;
      u16* rowp = p.proj() + tok * LDO + hh * 256 + sl * 32;
#pragma unroll
      for (int rg = 0; rg < 4; ++rg) {
        const int dv0 = 8 * rg + 4 * h;
        const u32x2 zz = zreg[rg];
        float z0 = bflo(zz[0]), z1 = bfhi(zz[0]), z2 = bflo(zz[1]), z3 = bfhi(zz[1]);
        u32x2 o;
        o[0] = pk2(oa[4 * rg] * siluf_(z0), oa[4 * rg + 1] * siluf_(z1));
        o[1] = pk2(oa[4 * rg + 2] * siluf_(z2), oa[4 * rg + 3] * siluf_(z3));
        if (!dry) *(u32x2*)(rowp + 1024 + dv0) = o;
      }
    } else {
      const int cb = 2 * (w - 2);
#pragma unroll
      for (int ks = 0; ks < 4; ++ks) {
        const int row0 = 16 * ks + 8 * h + trq;
        s16x4 lo = tr_read(vs + row0 * 64 + 32 * trblk + 8 * trp);
        s16x4 hi = tr_read(vs + (row0 + 4) * 64 + 32 * trblk + 8 * trp);
        const bf16x8 av = cat4(lo, hi);
#pragma unroll
        for (int ci = 0; ci < 2; ++ci) {
          const unsigned ko = 16u * ((4 * (cb + ci) + 2 * trblk + (trp >> 1)) ^ fk) + 8u * (trp & 1);
          s16x4 blo = tr_read(ki + kb2 + 4096 * ks + ko);
          s16x4 bhi = tr_read(ki + kb2 + 4096 * ks + 1024 + (ko ^ 16u));
          sacc[ci] = MFMA(av, cat4(blo, bhi), sacc[ci]);
        }
      }
#pragma unroll
      for (int ci = 0; ci < 2; ++ci)
#pragma unroll
        for (int i = 0; i < 16; ++i) sacc[ci][i] *= (ci ? el1 : el0);
    }
    RAW_BARRIER();
    __builtin_amdgcn_sched_barrier(0);
    if (n + 2 < 64) dma_qk(n + 2, n & 1);
    __builtin_amdgcn_sched_barrier(0);
  }
  __syncthreads();
}

#define FOR_TILES_XCD4(MT, NT, mt, nt)                                                           \
  for (int s_ = (bid >> 3), mt = 0, nt = 0;                                                       \
       s_ < ((MT) >> 3) * (NT) &&                                                                 \
       (mt = (bid & 7) + 8 * (4 * (s_ / (4 * (NT))) + (s_ & 3)), nt = (s_ % (4 * (NT))) >> 2, true); s_ += (nb >> 3))
#define FOR_TILES_XCD(MT, NT, mt, nt)                                                          \
  for (int s_ = (bid >> 3), mt = 0, nt = 0;                                                     \
       s_ < ((MT) >> 3) * (NT) && (mt = (bid & 7) + 8 * (s_ / (NT)), nt = s_ % (NT), true); s_ += (nb >> 3))
DI void run_phase(const Params& p, char* smem, int ph, bool dry) {
  int tid = threadIdx.x, bid = blockIdx.x;
  asm volatile("" : "+v"(tid));
  asm volatile("" : "+s"(bid));
  const int nb = gridDim.x;
#ifdef ONLY
  if (ph != ONLY) return;
#endif
  if (ph == 0) { phase_prologue(tid, bid, p, smem); return; }
  const int q = ph - 1, cyc = q / 10, rem = q % 10;
  const int li = cyc;
  if (rem < 6) {
    const int lyr = li;
    switch (rem) {
      case 0: {
        ALPlain al{p.xb(), LDX, 1 << 30, 0, 0};
        EPEvenIn ep{p.part(), p.proj(), p.sb_q_g + lyr * 128, p.sb_k_g + lyr * 128};
        const u16* Bt = p.WtEin() + (size_t)lyr * 5120 * LDK1;
        FOR_TILES_XCD4(256, 40, mt, nt) gemm_tile_dma(tid, smem, al, Bt, LDK1, 1024, mt * 256, nt * 128, ep, dry ? PROBE_VARIANT : 0);
      } break;
      case 1: {
        for (int it = bid; it < 4096; it += nb) {
          const int qb = 31 - (it >> 7), bh = it & 127;
          attn_item(tid, p, smem, bh >> 3, bh & 7, qb, dry);
        }
        asm volatile("" : "+v"(tid));
        for (int t = bid; t < 256; t += nb) {
          const int g = t >> 3, mt = t & 7;
          ALS5 al{p.proj(), p.hp(), g};
          EPS5P ep{p.Sc(), g};
          gemm_tile_dma(tid, smem, al, p.WtP() + ((size_t)lyr * 32 + g) * 128 * LDK5, LDK5, 512, mt * 256, 0, ep);
        }
      } break;
      case 2: {
        for (int idx = bid * 256 + tid; idx < 16 * 32 * 64; idx += nb * 256) {
          const int n = idx & 63, g = (idx >> 6) & 31, b = idx >> 11;
          const float lr = p.LT()[((lyr * 32 + g) * 64 + n) * 2], lim = p.LT()[((lyr * 32 + g) * 64 + n) * 2 + 1];
          float hr = 0.f, hi = 0.f;
          for (int c0 = 0; c0 < 128; c0 += 16) {
            float sr[16], si[16];
#pragma unroll
            for (int j = 0; j < 16; ++j) {
              const size_t o = ((size_t)(b * 128 + c0 + j) * 32 + g) * 128;
              sr[j] = p.Sc()[o + n]; si[j] = p.Sc()[o + 64 + n];
            }
#pragma unroll
            for (int j = 0; j < 16; ++j) {
              const size_t o = ((size_t)(b * 128 + c0 + j) * 32 + g) * 128;
              p.hp()[o + n] = f2bf(hr); p.hp()[o + 64 + n] = f2bf(hi);
              const float nr = lr * hr - lim * hi + sr[j], ni = lr * hi + lim * hr + si[j];
              hr = nr; hi = ni;
            }
          }
        }
      } break;
      case 3: {
        for (int t = bid; t < 1024; t += nb) {
          const int g = t >> 5, mt = (t >> 2) & 7, nt = t & 3;
          ALS5 al{p.proj(), p.hp(), g};
          EPS5Y ep{p.proj(), p.yb(), p.s5_d + lyr * 512, g};
          gemm_tile_dma(tid, smem, al, p.WtMQ() + ((size_t)lyr * 32 + g) * 512 * LDK6, LDK6, 640, mt * 256, nt * 128, ep);
        }
      } break;
      case 4: {
        ALPlain al{p.yb(), LDY, 1 << 30, 0, 0};
        EPGlu ep{p.proj(), p.yb(), p.b_glu + lyr * 512, dry};
        const u16* Bt = p.WtGlu() + (size_t)lyr * 512 * LDK5;
        FOR_TILES_XCD(256, 4, mt, nt) gemm_tile_dma(tid, smem, al, Bt, LDK5, 512, mt * 256, nt * 128, ep);
      } break;
      default: {
        ALPlain al{p.proj(), LDE, 1024, 3072, 3584};
        EPOut ep{cyc == 0 ? p.x : p.out, p.out, p.xb(), p.part(), dry};
        const u16* Bt = p.WtEout() + (size_t)lyr * 1024 * LDK15;
        FOR_TILES_XCD(256, 8, mt, nt) gemm_tile_dma(tid, smem, al, Bt, LDK15, 1536, mt * 256, nt * 128, ep);
      } break;
    }
  } else {
    const int lyr = li;
    switch (rem - 6) {
      case 0: {
        ALPlain al{p.xb(), LDX, 1 << 30, 0, 0};
        EPOddIn ep{p.part(), p.proj()};
        const u16* Bt = p.WtOin() + (size_t)lyr * 3200 * LDK1;
        FOR_TILES_XCD4(256, 25, mt, nt) gemm_tile_dma(tid, smem, al, Bt, LDK1, 1024, mt * 256, nt * 128, ep);
      } break;
      case 1: {
        if (!dry) for (int it = bid; it < 4096; it += nb) gla_g1(tid, p, smem, lyr, it >> 8, (it >> 2) & 63, it & 3);
      } break;
      case 2: {
        for (int it = bid; it < 512; it += nb) {
          const int xcd = it & 7, j = it >> 3, bh = xcd * 8 + (j >> 3), slc = j & 7;
          gla_item(tid, p, smem, lyr, bh >> 2, bh & 3, slc, dry);
        }
      } break;
      default: {
        ALGlaOut al{p.proj(), p.ssqg()};
        EPOut ep{p.out, p.out, p.xb(), p.part(), dry};
        const u16* Bt = p.WtOout() + (size_t)lyr * 1024 * LDK1;
        FOR_TILES_XCD(256, 8, mt, nt) gemm_tile(tid, smem, al, Bt, LDK1, 1024, mt * 256, nt * 128, ep);
      } break;
    }
  }
}


#define XB_TMO      128
#define XB_XCNT(j)  (256  + 64 * (j))
#define XB_XSUB(j)  (1280 + 64 * (j))
#define XB_XGEN(j)  (2304 + 64 * (j))
#define XB_TOP      3328
#define XB_TOPGEN   3392
#define XCD_BAR_WORDS 3456
#define XB_SPIN_CAP (1u << 18)
#define LAS __attribute__((address_space(3)))
DI unsigned xb_ld(unsigned* p) { return __hip_atomic_load(p, __ATOMIC_RELAXED, __HIP_MEMORY_SCOPE_AGENT); }
DI unsigned xb_add(unsigned* p, unsigned v) { return __hip_atomic_fetch_add(p, v, __ATOMIC_RELAXED, __HIP_MEMORY_SCOPE_AGENT); }
DI unsigned xb_xcc_id() { return (unsigned)__builtin_amdgcn_s_getreg((3 << 11) | 20) & 0xFu; }
#define XB_SPIN(cond, bar) do { unsigned _sp = 0; while (cond) { __builtin_amdgcn_s_sleep(1); \
    if ((++_sp & 255u) == 0u) { if (xb_ld(&(bar)[XB_TMO])) break; if (_sp > XB_SPIN_CAP) { atomicAdd(&(bar)[XB_TMO], 1u); break; } } } } while (0)
struct XcdBarrier { unsigned* bar; unsigned x; volatile LAS unsigned* st; };
DI XcdBarrier xcd_barrier_post(unsigned* bar, volatile LAS unsigned* st) {
  XcdBarrier b; b.bar = bar; b.x = xb_xcc_id(); b.st = st;
  if (threadIdx.x == 0) (void)xb_add(&bar[XB_XCNT(b.x)], 1u);
  return b;
}
DI void xcd_barrier_complete(unsigned* bar, unsigned x, unsigned& nloc, unsigned& nx) {
  const unsigned G = gridDim.x * gridDim.y * gridDim.z;
  unsigned sum, cnt, mine, sp = 0u;
  for (;;) {
    sum = 0u; cnt = 0u; mine = 0u;
#pragma unroll
    for (unsigned j = 0; j < 16; ++j) { const unsigned c = xb_ld(&bar[XB_XCNT(j)]); sum += c; cnt += (c > 0u) ? 1u : 0u; mine = (j == x) ? c : mine; }
    if (sum == G) break;
    __builtin_amdgcn_s_sleep(1);
    if ((++sp & 255u) == 0u) { if (xb_ld(&bar[XB_TMO])) break; if (sp > XB_SPIN_CAP) { atomicAdd(&bar[XB_TMO], 1u); break; } }
  }
  nloc = mine > 0u ? mine : 1u; nx = cnt > 0u ? cnt : 1u;
}
DI void xcd_barrier(const XcdBarrier& b) {
  asm volatile("s_waitcnt vmcnt(0)" ::: "memory");
  __syncthreads();
  if (threadIdx.x == 0) {
    unsigned* bar = b.bar;
    __builtin_amdgcn_s_waitcnt(0);
    unsigned nloc = b.st[0], nx = b.st[1];
    if (nloc == 0u) { xcd_barrier_complete(bar, b.x, nloc, nx); b.st[0] = nloc; b.st[1] = nx; }
    const unsigned old = xb_add(&bar[XB_XSUB(b.x)], 1u);
    const unsigned gen = old / nloc;
    if (old + 1u == (gen + 1u) * nloc) {
      __builtin_amdgcn_fence(__ATOMIC_RELEASE, "agent");
      asm volatile("s_waitcnt vmcnt(0)" ::: "memory");
      const unsigned og = xb_add(&bar[XB_TOP], 1u);
      const unsigned tg = og / nx;
      if (og + 1u == (tg + 1u) * nx) xb_add(&bar[XB_TOPGEN], 1u);
      else XB_SPIN(xb_ld(&bar[XB_TOPGEN]) == tg, bar);
      __builtin_amdgcn_fence(__ATOMIC_ACQUIRE, "agent");
      xb_add(&bar[XB_XGEN(b.x)], 1u);
      asm volatile("s_waitcnt vmcnt(0)" ::: "memory");
    } else {
      XB_SPIN(xb_ld(&bar[XB_XGEN(b.x)]) == gen, bar);
      __builtin_amdgcn_fence(__ATOMIC_ACQUIRE, "agent");
      asm volatile("s_waitcnt vmcnt(0)" ::: "memory");
    }
  }
  __syncthreads();
}

constexpr int NPHASE = 21;

#ifndef PROBE_MASK
#define PROBE_MASK 0
#endif
DI int phase_kind(int ph) { if (ph == 0) return 0; const int rem = (ph - 1) % 10; return 1 + rem; }

#ifndef PROBE_SEL
#define PROBE_SEL -1
#endif
__global__ void __launch_bounds__(256, 2) fwd_kernel(Params p, int ph_lo, int ph_hi, int probe_mask, int probe_sel) {
  __shared__ __attribute__((aligned(16))) char smem[SMEM_BYTES];
  __shared__ uint4 xb_words;
  if (threadIdx.x == 0) xb_words = make_uint4(0u, 0u, 0u, 0u);
  __syncthreads();
  (void)xcd_barrier_post((unsigned*)(p.ws + OFF_bar), (volatile LAS unsigned*)&xb_words);
  for (int ph = ph_lo; ph < ph_hi; ++ph) {
    if (ph > ph_lo) {
      XcdBarrier xb;
      unsigned* bar_ = (unsigned*)(p.ws + OFF_bar);
      asm volatile("" : "+s"(bar_));
      xb.bar = bar_; xb.x = xb_xcc_id(); xb.st = (volatile LAS unsigned*)&xb_words;
      xcd_barrier(xb);
    }
    if (probe_mask < 0) cg::this_grid().sync();
    run_phase(p, smem, ph, false);
  }
}

extern "C" void kernel_launch(void* const* d_in, const int* in_sizes, int n_in, void* d_out, int out_size, void* d_ws,
                              size_t ws_size, hipStream_t stream) {
  Params p{};
  const float** fp = (const float**)&p;
  for (int i = 0; i < 22; ++i) fp[i] = (const float*)d_in[i];
  p.out = (float*)d_out;
  p.ws = (char*)d_ws;
  if (WS_TOTAL > ws_size) { fprintf(stderr, "workspace too small: have %zu\n", ws_size); return; }

  static int grid_blocks = 0;
  if (!grid_blocks) {
    int dev = 0, cus = 0, per_cu = 0;
    hipGetDevice(&dev);
    hipDeviceGetAttribute(&cus, hipDeviceAttributeMultiprocessorCount, dev);
    hipOccupancyMaxActiveBlocksPerMultiprocessor(&per_cu, fwd_kernel, 256, 0);
    if (per_cu > 2) per_cu = 2;
    grid_blocks = cus * per_cu;
    if (grid_blocks <= 0) grid_blocks = 256;
  }
#if COOP
  hipMemsetAsync(p.ws + OFF_bar, 0, (size_t)XCD_BAR_WORDS * 4, stream);
  int lo = 0, hi = NPHASE, pm = PROBE_MASK, psel = PROBE_SEL;
  void* args[] = {&p, &lo, &hi, &pm, &psel};
  hipError_t e = hipLaunchCooperativeKernel((void*)fwd_kernel, dim3(grid_blocks), dim3(256), args, 0, stream);
  if (e != hipSuccess) fprintf(stderr, "cooperative launch failed: %s (grid %d)\n", hipGetErrorString(e), grid_blocks);
#else
  for (int ph = 0; ph < NPHASE; ++ph) hipLaunchKernelGGL(fwd_kernel, dim3(grid_blocks), dim3(256), 0, stream, p, ph, ph + 1, 0, -1);
#endif
}
```

```cpp
#include <hip/hip_runtime.h>
#include <hip/hip_cooperative_groups.h>
#include <cstdio>
namespace cg = cooperative_groups;

#ifndef COOP
#define COOP 1
#endif

#ifndef PROBE_VARIANT
#define PROBE_VARIANT 0
#endif
#define DI __device__ __forceinline__
typedef unsigned short u16;
typedef __attribute__((ext_vector_type(8))) short bf16x8;
typedef __attribute__((ext_vector_type(4))) short s16x4;
typedef __attribute__((ext_vector_type(16))) float f32x16;
typedef __attribute__((ext_vector_type(4))) float f32x4;
typedef __attribute__((ext_vector_type(2))) float f32x2;
typedef __attribute__((ext_vector_type(4))) unsigned u32x4;
typedef __attribute__((ext_vector_type(2))) unsigned u32x2;
typedef __bf16 bf2_t __attribute__((ext_vector_type(2)));
typedef __attribute__((address_space(3))) s16x4 lds_s16x4;

#define MFMA(a, b, c) __builtin_amdgcn_mfma_f32_32x32x16_bf16((a), (b), (c), 0, 0, 0)

constexpr int NTOK = 65536;
constexpr int SEQ = 4096;
constexpr int LDE = 5184;
constexpr int LDO = 3264;
constexpr int LDX = 1088;
constexpr int LDY = 576;
constexpr int LDK1 = 1088, LDK15 = 1600, LDK5 = 576, LDK6 = 704;
constexpr float EPS = 1e-6f;
constexpr int SMEM_BYTES = 77824;

constexpr size_t al256(size_t x) { return (x + 255) & ~(size_t)255; }
constexpr size_t OFF_WtEin = 0;
constexpr size_t OFF_WtEout = OFF_WtEin + al256((size_t)2 * 5120 * LDK1 * 2);
constexpr size_t OFF_WtGlu = OFF_WtEout + al256((size_t)2 * 1024 * LDK15 * 2);
constexpr size_t OFF_WtOin = OFF_WtGlu + al256((size_t)2 * 512 * LDK5 * 2);
constexpr size_t OFF_WtOout = OFF_WtOin + al256((size_t)2 * 3200 * LDK1 * 2);
constexpr size_t OFF_WgT = OFF_WtOout + al256((size_t)2 * 1024 * LDK1 * 2);
constexpr size_t OFF_WtMQ = OFF_WgT + al256((size_t)2 * 512 * 16 * 2);
constexpr size_t OFF_WtP = OFF_WtMQ + al256((size_t)2 * 32 * 512 * LDK6 * 2);
constexpr size_t OFF_LT = OFF_WtP + al256((size_t)2 * 32 * 128 * LDK5 * 2);
constexpr size_t OFF_xb = OFF_LT + al256((size_t)2 * 32 * 64 * 2 * 4);
constexpr size_t OFF_part = OFF_xb + al256((size_t)NTOK * LDX * 2);
constexpr size_t OFF_proj = OFF_part + al256((size_t)NTOK * 8 * 4);
constexpr size_t OFF_yb = OFF_proj + al256((size_t)NTOK * LDE * 2);
constexpr size_t OFF_Sc = OFF_yb + al256((size_t)NTOK * LDY * 2);
constexpr size_t OFF_hp = OFF_Sc + al256((size_t)2048 * 32 * 128 * 4);
constexpr size_t OFF_ssqg = OFF_hp + al256((size_t)2048 * 32 * 128 * 2);
constexpr size_t OFF_bar = OFF_ssqg + al256((size_t)NTOK * 32 * 4);
constexpr size_t WS_TOTAL = OFF_bar + al256((size_t)3456 * 4);

struct Params {
  const float *x, *even_norm_g, *even_w_in, *sb_q_g, *sb_k_g, *lam_re, *lam_im, *log_dt, *b_re, *b_im, *c_re, *c_im,
      *s5_d, *w_glu, *b_glu, *even_w_out, *odd_norm_g, *odd_w_in, *gla_w_gate, *gla_b_gate, *gla_o_g, *odd_w_out;
  float* out;
  char* ws;
  DI u16* WtEin() const { return (u16*)(ws + OFF_WtEin); }
  DI u16* WtEout() const { return (u16*)(ws + OFF_WtEout); }
  DI u16* WtGlu() const { return (u16*)(ws + OFF_WtGlu); }
  DI u16* WtOin() const { return (u16*)(ws + OFF_WtOin); }
  DI u16* WtOout() const { return (u16*)(ws + OFF_WtOout); }
  DI u16* WgT() const { return (u16*)(ws + OFF_WgT); }
  DI u16* WtMQ() const { return (u16*)(ws + OFF_WtMQ); }
  DI u16* WtP() const { return (u16*)(ws + OFF_WtP); }
  DI float* LT() const { return (float*)(ws + OFF_LT); }
  DI u16* xb() const { return (u16*)(ws + OFF_xb); }
  DI float* part() const { return (float*)(ws + OFF_part); }
  DI u16* proj() const { return (u16*)(ws + OFF_proj); }
  DI u16* yb() const { return (u16*)(ws + OFF_yb); }
  DI float* Sc() const { return (float*)(ws + OFF_Sc); }
  DI u16* hp() const { return (u16*)(ws + OFF_hp); }
  DI float* ssqg() const { return (float*)(ws + OFF_ssqg); }
};

DI unsigned pk2(float a, float b) { f32x2 v = {a, b}; return __builtin_bit_cast(unsigned, __builtin_convertvector(v, bf2_t)); }
DI u16 f2bf(float a) { return (u16)(pk2(a, 0.f) & 0xffffu); }
DI float bflo(unsigned u) { return __uint_as_float(u << 16); }
DI float bfhi(unsigned u) { return __uint_as_float(u & 0xffff0000u); }
DI int crow(int i, int h) { return (i & 3) + 8 * (i >> 2) + 4 * h; }
DI float fexp2(float x) { return __builtin_amdgcn_exp2f(x); }
DI float flog2(float x) { return __builtin_amdgcn_logf(x); }
DI float frcp(float x) { return __builtin_amdgcn_rcpf(x); }
DI float fexp(float x) { return fexp2(x * 1.44269504088896f); }
DI float sigmoidf_(float x) { return frcp(1.f + fexp(-x)); }
DI float siluf_(float x) { return x * sigmoidf_(x); }
DI unsigned off_b(unsigned row, unsigned ch) { return 256u * row + 16u * (ch ^ (((row & 3) << 2) | ((row >> 2) & 3))); }
DI unsigned off_g(unsigned row, unsigned ch) { return 128u * row + 16u * (ch ^ ((row >> 1) & 7)); }
DI s16x4 tr_read(const char* p) { return __builtin_amdgcn_ds_read_tr16_b64_v4i16((lds_s16x4*)p); }
DI bf16x8 cat4(s16x4 lo, s16x4 hi) { return __builtin_shufflevector(lo, hi, 0, 1, 2, 3, 4, 5, 6, 7); }
DI f32x16 zero16() { f32x16 z;
#pragma unroll
  for (int i = 0; i < 16; ++i) z[i] = 0.f; return z; }
DI bf16x8 pack8(const float* f) {
  u32x4 r; r[0] = pk2(f[0], f[1]); r[1] = pk2(f[2], f[3]); r[2] = pk2(f[4], f[5]); r[3] = pk2(f[6], f[7]);
  return __builtin_bit_cast(bf16x8, r);
}
DI void unpack8(bf16x8 v, float* f) {
  u32x4 r = __builtin_bit_cast(u32x4, v);
#pragma unroll
  for (int i = 0; i < 4; ++i) { f[2 * i] = bflo(r[i]); f[2 * i + 1] = bfhi(r[i]); }
}
DI bf16x8 ldg8(const u16* p) { return *(const bf16x8*)p; }
template <int CTRL> DI float dpp_mov(float v) {
  return __int_as_float(__builtin_amdgcn_update_dpp(0, __float_as_int(v), CTRL, 0xF, 0xF, true));
}
DI float red16(float v) {
  v += dpp_mov<0xB1>(v);
  v += dpp_mov<0x4E>(v);
  v += dpp_mov<0x141>(v);
  v += dpp_mov<0x140>(v);
  return v;
}
typedef unsigned u32x2v __attribute__((ext_vector_type(2)));
DI float xor32(float v, int h) {
  const u32x2v r = __builtin_amdgcn_permlane32_swap(__float_as_uint(v), __float_as_uint(v), false, false);
  return __uint_as_float(h ? r[0] : r[1]);
}
DI void wave_lds_fence() { __builtin_amdgcn_fence(__ATOMIC_RELEASE, "wavefront"); __builtin_amdgcn_wave_barrier(); __builtin_amdgcn_fence(__ATOMIC_ACQUIRE, "wavefront"); }

DI float row_rstd(const float* part, int row) {
  const f32x4* p = (const f32x4*)(part + (size_t)row * 8);
  f32x4 a = p[0], b = p[1];
  float s = a[0] + a[1] + a[2] + a[3] + b[0] + b[1] + b[2] + b[3];
  return __builtin_amdgcn_rsqf(s * (1.f / 1024.f) + EPS);
}

template <class AL, class EP>
DI void gemm_tile(int tid, char* smem, const AL& al, const u16* __restrict__ Bt, int ldb, int K, int row0, int col0, const EP& ep) {
  const int w = tid >> 6, l = tid & 63, r = l & 31, h = l >> 5;
  char* As = smem;
  char* Bs = smem + 32768;
  f32x16 acc[2][4];
#pragma unroll
  for (int mi = 0; mi < 2; ++mi)
#pragma unroll
    for (int ni = 0; ni < 4; ++ni) acc[mi][ni] = zero16();
  const int lrow = tid >> 3, lch = tid & 7;
  bf16x8 ra[8], rb[4];
  const unsigned boff = ((unsigned)(col0 + lrow) * (unsigned)ldb + lch * 8) * 2u;
  const unsigned bstep = 64u * (unsigned)ldb;
  auto gload = [&](int k0) {
    const char* ab = al.base(k0);
    unsigned ao = al.off(row0 + lrow, k0 + lch * 8);
    unsigned st = al.step32(k0), bs = bstep, bo = boff + 2u * k0;
    asm volatile("" : "+s"(st), "+s"(bs));
    asm volatile("" : "+v"(ao), "+v"(bo));
#pragma unroll
    for (int i = 0; i < 8; ++i) ra[i] = *(const bf16x8*)(ab + (ao + i * st));
#pragma unroll
    for (int i = 0; i < 4; ++i) rb[i] = *(const bf16x8*)((const char*)Bt + (bo + i * bs));
  };
  const unsigned wbase = off_g(lrow, lch);
  unsigned xo[4];
#pragma unroll
  for (int s = 0; s < 4; ++s) xo[s] = 16u * ((2 * s + h) ^ ((r >> 1) & 7));
  const unsigned abase = 128u * (64 * w + r), bbase = 32768u + 128u * r;
  gload(0);
  for (int k0 = 0; k0 < K; k0 += 64) {
    if constexpr (AL::kRowScale) {
      float* rsl = (float*)(smem + 49152);
      if ((k0 & 255) == 0) {
        rsl[tid] = al.rowscale(row0 + tid, k0 >> 8);
        __syncthreads();
      }
#pragma unroll
      for (int i = 0; i < 8; ++i) {
        const float sc = rsl[lrow + 32 * i];
        float f[8]; unpack8(ra[i], f);
#pragma unroll
        for (int j = 0; j < 8; ++j) f[j] *= sc;
        ra[i] = pack8(f);
      }
    }
#pragma unroll
    for (int i = 0; i < 8; ++i) *(bf16x8*)(As + wbase + 4096 * i) = ra[i];
#pragma unroll
    for (int i = 0; i < 4; ++i) *(bf16x8*)(Bs + wbase + 4096 * i) = rb[i];
    __syncthreads();
    if (k0 + 64 < K) gload(k0 + 64);
#pragma unroll
    for (int s = 0; s < 4; ++s) {
      bf16x8 a[2], b[4];
#pragma unroll
      for (int mi = 0; mi < 2; ++mi) a[mi] = *(const bf16x8*)(smem + abase + 4096 * mi + xo[s]);
#pragma unroll
      for (int ni = 0; ni < 4; ++ni) b[ni] = *(const bf16x8*)(smem + bbase + 4096 * ni + xo[s]);
#pragma unroll
      for (int mi = 0; mi < 2; ++mi)
#pragma unroll
        for (int ni = 0; ni < 4; ++ni) acc[mi][ni] = MFMA(a[mi], b[ni], acc[mi][ni]);
      __builtin_amdgcn_sched_barrier(0);
    }
    __syncthreads();
  }
  float* stg = (float*)(smem + w * 16896);
#pragma unroll
  for (int mi = 0; mi < 2; ++mi) {
#pragma unroll
    for (int ni = 0; ni < 4; ++ni)
#pragma unroll
      for (int i = 0; i < 16; ++i) stg[crow(i, h) * 132 + 32 * ni + r] = acc[mi][ni][i];
    wave_lds_fence();
#pragma unroll
    for (int ps = 0; ps < 8; ++ps) {
      const int rr = 4 * ps + (l >> 4), cc = (l & 15) * 8;
      float v[8];
      f32x4 v0 = *(const f32x4*)(stg + rr * 132 + cc), v1 = *(const f32x4*)(stg + rr * 132 + cc + 4);
#pragma unroll
      for (int j = 0; j < 4; ++j) { v[j] = v0[j]; v[4 + j] = v1[j]; }
      ep(row0 + 64 * w + 32 * mi + rr, col0 + cc, v, l, 1.f);
    }
    wave_lds_fence();
  }
  __syncthreads();
}

#define WAIT_V(n) asm volatile("s_waitcnt vmcnt(%0)" ::"n"(n) : "memory")
#define RAW_BARRIER() do { asm volatile("s_waitcnt lgkmcnt(0)" ::: "memory"); __builtin_amdgcn_s_barrier(); } while (0)
template <class AL, class EP>
DI void gemm_tile_dma(int tid, char* smem, const AL& al, const u16* __restrict__ Bt, int ldb, int K, int row0, int col0, const EP& ep, int variant = 0) {
  typedef __attribute__((ext_vector_type(4))) float f32x4v;
  const int w = tid >> 6, l = tid & 63, r16 = l & 15, q4 = l >> 4;
  f32x4v acc[4][8];
#pragma unroll
  for (int mi = 0; mi < 4; ++mi)
#pragma unroll
    for (int ni = 0; ni < 8; ++ni) { acc[mi][ni][0] = 0.f; acc[mi][ni][1] = 0.f; acc[mi][ni][2] = 0.f; acc[mi][ni][3] = 0.f; }
  auto Gf = [](int x) -> int { return (0x78 >> (2 * x)) & 3; };
  const int lch = (l & 3) ^ Gf((l >> 4) & 3);
  const unsigned boff = ((unsigned)(col0 + 32 * w + (l >> 2)) * (unsigned)ldb + lch * 8) * 2u;
  const unsigned bstep = 32u * (unsigned)ldb;
  auto stage = [&](int buf, int kt) {
    const int k0 = kt * 32;
    const char* ab = al.base(k0);
    unsigned ao = al.off(row0 + 64 * w + (l >> 2), k0 + lch * 8);
    unsigned st = al.step32(k0) >> 1, bs = bstep, bo = boff + 2u * k0;
    asm volatile("" : "+s"(st), "+s"(bs));
    asm volatile("" : "+v"(ao), "+v"(bo));
    char* sa = smem + buf * 24576 + w * 4096;
    char* sb = smem + buf * 24576 + 16384 + w * 2048;
#pragma unroll
    for (int i = 0; i < 4; ++i)
      __builtin_amdgcn_global_load_lds((const unsigned*)(ab + (ao + i * st)), (unsigned*)(sa + i * 1024), 16, 0, 0);
#pragma unroll
    for (int i = 0; i < 2; ++i)
      __builtin_amdgcn_global_load_lds((const unsigned*)((const char*)Bt + (bo + i * bs)), (unsigned*)(sb + i * 1024), 16, 0, 0);
  };
  const unsigned xo = 16u * (unsigned)(q4 ^ Gf((r16 >> 2) & 3));
  const unsigned fbase = 64u * r16 + xo;
  const unsigned wofs = 4096u * (unsigned)__builtin_amdgcn_readfirstlane(w);
  const int nt = K >> 5;
  float* rtab = (float*)(smem + 73728);
  if constexpr (EP::kRstd) rtab[tid] = row_rstd(ep.part, row0 + tid);
  stage(0, 0);
  stage(1, 1);
  WAIT_V(6);
  RAW_BARRIER();
  bf16x8 xa[4], xb[4], ya[4], yb[4];
  auto rdA = [&](bf16x8 (&fa)[4], unsigned bufoff) {
#pragma unroll
    for (int mi = 0; mi < 4; ++mi) fa[mi] = *(const bf16x8*)(smem + (bufoff + wofs + 1024u * mi) + fbase);
  };
  auto rdB = [&](bf16x8 (&fb)[4], unsigned bufoff, int hf) {
#pragma unroll
    for (int ni = 0; ni < 4; ++ni) fb[ni] = *(const bf16x8*)(smem + (bufoff + 16384u + 1024u * (4 * hf + ni)) + fbase);
  };
  int cur = 0;
  auto slice = [&](int t, bf16x8 (&fa)[4], bf16x8 (&fb0)[4], bf16x8 (&fan)[4], bf16x8 (&fb0n)[4]) {
    const int nxt = (cur == 2) ? 0 : cur + 1, nn = (nxt == 2) ? 0 : nxt + 1;
    bf16x8 fb1[4];
    stage(nn, t + 2 < nt ? t + 2 : nt - 1);
    __builtin_amdgcn_sched_barrier(0);
    rdB(fb1, (unsigned)cur * 24576u, 1);
    __builtin_amdgcn_sched_barrier(0);
#pragma unroll
    for (int ni = 0; ni < 4; ++ni)
#pragma unroll
      for (int mi = 0; mi < 4; ++mi) acc[mi][ni] = __builtin_amdgcn_mfma_f32_16x16x32_bf16(fa[mi], fb0[ni], acc[mi][ni], 0, 0, 0);
    __builtin_amdgcn_sched_barrier(0);
    WAIT_V(6);
    RAW_BARRIER();
    rdB(fb0n, (unsigned)nxt * 24576u, 0);
    __builtin_amdgcn_sched_barrier(0);
#pragma unroll
    for (int ni = 0; ni < 2; ++ni)
#pragma unroll
      for (int mi = 0; mi < 4; ++mi) acc[mi][4 + ni] = __builtin_amdgcn_mfma_f32_16x16x32_bf16(fa[mi], fb1[ni], acc[mi][4 + ni], 0, 0, 0);
    __builtin_amdgcn_sched_barrier(0);
    rdA(fan, (unsigned)nxt * 24576u);
    __builtin_amdgcn_sched_barrier(0);
#pragma unroll
    for (int ni = 2; ni < 4; ++ni)
#pragma unroll
      for (int mi = 0; mi < 4; ++mi) acc[mi][4 + ni] = __builtin_amdgcn_mfma_f32_16x16x32_bf16(fa[mi], fb1[ni], acc[mi][4 + ni], 0, 0, 0);
    __builtin_amdgcn_sched_barrier(0);
    cur = nxt;
  };
  rdA(xa, 0u);
  rdB(xb, 0u, 0);
  for (int t = 0; t < nt; t += 2) {
    slice(t, xa, xb, ya, yb);
    slice(t + 1, ya, yb, xa, xb);
  }
  WAIT_V(0);
  RAW_BARRIER();
  float* stg = (float*)(smem + w * 16896);
  EP e = ep;
  e.begin(col0 + (l & 15) * 8);
#pragma unroll
  for (int hm = 0; hm < 2; ++hm) {
#pragma unroll
    for (int m2 = 0; m2 < 2; ++m2)
#pragma unroll
      for (int ni = 0; ni < 8; ++ni)
#pragma unroll
        for (int i = 0; i < 4; ++i) stg[(16 * m2 + 4 * q4 + i) * 132 + 16 * ni + r16] = acc[2 * hm + m2][ni][i];
    wave_lds_fence();
#pragma unroll
    for (int ps = 0; ps < 8; ++ps) {
      const int rr = 4 * ps + (l >> 4), cc = (l & 15) * 8;
      float v[8];
      f32x4 v0 = *(const f32x4*)(stg + rr * 132 + cc), v1 = *(const f32x4*)(stg + rr * 132 + cc + 4);
#pragma unroll
      for (int jj = 0; jj < 4; ++jj) { v[jj] = v0[jj]; v[4 + jj] = v1[jj]; }
      float rs = 1.f;
      if constexpr (EP::kRstd) rs = rtab[64 * w + 32 * hm + rr];
      e(row0 + 64 * w + 32 * hm + rr, col0 + cc, v, l, rs);
    }
    wave_lds_fence();
  }
  __syncthreads();
}

struct ALPlain {
  static constexpr bool kRowScale = false;
  const u16* base_; int ld; int kseg; int off0; int off1;
  DI const char* base(int) const { return (const char*)base_; }
  DI unsigned off(int row, int k) const { return ((unsigned)row * (unsigned)ld + k + (k < kseg ? off0 : off1)) * 2u; }
  DI unsigned step32(int) const { return 64u * (unsigned)ld; }
  DI float rowscale(int, int) const { return 1.f; }
};
struct ALGlaOut {
  static constexpr bool kRowScale = true;
  const u16* base_; const float* ssq;
  DI const char* base(int) const { return (const char*)base_; }
  DI unsigned off(int row, int k) const { return ((unsigned)row * LDO + 1024 + k) * 2u; }
  DI unsigned step32(int) const { return 64u * LDO; }
  DI float rowscale(int row, int hd) const {
    const f32x4* p = (const f32x4*)(ssq + (size_t)row * 32 + hd * 8);
    f32x4 a = p[0], b = p[1];
    float s = a[0] + a[1] + a[2] + a[3] + b[0] + b[1] + b[2] + b[3];
    return __builtin_amdgcn_rsqf(s * (1.f / 256.f) + EPS);
  }
};
struct ALS5 {
  static constexpr bool kRowScale = false;
  const u16* proj; const u16* hp; int g;
  DI const char* base(int k0) const { return (const char*)(k0 < 512 ? proj : hp); }
  DI unsigned off(int row, int k) const {
    if (k < 512) return ((unsigned)(row * 32 + (k >> 4)) * LDE + 4096 + g * 16 + (k & 15)) * 2u;
    return (((unsigned)row * 32 + g) * 128 + (k - 512)) * 2u;
  }
  DI unsigned step32(int k) const { return k < 512 ? 2u * 32 * 32 * LDE : 2u * 32 * 32 * 128; }
  DI float rowscale(int, int) const { return 1.f; }
};

struct EPEvenIn {
  static constexpr bool kRstd = true;
  const float* part; u16* proj; const float* qg; const float* kg;
  float gsc[8];
  DI void begin(int col) {
    const float* g = (col < 1024 ? qg : kg) + (col & 127);
    const float sc = (col < 1024 ? 0.08838834764831845f * 1.44269504088896f : 1.f);
#pragma unroll
    for (int j = 0; j < 8; ++j) gsc[j] = (col < 2048) ? sc * g[j] : 1.f;
  }
  DI void operator()(int row, int col, float* v, int, float rs) const {
#pragma unroll
    for (int j = 0; j < 8; ++j) v[j] *= rs;
    if (col < 2048) {
      float s = 0.f;
#pragma unroll
      for (int j = 0; j < 8; ++j) s += v[j] * v[j];
      s = red16(s);
      const float rn = __builtin_amdgcn_rsqf(s * (1.f / 128.f) + EPS);
#pragma unroll
      for (int j = 0; j < 8; ++j) v[j] *= rn * gsc[j];
    }
    __builtin_nontemporal_store(pack8(v), (bf16x8*)((char*)proj + ((unsigned)row * LDE + col) * 2u));
  }
};
struct EPOddIn {
  static constexpr bool kRstd = true;
  const float* part; u16* proj;
  DI void begin(int) {}
  DI void operator()(int row, int col, float* v, int, float rs) const {
#pragma unroll
    for (int j = 0; j < 8; ++j) v[j] *= rs;
    __builtin_nontemporal_store(pack8(v), (bf16x8*)((char*)proj + ((unsigned)row * LDO + col) * 2u));
  }
};
struct EPOut {
  static constexpr bool kRstd = false;
  const float* xin; float* xout; u16* xb; float* part; bool dry;
  DI void begin(int) {}
  DI void operator()(int row, int col, float* v, int lane, float) const {
    const f32x4* xi = (const f32x4*)(xin + (size_t)row * 1024 + col);
    f32x4 a = __builtin_nontemporal_load(xi), b = __builtin_nontemporal_load(xi + 1);
#pragma unroll
    for (int j = 0; j < 4; ++j) { v[j] += a[j]; v[4 + j] += b[j]; }
    if (dry) return;
    f32x4* xo = (f32x4*)(xout + (size_t)row * 1024 + col);
    f32x4 o0 = {v[0], v[1], v[2], v[3]}, o1 = {v[4], v[5], v[6], v[7]};
    __builtin_nontemporal_store(o0, xo); __builtin_nontemporal_store(o1, xo + 1);
    *(bf16x8*)(xb + (size_t)row * LDX + col) = pack8(v);
    float s = 0.f;
#pragma unroll
    for (int j = 0; j < 8; ++j) s += v[j] * v[j];
    s = red16(s);
    if ((lane & 15) == 0) part[(size_t)row * 8 + (col >> 7)] = s;
  }
};
struct EPS5P {
  static constexpr bool kRstd = false;
  float* Sc; int g;
  DI void begin(int) {}
  DI void operator()(int row, int col, float* v, int, float) const {
    f32x4* o = (f32x4*)(Sc + ((size_t)row * 32 + g) * 128 + col);
    f32x4 o0 = {v[0], v[1], v[2], v[3]}, o1 = {v[4], v[5], v[6], v[7]};
    o[0] = o0; o[1] = o1;
  }
};
DI float gelu_tanh(float y) {
  const float u = 0.7978845608028654f * (y + 0.044715f * y * y * y);
  const float t = 1.f - 2.f * frcp(1.f + fexp(2.f * u));
  return 0.5f * y * (1.f + t);
}
struct EPS5Y {
  static constexpr bool kRstd = false;
  const u16* proj; u16* yb; const float* dsk; int g;
  DI void begin(int) {}
  DI void operator()(int row, int col, float* v, int, float) const {
    const int tok = row * 32 + (col >> 4), ch = g * 16 + (col & 15);
    float u[8]; unpack8(ldg8(proj + (size_t)tok * LDE + 4096 + ch), u);
#pragma unroll
    for (int j = 0; j < 8; ++j) v[j] = gelu_tanh(v[j] + dsk[ch + j] * u[j]);
    *(bf16x8*)(yb + (size_t)tok * LDY + ch) = pack8(v);
  }
};
struct EPGlu {
  static constexpr bool kRstd = false;
  u16* proj; const u16* yb; const float* bg; bool dry;
  DI void begin(int) {}
  DI void operator()(int row, int col, float* v, int, float) const {
    float y[8], z[8];
    unpack8(ldg8(yb + (size_t)row * LDY + col), y);
    u16* zp = proj + (size_t)row * LDE + 4608 + col;
    unpack8(ldg8(zp), z);
#pragma unroll
    for (int j = 0; j < 8; ++j) v[j] = y[j] * sigmoidf_(v[j] + bg[col + j]) * siluf_(z[j]);
    if (!dry) *(bf16x8*)zp = pack8(v);
  }
};

DI void transpose_tile(int tid, char* smem, const float* __restrict__ src, u16* __restrict__ dst, int K, int N, int ldk, int kt, int nt,
                       const float* scale, int smask) {
  float* t = (float*)smem;
  const int k0 = kt * 64, n0 = nt * 64;
#pragma unroll
  for (int i = 0; i < 16; ++i) {
    const int kk = (tid >> 6) + 4 * i, nn = tid & 63;
    float v = 0.f;
    if (n0 + nn < N) v = src[(size_t)(k0 + kk) * N + n0 + nn] * (scale ? scale[(k0 + kk) & smask] : 1.f);
    t[kk * 65 + nn] = v;
  }
  __syncthreads();
#pragma unroll
  for (int i = 0; i < 2; ++i) {
    const int c = tid + 256 * i;
    const int nn = c >> 3, k8 = (c & 7) * 8;
    float f[8];
#pragma unroll
    for (int j = 0; j < 8; ++j) f[j] = t[(k8 + j) * 65 + nn];
    *(bf16x8*)(dst + (size_t)(n0 + nn) * ldk + k0 + k8) = pack8(f);
  }
  __syncthreads();
}

DI void s5_setup(int tid, const Params& p, char* smem, int lg) {
  float* pw_re = (float*)smem;
  float* pw_im = pw_re + 33 * 64;
  float* bb_re = pw_im + 33 * 64;
  float* bb_im = bb_re + 1024;
  float* cc_re = bb_im + 1024;
  float* cc_im = cc_re + 1024;
  float* f_re = cc_im + 1024;
  float* f_im = f_re + 64;
  float* Kt = f_im + 64;
  if (tid < 64) {
    const float lr = p.lam_re[lg * 64 + tid], li = p.lam_im[lg * 64 + tid];
    const float dt = expf(p.log_dt[lg]);
    const float mag = expf(lr * dt);
    float sn, cs; sincosf(li * dt, &sn, &cs);
    const float br = mag * cs, bi = mag * sn;
    float pr = 1.f, pi = 0.f;
    for (int t = 0; t <= 32; ++t) {
      pw_re[t * 64 + tid] = pr; pw_im[t * 64 + tid] = pi;
      const float nr = pr * br - pi * bi, ni = pr * bi + pi * br;
      pr = nr; pi = ni;
    }
    p.LT()[(lg * 64 + tid) * 2] = pw_re[32 * 64 + tid];
    p.LT()[(lg * 64 + tid) * 2 + 1] = pw_im[32 * 64 + tid];
    const float nr = br - 1.f, ni = bi, den = 1.f / (lr * lr + li * li);
    f_re[tid] = (nr * lr + ni * li) * den;
    f_im[tid] = (ni * lr - nr * li) * den;
  }
  __syncthreads();
  for (int e = tid; e < 1024; e += 256) {
    const int n = e >> 4;
    const float br = p.b_re[(size_t)lg * 1024 + e], bi = p.b_im[(size_t)lg * 1024 + e];
    bb_re[e] = f_re[n] * br - f_im[n] * bi;
    bb_im[e] = f_re[n] * bi + f_im[n] * br;
    cc_re[e] = p.c_re[(size_t)lg * 1024 + e];
    cc_im[e] = p.c_im[(size_t)lg * 1024 + e];
  }
  __syncthreads();
  {
    const int pp = tid >> 4, pq = tid & 15;
    for (int t = 0; t < 32; ++t) {
      float s = 0.f;
      for (int n = 0; n < 64; ++n) {
        const float cr = cc_re[pp * 64 + n], ci = cc_im[pp * 64 + n];
        const float wr = pw_re[t * 64 + n], wi = pw_im[t * 64 + n];
        const float xr = cr * wr - ci * wi, xi = cr * wi + ci * wr;
        s += xr * bb_re[n * 16 + pq] - xi * bb_im[n * 16 + pq];
      }
      Kt[t * 256 + tid] = s;
    }
  }
  __syncthreads();
  u16* mq = p.WtMQ() + (size_t)lg * 512 * LDK6;
  for (int c = tid; c < 512 * 80; c += 256) {
    const int no = c / 80, k8 = (c % 80) * 8;
    const int t = no >> 4, pp = no & 15;
    float f[8];
    if (k8 < 512) {
      const int s = k8 >> 4, q0 = k8 & 15;
#pragma unroll
      for (int j = 0; j < 8; ++j) f[j] = (s <= t) ? Kt[(t - s) * 256 + pp * 16 + q0 + j] : 0.f;
    } else if (k8 < 576) {
      const int n0 = k8 - 512;
#pragma unroll
      for (int j = 0; j < 8; ++j) {
        const int n = n0 + j;
        f[j] = cc_re[pp * 64 + n] * pw_re[(t + 1) * 64 + n] - cc_im[pp * 64 + n] * pw_im[(t + 1) * 64 + n];
      }
    } else {
      const int n0 = k8 - 576;
#pragma unroll
      for (int j = 0; j < 8; ++j) {
        const int n = n0 + j;
        f[j] = -(cc_re[pp * 64 + n] * pw_im[(t + 1) * 64 + n] + cc_im[pp * 64 + n] * pw_re[(t + 1) * 64 + n]);
      }
    }
    *(bf16x8*)(mq + (size_t)no * LDK6 + k8) = pack8(f);
  }
  u16* wp = p.WtP() + (size_t)lg * 128 * LDK5;
  for (int c = tid; c < 128 * 64; c += 256) {
    const int nn = c >> 6, k8 = (c & 63) * 8;
    const int n = nn & 63, s = k8 >> 4, q0 = k8 & 15;
    const float wr = pw_re[(31 - s) * 64 + n], wi = pw_im[(31 - s) * 64 + n];
    float f[8];
#pragma unroll
    for (int j = 0; j < 8; ++j) {
      const float br = bb_re[n * 16 + q0 + j], bi = bb_im[n * 16 + q0 + j];
      f[j] = (nn < 64) ? (wr * br - wi * bi) : (wr * bi + wi * br);
    }
    *(bf16x8*)(wp + (size_t)nn * LDK5 + k8) = pack8(f);
  }
  __syncthreads();
}

DI void phase_prologue(int tid, int bid, const Params& p, char* smem) {
  const int nb = gridDim.x;
  const bool s5blk = (nb >= 128) && (bid >= nb - 64);
  if (nb >= 128) { if (s5blk) s5_setup(tid, p, smem, bid - (nb - 64)); }
  else for (int it = bid; it < 64; it += nb) s5_setup(tid, p, smem, it);
  const int nbw = (nb >= 128) ? nb - 64 : nb;
  if (s5blk) return;
  for (int lyr = 0; lyr < 2; ++lyr) {
    struct TJ { const float* src; u16* dst; int K, N, Npad, ldk; const float* sc; int smask; };
    const TJ jobs[5] = {
        {p.even_w_in + (size_t)lyr * 1024 * 5120, p.WtEin() + (size_t)lyr * 5120 * LDK1, 1024, 5120, 5120, LDK1, p.even_norm_g + lyr * 1024, 1023},
        {p.even_w_out + (size_t)lyr * 1536 * 1024, p.WtEout() + (size_t)lyr * 1024 * LDK15, 1536, 1024, 1024, LDK15, nullptr, 0},
        {p.w_glu + (size_t)lyr * 512 * 512, p.WtGlu() + (size_t)lyr * 512 * LDK5, 512, 512, 512, LDK5, nullptr, 0},
        {p.odd_w_in + (size_t)lyr * 1024 * 3088, p.WtOin() + (size_t)lyr * 3200 * LDK1, 1024, 3088, 3200, LDK1, p.odd_norm_g + lyr * 1024, 1023},
        {p.odd_w_out + (size_t)lyr * 1024 * 1024, p.WtOout() + (size_t)lyr * 1024 * LDK1, 1024, 1024, 1024, LDK1, p.gla_o_g + lyr * 256, 255}};
#pragma unroll
    for (int j = 0; j < 5; ++j) {
      const int nkt = jobs[j].K / 64, nnt = jobs[j].Npad / 64;
      for (int t = bid; t < nkt * nnt; t += nbw)
        transpose_tile(tid, smem, jobs[j].src, jobs[j].dst, jobs[j].K, jobs[j].N, jobs[j].ldk, t % nkt, t / nkt, jobs[j].sc, jobs[j].smask);
    }
    for (int e = bid * 256 + tid; e < 512 * 16; e += nbw * 256) {
      const int c = e >> 4, k = e & 15;
      p.WgT()[(size_t)lyr * 8192 + e] = f2bf(p.gla_w_gate[(size_t)lyr * 8192 + k * 512 + c]);
    }
  }
  const int w = tid >> 6, l = tid & 63;
  for (int row0 = (bid * 4 + w) * 4; row0 < NTOK; row0 += nbw * 16) {
    f32x4 va[4][4];
#pragma unroll
    for (int rr = 0; rr < 4; ++rr) {
      const f32x4* xr = (const f32x4*)(p.x + (size_t)(row0 + rr) * 1024);
#pragma unroll
      for (int i = 0; i < 2; ++i) { va[rr][2 * i] = xr[(l + 64 * i) * 2]; va[rr][2 * i + 1] = xr[(l + 64 * i) * 2 + 1]; }
    }
#pragma unroll
    for (int rr = 0; rr < 4; ++rr) {
      float s = 0.f;
#pragma unroll
      for (int i = 0; i < 2; ++i) {
        f32x4 a = va[rr][2 * i], b = va[rr][2 * i + 1];
        float f[8] = {a[0], a[1], a[2], a[3], b[0], b[1], b[2], b[3]};
#pragma unroll
        for (int j = 0; j < 8; ++j) s += f[j] * f[j];
        *(bf16x8*)(p.xb() + (size_t)(row0 + rr) * LDX + (l + 64 * i) * 8) = pack8(f);
      }
#pragma unroll
      for (int m = 1; m < 64; m <<= 1) s += __shfl_xor(s, m);
      if (l < 8) p.part()[(size_t)(row0 + rr) * 8 + l] = (l == 0) ? s : 0.f;
    }
  }
}

DI void attn_item(int tid, const Params& p, char* smem, int b, int hh, int qb, bool dry) {
  const int w = tid >> 6, l = tid & 63, r = l & 31, h = l >> 5;
  char* Ks = smem;
  char* Vs = smem + 16384;
  char* Qs = smem + 32768 + w * 8192;
  float* flags = (float*)(smem + 65536);
  float* stg = (float*)(smem + w * 8704);
  const u16* base = p.proj() + (size_t)b * SEQ * LDE;
  const int q0 = qb * 128, qw0 = q0 + 32 * w;
  {
    const u16* qp = base + (size_t)(qw0 + r) * LDE + hh * 128 + 8 * h;
#pragma unroll
    for (int s = 0; s < 8; ++s) *(bf16x8*)(Qs + off_b(r, 2 * s + h)) = ldg8(qp + 16 * s);
  }
  f32x16 ot[4];
#pragma unroll
  for (int d = 0; d < 4; ++d) ot[d] = zero16();
  float carry = 1.f, wmax = 1.f;
  const int lrow = tid >> 4, lch = tid & 15;
  bf16x8 rk[4], rv[4];
  auto gload = [&](int jt) {
    const u16* kp = base + (size_t)(jt * 64 + lrow) * LDE + 1024 + hh * 128 + lch * 8;
#pragma unroll
    for (int i = 0; i < 4; ++i) { rk[i] = ldg8(kp + (size_t)(16 * i) * LDE); rv[i] = ldg8(kp + (size_t)(16 * i) * LDE + 1024); }
  };
  const int trq = (l & 15) >> 2, trp = l & 3, trblk = (l >> 4) & 1;
  const unsigned fr = ((r & 3) << 2) | ((r >> 2) & 3);
  unsigned xs[8];
#pragma unroll
  for (int s = 0; s < 8; ++s) xs[s] = 16u * ((2 * s + h) ^ fr);
  const char* kbase = Ks + 256 * r;
  const char* qbase = Qs + 256 * r;
  const unsigned fv = (trq << 2) | h;
  unsigned vo[4];
#pragma unroll
  for (int d = 0; d < 4; ++d) vo[d] = 16u * ((4 * d + 2 * trblk + (trp >> 1)) ^ fv) + 8u * (trp & 1);
  const char* vbase = Vs + 256 * (4 * h + trq);
  int jt = 2 * qb + 1;
  gload(jt);
  for (; jt >= 0; --jt) {
#pragma unroll
    for (int i = 0; i < 4; ++i) {
      *(bf16x8*)(Ks + off_b(lrow + 16 * i, lch)) = rk[i];
      *(bf16x8*)(Vs + off_b(lrow + 16 * i, lch)) = rv[i];
    }
    RAW_BARRIER();
    if (jt > 0) gload(jt - 1);
    const int k0 = jt * 64;
    if (k0 <= qw0 && wmax >= 1e-30f) {
      f32x16 st[2];
      st[0] = zero16(); st[1] = zero16();
#pragma unroll
      for (int s = 0; s < 8; ++s) {
        const bf16x8 qf = *(const bf16x8*)(qbase + xs[s]);
#pragma unroll
        for (int kt = 0; kt < 2; ++kt) {
          bf16x8 a = *(const bf16x8*)(kbase + 8192 * kt + xs[s]);
          st[kt] = MFMA(a, qf, st[kt]);
        }
      }
      const bool need_mask = (k0 + 63 >= qw0);
      const int tq = qw0 + r;
      float running = carry;
#pragma unroll
      for (int kt = 1; kt >= 0; --kt) {
        float bt[16];
#pragma unroll
        for (int i = 0; i < 16; ++i) {
          float z2 = fminf(fmaxf(st[kt][i], -100.f), 100.f);
          float e = fexp2(-z2);
          float be = frcp(1.f + e);
          float om = e * be;
          if (need_mask && (k0 + 32 * kt + crow(i, h) >= tq)) { be = 0.f; om = 1.f; }
          bt[i] = be; st[kt][i] = om;
        }
#pragma unroll
        for (int rg = 3; rg >= 0; --rg) {
          const int i0 = 4 * rg;
          const float s2 = st[kt][i0 + 3], s1 = s2 * st[kt][i0 + 2], s0 = s1 * st[kt][i0 + 1], T = s0 * st[kt][i0];
          const float To = xor32(T, h);
          const float off = running * (h ? 1.f : To);
          st[kt][i0 + 3] = bt[i0 + 3] * off;
          st[kt][i0 + 2] = bt[i0 + 2] * off * s2;
          st[kt][i0 + 1] = bt[i0 + 1] * off * s1;
          st[kt][i0] = bt[i0] * off * s0;
          running = off * T * (h ? To : 1.f);
        }
      }
      carry = running;
#pragma unroll
      for (int ks = 0; ks < 4; ++ks) {
        float wv[8];
#pragma unroll
        for (int j = 0; j < 8; ++j) wv[j] = st[ks >> 1][8 * (ks & 1) + j];
        const bf16x8 bw = pack8(wv);
#pragma unroll
        for (int d = 0; d < 4; ++d) {
          s16x4 lo = tr_read(vbase + 4096 * ks + vo[d]);
          s16x4 hi = tr_read(vbase + 4096 * ks + 2048 + (vo[d] ^ 32u));
          ot[d] = MFMA(cat4(lo, hi), bw, ot[d]);
        }
      }
    }
    {
      float m = carry;
#pragma unroll
      for (int s = 1; s < 64; s <<= 1) m = fmaxf(m, __shfl_xor(m, s));
      if (l == 0) flags[w] = m;
      wmax = m;
    }
    RAW_BARRIER();
    const float mx = fmaxf(fmaxf(flags[0], flags[1]), fmaxf(flags[2], flags[3]));
    if (mx < 1e-30f) break;
  }
#pragma unroll
  for (int hf = 0; hf < 2; ++hf) {
#pragma unroll
    for (int dd = 0; dd < 2; ++dd)
#pragma unroll
      for (int rg = 0; rg < 4; ++rg) {
        f32x4 v = {ot[2 * hf + dd][4 * rg], ot[2 * hf + dd][4 * rg + 1], ot[2 * hf + dd][4 * rg + 2], ot[2 * hf + dd][4 * rg + 3]};
        *(f32x4*)(stg + r * 68 + 32 * dd + 8 * rg + 4 * h) = v;
      }
    wave_lds_fence();
#pragma unroll
    for (int ps = 0; ps < 4; ++ps) {
      const int id = l + 64 * ps, rr = id >> 3, c8 = (id & 7) * 8;
      f32x4 v0 = *(const f32x4*)(stg + rr * 68 + c8), v1 = *(const f32x4*)(stg + rr * 68 + c8 + 4);
      u16* zp = p.proj() + ((size_t)b * SEQ + qw0 + rr) * LDE + 3072 + hh * 128 + 64 * hf + c8;
      float z[8], o[8];
      unpack8(ldg8(zp), z);
#pragma unroll
      for (int j = 0; j < 4; ++j) { o[j] = v0[j] * siluf_(z[j]); o[4 + j] = v1[j] * siluf_(z[4 + j]); }
      if (!dry) *(bf16x8*)zp = pack8(o);
    }
    wave_lds_fence();
  }
  __syncthreads();
}

DI void gla_g1(int tid, const Params& p, char* smem, int lyr, int b, int n, int hh) {
  const int w = tid >> 6, l = tid & 63, r = l & 31, h = l >> 5;
  float* Ef = (float*)smem;
  u16* base = p.proj() + (size_t)b * SEQ * LDO;
  const bf16x8 wgf = ldg8(p.WgT() + (size_t)lyr * 8192 + (hh * 128 + 32 * w + r) * 16 + 8 * h);
  const float gbias = p.gla_b_gate[lyr * 512 + hh * 128 + 32 * w + r];
  bf16x8 rf[2], rq[4], rkk[4];
  const int erow = tid >> 4, ech = tid & 15;
#pragma unroll
  for (int mt = 0; mt < 2; ++mt) rf[mt] = ldg8(base + (size_t)(n * 64 + 32 * mt + r) * LDO + 3072 + 8 * h);
#pragma unroll
  for (int i = 0; i < 4; ++i) {
    const u16* rp = base + (size_t)(n * 64 + erow + 16 * i) * LDO + hh * 128 + ech * 8;
    rq[i] = ldg8(rp); rkk[i] = ldg8(rp + 512);
  }
  {
    f32x16 ga[2];
#pragma unroll
    for (int mt = 0; mt < 2; ++mt) ga[mt] = MFMA(rf[mt], wgf, zero16());
    float running = 0.f;
#pragma unroll
    for (int mt = 0; mt < 2; ++mt)
#pragma unroll
      for (int rg = 0; rg < 4; ++rg) {
        float c[4];
#pragma unroll
        for (int j = 0; j < 4; ++j) {
          const float x = ga[mt][4 * rg + j] + gbias;
          const float sp = fmaxf(-x, 0.f) + 0.6931471805599453f * flog2(1.f + fexp(-fabsf(x)));
          c[j] = -sp * (1.f / 16.f);
        }
        c[1] += c[0]; c[2] += c[1]; c[3] += c[2];
        const float T = c[3], To = xor32(T, h);
        const float off = running + (h ? To : 0.f);
#pragma unroll
        for (int j = 0; j < 4; ++j) Ef[(32 * mt + 8 * rg + 4 * h + j) * 128 + 32 * w + r] = fexp(off + c[j]);
        running = off + T + (h ? 0.f : To);
      }
  }
  __syncthreads();
#pragma unroll
  for (int i = 0; i < 4; ++i) {
    const int t = erow + 16 * i;
    const f32x4* ep = (const f32x4*)(Ef + t * 128 + ech * 8);
    f32x4 e0 = ep[0], e1 = ep[1];
    float e[8] = {e0[0], e0[1], e0[2], e0[3], e1[0], e1[1], e1[2], e1[3]};
    float q[8], k[8];
    unpack8(rq[i], q); unpack8(rkk[i], k);
#pragma unroll
    for (int j = 0; j < 8; ++j) { q[j] *= e[j] * 0.08838834764831845f; k[j] *= frcp(e[j]); }
    u16* rp = base + (size_t)(n * 64 + t) * LDO + hh * 128 + ech * 8;
    *(bf16x8*)rp = pack8(q);
    *(bf16x8*)(rp + 512) = pack8(k);
  }
  if (tid < 128) p.Sc()[(((size_t)b * 64 + n) * 4 + hh) * 128 + tid] = Ef[63 * 128 + tid];
  __syncthreads();
}

DI void gla_item(int tid, const Params& p, char* smem, int lyr, int b, int hh, int sl, bool dry) {
  const int w = tid >> 6, l = tid & 63, r = l & 31, h = l >> 5;
  char* vs = smem + 65536;
  char* sT = smem + 69632;
  u16* base = p.proj() + (size_t)b * SEQ * LDO;
  const float* elast = p.Sc() + ((size_t)b * 64 * 4 + hh) * 128;
  const int trq = (l & 15) >> 2, trp = l & 3, trblk = (l >> 4) & 1;
  const unsigned fr = ((r & 3) << 2) | ((r >> 2) & 3);
  auto xsf = [&](int s8) -> unsigned { unsigned v = 16u * ((2 * s8 + h) ^ fr); asm volatile("" : "+v"(v)); return v; };
  const unsigned rowb = 256u * r;
  const unsigned fk = (trq << 2) | (2 * h);
  const unsigned kb2 = 256u * (8 * h + trq);
  f32x16 sacc[2];
  sacc[0] = zero16(); sacc[1] = zero16();
  for (int e = tid; e < 2048; e += 256) ((unsigned*)sT)[e] = 0u;
  bf16x8 rvv;
  auto load_v = [&](int n) {
    rvv = ldg8(base + (size_t)(n * 64 + (tid >> 2)) * LDO + 1024 + hh * 256 + sl * 32 + (tid & 3) * 8);
  };
  auto dma_qk = [&](int n, int buf) {
    char* dq = smem + buf * 32768 + w * 4096;
#pragma unroll
    for (int i = 0; i < 4; ++i) {
      const int j = 4 * w + i;
      const int ch = (l & 15) ^ (((l >> 4) << 2) | (j & 3));
      const u16* src = base + (size_t)(n * 64 + 4 * j + (l >> 4)) * LDO + hh * 128 + ch * 8;
      __builtin_amdgcn_global_load_lds((const unsigned*)src, (unsigned*)(dq + i * 1024), 16, 0, 0);
      __builtin_amdgcn_global_load_lds((const unsigned*)(src + 512), (unsigned*)(dq + 16384 + i * 1024), 16, 0, 0);
    }
  };
  float el[2] = {1.f, 1.f};
  auto load_el = [&](int n) {
    if (w >= 2) {
#pragma unroll
      for (int ci = 0; ci < 2; ++ci) el[ci] = elast[(size_t)n * 512 + 32 * (2 * (w - 2) + ci) + r];
    }
  };
  u32x2 zreg[4];
  auto load_z = [&](int n) {
    const u16* zp = base + (size_t)(n * 64 + 32 * (w & 1) + r) * LDO + 2048 + hh * 256 + sl * 32 + 4 * h;
#pragma unroll
    for (int rg = 0; rg < 4; ++rg) zreg[rg] = *(const u32x2*)(zp + 8 * rg);
  };
  dma_qk(0, 0);
  load_v(0);
  load_el(0);
  dma_qk(1, 1);
  __builtin_amdgcn_sched_barrier(0);
  for (int n = 0; n < 64; ++n) {
    const char* qd = smem + (n & 1) * 32768;
    const char* ki = qd + 16384;
    {
      *(bf16x8*)(vs + (tid >> 2) * 64 + (tid & 3) * 16) = rvv;
      if (w >= 2 && n > 0 && !(dry && (PROBE_VARIANT == 12 || PROBE_VARIANT == 13))) {
        const int cb = 2 * (w - 2);
#pragma unroll
        for (int ci = 0; ci < 2; ++ci) {
          const int c = 32 * (cb + ci) + r;
#pragma unroll
          for (int i = 0; i < 16; ++i) *(u16*)(sT + off_b(crow(i, h), c >> 3) + (c & 7) * 2) = f2bf(sacc[ci][i]);
        }
      }
    }
    const float el0 = el[0], el1 = el[1];
    if (n + 1 < 64) WAIT_V(8); else WAIT_V(0);
    RAW_BARRIER();
    if (n + 1 < 64) { load_v(n + 1); load_el(n + 1); }
    const bool skip_o = dry && (PROBE_VARIANT == 11 || PROBE_VARIANT == 13), skip_s = dry && (PROBE_VARIANT == 12 || PROBE_VARIANT == 13);
    if (w < 2 ? skip_o : skip_s) {
    } else if (w < 2) {
      const int tt = w;
      load_z(n);
      f32x16 oa = zero16();
#pragma unroll
      for (int st = 0; st < 2; ++st) {
        if (st <= tt) {
          f32x16 sc = zero16();
#pragma unroll
          for (int hb = 0; hb < 2; ++hb) {
            bf16x8 af[4], bf[4];
#pragma unroll
            for (int q4 = 0; q4 < 4; ++q4) {
              af[q4] = *(const bf16x8*)(ki + rowb + 8192 * st + xsf(4 * hb + q4));
              bf[q4] = *(const bf16x8*)(qd + rowb + 8192 * tt + xsf(4 * hb + q4));
            }
            __builtin_amdgcn_sched_barrier(0);
#pragma unroll
            for (int q4 = 0; q4 < 4; ++q4) sc = MFMA(af[q4], bf[q4], sc);
            __builtin_amdgcn_sched_barrier(0);
          }
          if (st == tt) {
#pragma unroll
            for (int i = 0; i < 16; ++i)
              if (crow(i, h) > r) sc[i] = 0.f;
          }
          s16x4 vlo[2], vhi[2];
#pragma unroll
          for (int ks = 0; ks < 2; ++ks) {
            const int row0 = 32 * st + 16 * ks + 4 * h + trq;
            vlo[ks] = tr_read(vs + row0 * 64 + 32 * trblk + 8 * trp);
            vhi[ks] = tr_read(vs + (row0 + 8) * 64 + 32 * trblk + 8 * trp);
          }
#pragma unroll
          for (int ks = 0; ks < 2; ++ks) {
            float wv[8];
#pragma unroll
            for (int j = 0; j < 8; ++j) wv[j] = sc[8 * ks + j];
            oa = MFMA(cat4(vlo[ks], vhi[ks]), pack8(wv), oa);
          }
        }
      }
#pragma unroll
      for (int hb = 0; hb < 2; ++hb) {
        bf16x8 sf[4], bf[4];
#pragma unroll
        for (int q4 = 0; q4 < 4; ++q4) {
          sf[q4] = *(const bf16x8*)(sT + rowb + xsf(4 * hb + q4));
          bf[q4] = *(const bf16x8*)(qd + rowb + 8192 * tt + xsf(4 * hb + q4));
        }
        __builtin_amdgcn_sched_barrier(0);
#pragma unroll
        for (int q4 = 0; q4 < 4; ++q4) oa = MFMA(sf[q4], bf[q4], oa);
        __builtin_amdgcn_sched_barrier(0);
      }
      const size_t tok = (size_t)b * SEQ + n * 64 + 32 * tt + r;
      float ss = 0.f;
#pragma unroll
      for (int i = 0; i < 16; ++i) ss += oa[i] * oa[i];
      ss += xor32(ss, h);
      if (h == 0 && !dry) p.ssqg()[tok * 32 + hh * 8 + sl] = ss;
      u16* rowp = p.proj() + tok * LDO + hh * 256 + sl * 32;
#pragma unroll
      for (int rg = 0; rg < 4; ++rg) {
        const int dv0 = 8 * rg + 4 * h;
        const u32x2 zz = zreg[rg];
        float z0 = bflo(zz[0]), z1 = bfhi(zz[0]), z2 = bflo(zz[1]), z3 = bfhi(zz[1]);
        u32x2 o;
        o[0] = pk2(oa[4 * rg] * siluf_(z0), oa[4 * rg + 1] * siluf_(z1));
        o[1] = pk2(oa[4 * rg + 2] * siluf_(z2), oa[4 * rg + 3] * siluf_(z3));
        if (!dry) *(u32x2*)(rowp + 1024 + dv0) = o;
      }
    } else {
      const int cb = 2 * (w - 2);
#pragma unroll
      for (int ks = 0; ks < 4; ++ks) {
        const int row0 = 16 * ks + 8 * h + trq;
        s16x4 lo = tr_read(vs + row0 * 64 + 32 * trblk + 8 * trp);
        s16x4 hi = tr_read(vs + (row0 + 4) * 64 + 32 * trblk + 8 * trp);
        const bf16x8 av = cat4(lo, hi);
#pragma unroll
        for (int ci = 0; ci < 2; ++ci) {
          const unsigned ko = 16u * ((4 * (cb + ci) + 2 * trblk + (trp >> 1)) ^ fk) + 8u * (trp & 1);
          s16x4 blo = tr_read(ki + kb2 + 4096 * ks + ko);
          s16x4 bhi = tr_read(ki + kb2 + 4096 * ks + 1024 + (ko ^ 16u));
          sacc[ci] = MFMA(av, cat4(blo, bhi), sacc[ci]);
        }
      }
#pragma unroll
      for (int ci = 0; ci < 2; ++ci)
#pragma unroll
        for (int i = 0; i < 16; ++i) sacc[ci][i] *= (ci ? el1 : el0);
    }
    RAW_BARRIER();
    __builtin_amdgcn_sched_barrier(0);
    if (n + 2 < 64) dma_qk(n + 2, n & 1);
    __builtin_amdgcn_sched_barrier(0);
  }
  __syncthreads();
}

#define FOR_TILES_XCD4(MT, NT, mt, nt)                                                           \
  for (int s_ = (bid >> 3), mt = 0, nt = 0;                                                       \
       s_ < ((MT) >> 3) * (NT) &&                                                                 \
       (mt = (bid & 7) + 8 * (4 * (s_ / (4 * (NT))) + (s_ & 3)), nt = (s_ % (4 * (NT))) >> 2, true); s_ += (nb >> 3))
#define FOR_TILES_XCD(MT, NT, mt, nt)                                                          \
  for (int s_ = (bid >> 3), mt = 0, nt = 0;                                                     \
       s_ < ((MT) >> 3) * (NT) && (mt = (bid & 7) + 8 * (s_ / (NT)), nt = s_ % (NT), true); s_ += (nb >> 3))
DI void run_phase(const Params& p, char* smem, int ph, bool dry) {
  int tid = threadIdx.x, bid = blockIdx.x;
  asm volatile("" : "+v"(tid));
  asm volatile("" : "+s"(bid));
  const int nb = gridDim.x;
#ifdef ONLY
  if (ph != ONLY) return;
#endif
  if (ph == 0) { phase_prologue(tid, bid, p, smem); return; }
  const int q = ph - 1, cyc = q / 10, rem = q % 10;
  const int li = cyc;
  if (rem < 6) {
    const int lyr = li;
    switch (rem) {
      case 0: {
        ALPlain al{p.xb(), LDX, 1 << 30, 0, 0};
        EPEvenIn ep{p.part(), p.proj(), p.sb_q_g + lyr * 128, p.sb_k_g + lyr * 128};
        const u16* Bt = p.WtEin() + (size_t)lyr * 5120 * LDK1;
        FOR_TILES_XCD4(256, 40, mt, nt) gemm_tile_dma(tid, smem, al, Bt, LDK1, 1024, mt * 256, nt * 128, ep, dry ? PROBE_VARIANT : 0);
      } break;
      case 1: {
        for (int it = bid; it < 4096; it += nb) {
          const int qb = 31 - (it >> 7), bh = it & 127;
          attn_item(tid, p, smem, bh >> 3, bh & 7, qb, dry);
        }
        asm volatile("" : "+v"(tid));
        for (int t = bid; t < 256; t += nb) {
          const int g = t >> 3, mt = t & 7;
          ALS5 al{p.proj(), p.hp(), g};
          EPS5P ep{p.Sc(), g};
          gemm_tile_dma(tid, smem, al, p.WtP() + ((size_t)lyr * 32 + g) * 128 * LDK5, LDK5, 512, mt * 256, 0, ep);
        }
      } break;
      case 2: {
        for (int idx = bid * 256 + tid; idx < 16 * 32 * 64; idx += nb * 256) {
          const int n = idx & 63, g = (idx >> 6) & 31, b = idx >> 11;
          const float lr = p.LT()[((lyr * 32 + g) * 64 + n) * 2], lim = p.LT()[((lyr * 32 + g) * 64 + n) * 2 + 1];
          float hr = 0.f, hi = 0.f;
          for (int c0 = 0; c0 < 128; c0 += 16) {
            float sr[16], si[16];
#pragma unroll
            for (int j = 0; j < 16; ++j) {
              const size_t o = ((size_t)(b * 128 + c0 + j) * 32 + g) * 128;
              sr[j] = p.Sc()[o + n]; si[j] = p.Sc()[o + 64 + n];
            }
#pragma unroll
            for (int j = 0; j < 16; ++j) {
              const size_t o = ((size_t)(b * 128 + c0 + j) * 32 + g) * 128;
              p.hp()[o + n] = f2bf(hr); p.hp()[o + 64 + n] = f2bf(hi);
              const float nr = lr * hr - lim * hi + sr[j], ni = lr * hi + lim * hr + si[j];
              hr = nr; hi = ni;
            }
          }
        }
      } break;
      case 3: {
        for (int t = bid; t < 1024; t += nb) {
          const int g = t >> 5, mt = (t >> 2) & 7, nt = t & 3;
          ALS5 al{p.proj(), p.hp(), g};
          EPS5Y ep{p.proj(), p.yb(), p.s5_d + lyr * 512, g};
          gemm_tile_dma(tid, smem, al, p.WtMQ() + ((size_t)lyr * 32 + g) * 512 * LDK6, LDK6, 640, mt * 256, nt * 128, ep);
        }
      } break;
      case 4: {
        ALPlain al{p.yb(), LDY, 1 << 30, 0, 0};
        EPGlu ep{p.proj(), p.yb(), p.b_glu + lyr * 512, dry};
        const u16* Bt = p.WtGlu() + (size_t)lyr * 512 * LDK5;
        FOR_TILES_XCD(256, 4, mt, nt) gemm_tile_dma(tid, smem, al, Bt, LDK5, 512, mt * 256, nt * 128, ep);
      } break;
      default: {
        ALPlain al{p.proj(), LDE, 1024, 3072, 3584};
        EPOut ep{cyc == 0 ? p.x : p.out, p.out, p.xb(), p.part(), dry};
        const u16* Bt = p.WtEout() + (size_t)lyr * 1024 * LDK15;
        FOR_TILES_XCD(256, 8, mt, nt) gemm_tile_dma(tid, smem, al, Bt, LDK15, 1536, mt * 256, nt * 128, ep);
      } break;
    }
  } else {
    const int lyr = li;
    switch (rem - 6) {
      case 0: {
        ALPlain al{p.xb(), LDX, 1 << 30, 0, 0};
        EPOddIn ep{p.part(), p.proj()};
        const u16* Bt = p.WtOin() + (size_t)lyr * 3200 * LDK1;
        FOR_TILES_XCD4(256, 25, mt, nt) gemm_tile_dma(tid, smem, al, Bt, LDK1, 1024, mt * 256, nt * 128, ep);
      } break;
      case 1: {
        if (!dry) for (int it = bid; it < 4096; it += nb) gla_g1(tid, p, smem, lyr, it >> 8, (it >> 2) & 63, it & 3);
      } break;
      case 2: {
        for (int it = bid; it < 512; it += nb) {
          const int xcd = it & 7, j = it >> 3, bh = xcd * 8 + (j >> 3), slc = j & 7;
          gla_item(tid, p, smem, lyr, bh >> 2, bh & 3, slc, dry);
        }
      } break;
      default: {
        ALGlaOut al{p.proj(), p.ssqg()};
        EPOut ep{p.out, p.out, p.xb(), p.part(), dry};
        const u16* Bt = p.WtOout() + (size_t)lyr * 1024 * LDK1;
        FOR_TILES_XCD(256, 8, mt, nt) gemm_tile(tid, smem, al, Bt, LDK1, 1024, mt * 256, nt * 128, ep);
      } break;
    }
  }
}


#define XB_TMO      128
#define XB_XCNT(j)  (256  + 64 * (j))
#define XB_XSUB(j)  (1280 + 64 * (j))
#define XB_XGEN(j)  (2304 + 64 * (j))
#define XB_TOP      3328
#define XB_TOPGEN   3392
#define XCD_BAR_WORDS 3456
#define XB_SPIN_CAP (1u << 18)
#define LAS __attribute__((address_space(3)))
DI unsigned xb_ld(unsigned* p) { return __hip_atomic_load(p, __ATOMIC_RELAXED, __HIP_MEMORY_SCOPE_AGENT); }
DI unsigned xb_add(unsigned* p, unsigned v) { return __hip_atomic_fetch_add(p, v, __ATOMIC_RELAXED, __HIP_MEMORY_SCOPE_AGENT); }
DI unsigned xb_xcc_id() { return (unsigned)__builtin_amdgcn_s_getreg((3 << 11) | 20) & 0xFu; }
#define XB_SPIN(cond, bar) do { unsigned _sp = 0; while (cond) { __builtin_amdgcn_s_sleep(1); \
    if ((++_sp & 255u) == 0u) { if (xb_ld(&(bar)[XB_TMO])) break; if (_sp > XB_SPIN_CAP) { atomicAdd(&(bar)[XB_TMO], 1u); break; } } } } while (0)
struct XcdBarrier { unsigned* bar; unsigned x; volatile LAS unsigned* st; };
DI XcdBarrier xcd_barrier_post(unsigned* bar, volatile LAS unsigned* st) {
  XcdBarrier b; b.bar = bar; b.x = xb_xcc_id(); b.st = st;
  if (threadIdx.x == 0) (void)xb_add(&bar[XB_XCNT(b.x)], 1u);
  return b;
}
DI void xcd_barrier_complete(unsigned* bar, unsigned x, unsigned& nloc, unsigned& nx) {
  const unsigned G = gridDim.x * gridDim.y * gridDim.z;
  unsigned sum, cnt, mine, sp = 0u;
  for (;;) {
    sum = 0u; cnt = 0u; mine = 0u;
#pragma unroll
    for (unsigned j = 0; j < 16; ++j) { const unsigned c = xb_ld(&bar[XB_XCNT(j)]); sum += c; cnt += (c > 0u) ? 1u : 0u; mine = (j == x) ? c : mine; }
    if (sum == G) break;
    __builtin_amdgcn_s_sleep(1);
    if ((++sp & 255u) == 0u) { if (xb_ld(&bar[XB_TMO])) break; if (sp > XB_SPIN_CAP) { atomicAdd(&bar[XB_TMO], 1u); break; } }
  }
  nloc = mine > 0u ? mine : 1u; nx = cnt > 0u ? cnt : 1u;
}
DI void xcd_barrier(const XcdBarrier& b) {
  asm volatile("s_waitcnt vmcnt(0)" ::: "memory");
  __syncthreads();
  if (threadIdx.x == 0) {
    unsigned* bar = b.bar;
    __builtin_amdgcn_s_waitcnt(0);
    unsigned nloc = b.st[0], nx = b.st[1];
    if (nloc == 0u) { xcd_barrier_complete(bar, b.x, nloc, nx); b.st[0] = nloc; b.st[1] = nx; }
    const unsigned old = xb_add(&bar[XB_XSUB(b.x)], 1u);
    const unsigned gen = old / nloc;
    if (old + 1u == (gen + 1u) * nloc) {
      __builtin_amdgcn_fence(__ATOMIC_RELEASE, "agent");
      asm volatile("s_waitcnt vmcnt(0)" ::: "memory");
      const unsigned og = xb_add(&bar[XB_TOP], 1u);
      const unsigned tg = og / nx;
      if (og + 1u == (tg + 1u) * nx) xb_add(&bar[XB_TOPGEN], 1u);
      else XB_SPIN(xb_ld(&bar[XB_TOPGEN]) == tg, bar);
      __builtin_amdgcn_fence(__ATOMIC_ACQUIRE, "agent");
      xb_add(&bar[XB_XGEN(b.x)], 1u);
      asm volatile("s_waitcnt vmcnt(0)" ::: "memory");
    } else {
      XB_SPIN(xb_ld(&bar[XB_XGEN(b.x)]) == gen, bar);
      __builtin_amdgcn_fence(__ATOMIC_ACQUIRE, "agent");
      asm volatile("s_waitcnt vmcnt(0)" ::: "memory");
    }
  }
  __syncthreads();
}

constexpr int NPHASE = 21;

#ifndef PROBE_MASK
#define PROBE_MASK 0
#endif
DI int phase_kind(int ph) { if (ph == 0) return 0; const int rem = (ph - 1) % 10; return 1 + rem; }

#ifndef PROBE_SEL
#define PROBE_SEL -1
#endif
__global__ void __launch_bounds__(256, 2) fwd_kernel(Params p, int ph_lo, int ph_hi, int probe_mask, int probe_sel) {
  __shared__ __attribute__((aligned(16))) char smem[SMEM_BYTES];
  __shared__ uint4 xb_words;
  if (threadIdx.x == 0) xb_words = make_uint4(0u, 0u, 0u, 0u);
  __syncthreads();
  (void)xcd_barrier_post((unsigned*)(p.ws + OFF_bar), (volatile LAS unsigned*)&xb_words);
  for (int ph = ph_lo; ph < ph_hi; ++ph) {
    if (ph > ph_lo) {
      XcdBarrier xb;
      unsigned* bar_ = (unsigned*)(p.ws + OFF_bar);
      asm volatile("" : "+s"(bar_));
      xb.bar = bar_; xb.x = xb_xcc_id(); xb.st = (volatile LAS unsigned*)&xb_words;
      xcd_barrier(xb);
    }
    if (probe_mask < 0) cg::this_grid().sync();
    run_phase(p, smem, ph, false);
  }
}

extern "C" void kernel_launch(void* const* d_in, const int* in_sizes, int n_in, void* d_out, int out_size, void* d_ws,
                              size_t ws_size, hipStream_t stream) {
  Params p{};
  const float** fp = (const float**)&p;
  for (int i = 0; i < 22; ++i) fp[i] = (const float*)d_in[i];
  p.out = (float*)d_out;
  p.ws = (char*)d_ws;
  if (WS_TOTAL > ws_size) { fprintf(stderr, "workspace too small: have %zu\n", ws_size); return; }

  static int grid_blocks = 0;
  if (!grid_blocks) {
    int dev = 0, cus = 0, per_cu = 0;
    hipGetDevice(&dev);
    hipDeviceGetAttribute(&cus, hipDeviceAttributeMultiprocessorCount, dev);
    hipOccupancyMaxActiveBlocksPerMultiprocessor(&per_cu, fwd_kernel, 256, 0);
    if (per_cu > 2) per_cu = 2;
    grid_blocks = cus * per_cu;
    if (grid_blocks <= 0) grid_blocks = 256;
  }
#if COOP
  hipMemsetAsync(p.ws + OFF_bar, 0, (size_t)XCD_BAR_WORDS * 4, stream);
  int lo = 0, hi = NPHASE, pm = PROBE_MASK, psel = PROBE_SEL;
  void* args[] = {&p, &lo, &hi, &pm, &psel};
  hipError_t e = hipLaunchCooperativeKernel((void*)fwd_kernel, dim3(grid_blocks), dim3(256), args, 0, stream);
  if (e != hipSuccess) fprintf(stderr, "cooperative launch failed: %s (grid %d)\n", hipGetErrorString(e), grid_blocks);
#else
  for (int ph = 0; ph < NPHASE; ++ph) hipLaunchKernelGGL(fwd_kernel, dim3(grid_blocks), dim3(256), 0, stream, p, ph, ph + 1, 0, -1);
#endif
}
```

```cpp
#include <hip/hip_runtime.h>
#include <hip/hip_cooperative_groups.h>
#include <cstdio>
namespace cg = cooperative_groups;

#ifndef COOP
#define COOP 1
#endif

#ifndef PROBE_VARIANT
#define PROBE_VARIANT 0
#endif
#define DI __device__ __forceinline__
typedef unsigned short u16;
typedef __attribute__((ext_vector_type(8))) short bf16x8;
typedef __attribute__((ext_vector_type(4))) short s16x4;
typedef __attribute__((ext_vector_type(16))) float f32x16;
typedef __attribute__((ext_vector_type(4))) float f32x4;
typedef __attribute__((ext_vector_type(2))) float f32x2;
typedef __attribute__((ext_vector_type(4))) unsigned u32x4;
typedef __attribute__((ext_vector_type(2))) unsigned u32x2;
typedef __bf16 bf2_t __attribute__((ext_vector_type(2)));
typedef __attribute__((address_space(3))) s16x4 lds_s16x4;

#define MFMA(a, b, c) __builtin_amdgcn_mfma_f32_32x32x16_bf16((a), (b), (c), 0, 0, 0)

constexpr int NTOK = 65536;
constexpr int SEQ = 4096;
constexpr int LDE = 5184;
constexpr int LDO = 3264;
constexpr int LDX = 1088;
constexpr int LDY = 576;
constexpr int LDK1 = 1088, LDK15 = 1600, LDK5 = 576, LDK6 = 704;
constexpr float EPS = 1e-6f;
constexpr int SMEM_BYTES = 77824;

constexpr size_t al256(size_t x) { return (x + 255) & ~(size_t)255; }
constexpr size_t OFF_WtEin = 0;
constexpr size_t OFF_WtEout = OFF_WtEin + al256((size_t)2 * 5120 * LDK1 * 2);
constexpr size_t OFF_WtGlu = OFF_WtEout + al256((size_t)2 * 1024 * LDK15 * 2);
constexpr size_t OFF_WtOin = OFF_WtGlu + al256((size_t)2 * 512 * LDK5 * 2);
constexpr size_t OFF_WtOout = OFF_WtOin + al256((size_t)2 * 3200 * LDK1 * 2);
constexpr size_t OFF_WgT = OFF_WtOout + al256((size_t)2 * 1024 * LDK1 * 2);
constexpr size_t OFF_WtMQ = OFF_WgT + al256((size_t)2 * 512 * 16 * 2);
constexpr size_t OFF_WtP = OFF_WtMQ + al256((size_t)2 * 32 * 512 * LDK6 * 2);
constexpr size_t OFF_LT = OFF_WtP + al256((size_t)2 * 32 * 128 * LDK5 * 2);
constexpr size_t OFF_xb = OFF_LT + al256((size_t)2 * 32 * 64 * 2 * 4);
constexpr size_t OFF_part = OFF_xb + al256((size_t)NTOK * LDX * 2);
constexpr size_t OFF_proj = OFF_part + al256((size_t)NTOK * 8 * 4);
constexpr size_t OFF_yb = OFF_proj + al256((size_t)NTOK * LDE * 2);
constexpr size_t OFF_Sc = OFF_yb + al256((size_t)NTOK * LDY * 2);
constexpr size_t OFF_hp = OFF_Sc + al256((size_t)2048 * 32 * 128 * 4);
constexpr size_t OFF_ssqg = OFF_hp + al256((size_t)2048 * 32 * 128 * 2);
constexpr size_t OFF_bar = OFF_ssqg + al256((size_t)NTOK * 32 * 4);
constexpr size_t WS_TOTAL = OFF_bar + al256((size_t)3456 * 4);

struct Params {
  const float *x, *even_norm_g, *even_w_in, *sb_q_g, *sb_k_g, *lam_re, *lam_im, *log_dt, *b_re, *b_im, *c_re, *c_im,
      *s5_d, *w_glu, *b_glu, *even_w_out, *odd_norm_g, *odd_w_in, *gla_w_gate, *gla_b_gate, *gla_o_g, *odd_w_out;
  float* out;
  char* ws;
  DI u16* WtEin() const { return (u16*)(ws + OFF_WtEin); }
  DI u16* WtEout() const { return (u16*)(ws + OFF_WtEout); }
  DI u16* WtGlu() const { return (u16*)(ws + OFF_WtGlu); }
  DI u16* WtOin() const { return (u16*)(ws + OFF_WtOin); }
  DI u16* WtOout() const { return (u16*)(ws + OFF_WtOout); }
  DI u16* WgT() const { return (u16*)(ws + OFF_WgT); }
  DI u16* WtMQ() const { return (u16*)(ws + OFF_WtMQ); }
  DI u16* WtP() const { return (u16*)(ws + OFF_WtP); }
  DI float* LT() const { return (float*)(ws + OFF_LT); }
  DI u16* xb() const { return (u16*)(ws + OFF_xb); }
  DI float* part() const { return (float*)(ws + OFF_part); }
  DI u16* proj() const { return (u16*)(ws + OFF_proj); }
  DI u16* yb() const { return (u16*)(ws + OFF_yb); }
  DI float* Sc() const { return (float*)(ws + OFF_Sc); }
  DI u16* hp() const { return (u16*)(ws + OFF_hp); }
  DI float* ssqg() const { return (float*)(ws + OFF_ssqg); }
};

DI unsigned pk2(float a, float b) { f32x2 v = {a, b}; return __builtin_bit_cast(unsigned, __builtin_convertvector(v, bf2_t)); }
DI u16 f2bf(float a) { return (u16)(pk2(a, 0.f) & 0xffffu); }
DI float bflo(unsigned u) { return __uint_as_float(u << 16); }
DI float bfhi(unsigned u) { return __uint_as_float(u & 0xffff0000u); }
DI int crow(int i, int h) { return (i & 3) + 8 * (i >> 2) + 4 * h; }
DI float fexp2(float x) { return __builtin_amdgcn_exp2f(x); }
DI float flog2(float x) { return __builtin_amdgcn_logf(x); }
DI float frcp(float x) { return __builtin_amdgcn_rcpf(x); }
DI float fexp(float x) { return fexp2(x * 1.44269504088896f); }
DI float sigmoidf_(float x) { return frcp(1.f + fexp(-x)); }
DI float siluf_(float x) { return x * sigmoidf_(x); }
DI unsigned off_b(unsigned row, unsigned ch) { return 256u * row + 16u * (ch ^ (((row & 3) << 2) | ((row >> 2) & 3))); }
DI unsigned off_g(unsigned row, unsigned ch) { return 128u * row + 16u * (ch ^ ((row >> 1) & 7)); }
DI s16x4 tr_read(const char* p) { return __builtin_amdgcn_ds_read_tr16_b64_v4i16((lds_s16x4*)p); }
DI bf16x8 cat4(s16x4 lo, s16x4 hi) { return __builtin_shufflevector(lo, hi, 0, 1, 2, 3, 4, 5, 6, 7); }
DI f32x16 zero16() { f32x16 z;
#pragma unroll
  for (int i = 0; i < 16; ++i) z[i] = 0.f; return z; }
DI bf16x8 pack8(const float* f) {
  u32x4 r; r[0] = pk2(f[0], f[1]); r[1] = pk2(f[2], f[3]); r[2] = pk2(f[4], f[5]); r[3] = pk2(f[6], f[7]);
  return __builtin_bit_cast(bf16x8, r);
}
DI void unpack8(bf16x8 v, float* f) {
  u32x4 r = __builtin_bit_cast(u32x4, v);
#pragma unroll
  for (int i = 0; i < 4; ++i) { f[2 * i] = bflo(r[i]); f[2 * i + 1] = bfhi(r[i]); }
}
DI bf16x8 ldg8(const u16* p) { return *(const bf16x8*)p; }
template <int CTRL> DI float dpp_mov(float v) {
  return __int_as_float(__builtin_amdgcn_update_dpp(0, __float_as_int(v), CTRL, 0xF, 0xF, true));
}
DI float red16(float v) {
  v += dpp_mov<0xB1>(v);
  v += dpp_mov<0x4E>(v);
  v += dpp_mov<0x141>(v);
  v += dpp_mov<0x140>(v);
  return v;
}
typedef unsigned u32x2v __attribute__((ext_vector_type(2)));
DI float xor32(float v, int h) {
  const u32x2v r = __builtin_amdgcn_permlane32_swap(__float_as_uint(v), __float_as_uint(v), false, false);
  return __uint_as_float(h ? r[0] : r[1]);
}
DI void wave_lds_fence() { __builtin_amdgcn_fence(__ATOMIC_RELEASE, "wavefront"); __builtin_amdgcn_wave_barrier(); __builtin_amdgcn_fence(__ATOMIC_ACQUIRE, "wavefront"); }

DI float row_rstd(const float* part, int row) {
  const f32x4* p = (const f32x4*)(part + (size_t)row * 8);
  f32x4 a = p[0], b = p[1];
  float s = a[0] + a[1] + a[2] + a[3] + b[0] + b[1] + b[2] + b[3];
  return __builtin_amdgcn_rsqf(s * (1.f / 1024.f) + EPS);
}

template <class AL, class EP>
DI void gemm_tile(int tid, char* smem, const AL& al, const u16* __restrict__ Bt, int ldb, int K, int row0, int col0, const EP& ep) {
  const int w = tid >> 6, l = tid & 63, r = l & 31, h = l >> 5;
  char* As = smem;
  char* Bs = smem + 32768;
  f32x16 acc[2][4];
#pragma unroll
  for (int mi = 0; mi < 2; ++mi)
#pragma unroll
    for (int ni = 0; ni < 4; ++ni) acc[mi][ni] = zero16();
  const int lrow = tid >> 3, lch = tid & 7;
  bf16x8 ra[8], rb[4];
  const unsigned boff = ((unsigned)(col0 + lrow) * (unsigned)ldb + lch * 8) * 2u;
  const unsigned bstep = 64u * (unsigned)ldb;
  auto gload = [&](int k0) {
    const char* ab = al.base(k0);
    unsigned ao = al.off(row0 + lrow, k0 + lch * 8);
    unsigned st = al.step32(k0), bs = bstep, bo = boff + 2u * k0;
    asm volatile("" : "+s"(st), "+s"(bs));
    asm volatile("" : "+v"(ao), "+v"(bo));
#pragma unroll
    for (int i = 0; i < 8; ++i) ra[i] = *(const bf16x8*)(ab + (ao + i * st));
#pragma unroll
    for (int i = 0; i < 4; ++i) rb[i] = *(const bf16x8*)((const char*)Bt + (bo + i * bs));
  };
  const unsigned wbase = off_g(lrow, lch);
  unsigned xo[4];
#pragma unroll
  for (int s = 0; s < 4; ++s) xo[s] = 16u * ((2 * s + h) ^ ((r >> 1) & 7));
  const unsigned abase = 128u * (64 * w + r), bbase = 32768u + 128u * r;
  gload(0);
  for (int k0 = 0; k0 < K; k0 += 64) {
    if constexpr (AL::kRowScale) {
      float* rsl = (float*)(smem + 49152);
      if ((k0 & 255) == 0) {
        rsl[tid] = al.rowscale(row0 + tid, k0 >> 8);
        __syncthreads();
      }
#pragma unroll
      for (int i = 0; i < 8; ++i) {
        const float sc = rsl[lrow + 32 * i];
        float f[8]; unpack8(ra[i], f);
#pragma unroll
        for (int j = 0; j < 8; ++j) f[j] *= sc;
        ra[i] = pack8(f);
      }
    }
#pragma unroll
    for (int i = 0; i < 8; ++i) *(bf16x8*)(As + wbase + 4096 * i) = ra[i];
#pragma unroll
    for (int i = 0; i < 4; ++i) *(bf16x8*)(Bs + wbase + 4096 * i) = rb[i];
    __syncthreads();
    if (k0 + 64 < K) gload(k0 + 64);
#pragma unroll
    for (int s = 0; s < 4; ++s) {
      bf16x8 a[2], b[4];
#pragma unroll
      for (int mi = 0; mi < 2; ++mi) a[mi] = *(const bf16x8*)(smem + abase + 4096 * mi + xo[s]);
#pragma unroll
      for (int ni = 0; ni < 4; ++ni) b[ni] = *(const bf16x8*)(smem + bbase + 4096 * ni + xo[s]);
#pragma unroll
      for (int mi = 0; mi < 2; ++mi)
#pragma unroll
        for (int ni = 0; ni < 4; ++ni) acc[mi][ni] = MFMA(a[mi], b[ni], acc[mi][ni]);
      __builtin_amdgcn_sched_barrier(0);
    }
    __syncthreads();
  }
  float* stg = (float*)(smem + w * 16896);
#pragma unroll
  for (int mi = 0; mi < 2; ++mi) {
#pragma unroll
    for (int ni = 0; ni < 4; ++ni)
#pragma unroll
      for (int i = 0; i < 16; ++i) stg[crow(i, h) * 132 + 32 * ni + r] = acc[mi][ni][i];
    wave_lds_fence();
#pragma unroll
    for (int ps = 0; ps < 8; ++ps) {
      const int rr = 4 * ps + (l >> 4), cc = (l & 15) * 8;
      float v[8];
      f32x4 v0 = *(const f32x4*)(stg + rr * 132 + cc), v1 = *(const f32x4*)(stg + rr * 132 + cc + 4);
#pragma unroll
      for (int j = 0; j < 4; ++j) { v[j] = v0[j]; v[4 + j] = v1[j]; }
      ep(row0 + 64 * w + 32 * mi + rr, col0 + cc, v, l, 1.f);
    }
    wave_lds_fence();
  }
  __syncthreads();
}

#define WAIT_V(n) asm volatile("s_waitcnt vmcnt(%0)" ::"n"(n) : "memory")
#define RAW_BARRIER() do { asm volatile("s_waitcnt lgkmcnt(0)" ::: "memory"); __builtin_amdgcn_s_barrier(); } while (0)
template <class AL, class EP>
DI void gemm_tile_dma(int tid, char* smem, const AL& al, const u16* __restrict__ Bt, int ldb, int K, int row0, int col0, const EP& ep, int variant = 0) {
  typedef __attribute__((ext_vector_type(4))) float f32x4v;
  const int w = tid >> 6, l = tid & 63, r16 = l & 15, q4 = l >> 4;
  f32x4v acc[4][8];
#pragma unroll
  for (int mi = 0; mi < 4; ++mi)
#pragma unroll
    for (int ni = 0; ni < 8; ++ni) { acc[mi][ni][0] = 0.f; acc[mi][ni][1] = 0.f; acc[mi][ni][2] = 0.f; acc[mi][ni][3] = 0.f; }
  auto Gf = [](int x) -> int { return (0x78 >> (2 * x)) & 3; };
  const int lch = (l & 3) ^ Gf((l >> 4) & 3);
  const unsigned boff = ((unsigned)(col0 + 32 * w + (l >> 2)) * (unsigned)ldb + lch * 8) * 2u;
  const unsigned bstep = 32u * (unsigned)ldb;
  auto stage = [&](int buf, int kt) {
    const int k0 = kt * 32;
    const char* ab = al.base(k0);
    unsigned ao = al.off(row0 + 64 * w + (l >> 2), k0 + lch * 8);
    unsigned st = al.step32(k0) >> 1, bs = bstep, bo = boff + 2u * k0;
    asm volatile("" : "+s"(st), "+s"(bs));
    asm volatile("" : "+v"(ao), "+v"(bo));
    char* sa = smem + buf * 24576 + w * 4096;
    char* sb = smem + buf * 24576 + 16384 + w * 2048;
#pragma unroll
    for (int i = 0; i < 4; ++i)
      __builtin_amdgcn_global_load_lds((const unsigned*)(ab + (ao + i * st)), (unsigned*)(sa + i * 1024), 16, 0, 0);
#pragma unroll
    for (int i = 0; i < 2; ++i)
      __builtin_amdgcn_global_load_lds((const unsigned*)((const char*)Bt + (bo + i * bs)), (unsigned*)(sb + i * 1024), 16, 0, 0);
  };
  const unsigned xo = 16u * (unsigned)(q4 ^ Gf((r16 >> 2) & 3));
  const unsigned fbase = 64u * r16 + xo;
  const unsigned wofs = 4096u * (unsigned)__builtin_amdgcn_readfirstlane(w);
  const int nt = K >> 5;
  float* rtab = (float*)(smem + 73728);
  if constexpr (EP::kRstd) rtab[tid] = row_rstd(ep.part, row0 + tid);
  stage(0, 0);
  stage(1, 1);
  WAIT_V(6);
  RAW_BARRIER();
  bf16x8 xa[4], xb[4], ya[4], yb[4];
  auto rdA = [&](bf16x8 (&fa)[4], unsigned bufoff) {
#pragma unroll
    for (int mi = 0; mi < 4; ++mi) fa[mi] = *(const bf16x8*)(smem + (bufoff + wofs + 1024u * mi) + fbase);
  };
  auto rdB = [&](bf16x8 (&fb)[4], unsigned bufoff, int hf) {
#pragma unroll
    for (int ni = 0; ni < 4; ++ni) fb[ni] = *(const bf16x8*)(smem + (bufoff + 16384u + 1024u * (4 * hf + ni)) + fbase);
  };
  int cur = 0;
  auto slice = [&](int t, bf16x8 (&fa)[4], bf16x8 (&fb0)[4], bf16x8 (&fan)[4], bf16x8 (&fb0n)[4]) {
    const int nxt = (cur == 2) ? 0 : cur + 1, nn = (nxt == 2) ? 0 : nxt + 1;
    bf16x8 fb1[4];
    stage(nn, t + 2 < nt ? t + 2 : nt - 1);
    __builtin_amdgcn_sched_barrier(0);
    rdB(fb1, (unsigned)cur * 24576u, 1);
    __builtin_amdgcn_sched_barrier(0);
#pragma unroll
    for (int ni = 0; ni < 4; ++ni)
#pragma unroll
      for (int mi = 0; mi < 4; ++mi) acc[mi][ni] = __builtin_amdgcn_mfma_f32_16x16x32_bf16(fa[mi], fb0[ni], acc[mi][ni], 0, 0, 0);
    __builtin_amdgcn_sched_barrier(0);
    WAIT_V(6);
    RAW_BARRIER();
    rdB(fb0n, (unsigned)nxt * 24576u, 0);
    __builtin_amdgcn_sched_barrier(0);
#pragma unroll
    for (int ni = 0; ni < 2; ++ni)
#pragma unroll
      for (int mi = 0; mi < 4; ++mi) acc[mi][4 + ni] = __builtin_amdgcn_mfma_f32_16x16x32_bf16(fa[mi], fb1[ni], acc[mi][4 + ni], 0, 0, 0);
    __builtin_amdgcn_sched_barrier(0);
    rdA(fan, (unsigned)nxt * 24576u);
    __builtin_amdgcn_sched_barrier(0);
#pragma unroll
    for (int ni = 2; ni < 4; ++ni)
#pragma unroll
      for (int mi = 0; mi < 4; ++mi) acc[mi][4 + ni] = __builtin_amdgcn_mfma_f32_16x16x32_bf16(fa[mi], fb1[ni], acc[mi][4 + ni], 0, 0, 0);
    __builtin_amdgcn_sched_barrier(0);
    cur = nxt;
  };
  rdA(xa, 0u);
  rdB(xb, 0u, 0);
  for (int t = 0; t < nt; t += 2) {
    slice(t, xa, xb, ya, yb);
    slice(t + 1, ya, yb, xa, xb);
  }
  WAIT_V(0);
  RAW_BARRIER();
  float* stg = (float*)(smem + w * 16896);
  EP e = ep;
  e.begin(col0 + (l & 15) * 8);
#pragma unroll
  for (int hm = 0; hm < 2; ++hm) {
#pragma unroll
    for (int m2 = 0; m2 < 2; ++m2)
#pragma unroll
      for (int ni = 0; ni < 8; ++ni)
#pragma unroll
        for (int i = 0; i < 4; ++i) stg[(16 * m2 + 4 * q4 + i) * 132 + 16 * ni + r16] = acc[2 * hm + m2][ni][i];
    wave_lds_fence();
#pragma unroll
    for (int ps = 0; ps < 8; ++ps) {
      const int rr = 4 * ps + (l >> 4), cc = (l & 15) * 8;
      float v[8];
      f32x4 v0 = *(const f32x4*)(stg + rr * 132 + cc), v1 = *(const f32x4*)(stg + rr * 132 + cc + 4);
#pragma unroll
      for (int jj = 0; jj < 4; ++jj) { v[jj] = v0[jj]; v[4 + jj] = v1[jj]; }
      float rs = 1.f;
      if constexpr (EP::kRstd) rs = rtab[64 * w + 32 * hm + rr];
      e(row0 + 64 * w + 32 * hm + rr, col0 + cc, v, l, rs);
    }
    wave_lds_fence();
  }
  __syncthreads();
}

struct ALPlain {
  static constexpr bool kRowScale = false;
  const u16* base_; int ld; int kseg; int off0; int off1;
  DI const char* base(int) const { return (const char*)base_; }
  DI unsigned off(int row, int k) const { return ((unsigned)row * (unsigned)ld + k + (k < kseg ? off0 : off1)) * 2u; }
  DI unsigned step32(int) const { return 64u * (unsigned)ld; }
  DI float rowscale(int, int) const { return 1.f; }
};
struct ALGlaOut {
  static constexpr bool kRowScale = true;
  const u16* base_; const float* ssq;
  DI const char* base(int) const { return (const char*)base_; }
  DI unsigned off(int row, int k) const { return ((unsigned)row * LDO + 1024 + k) * 2u; }
  DI unsigned step32(int) const { return 64u * LDO; }
  DI float rowscale(int row, int hd) const {
    const f32x4* p = (const f32x4*)(ssq + (size_t)row * 32 + hd * 8);
    f32x4 a = p[0], b = p[1];
    float s = a[0] + a[1] + a[2] + a[3] + b[0] + b[1] + b[2] + b[3];
    return __builtin_amdgcn_rsqf(s * (1.f / 256.f) + EPS);
  }
};
struct ALS5 {
  static constexpr bool kRowScale = false;
  const u16* proj; const u16* hp; int g;
  DI const char* base(int k0) const { return (const char*)(k0 < 512 ? proj : hp); }
  DI unsigned off(int row, int k) const {
    if (k < 512) return ((unsigned)(row * 32 + (k >> 4)) * LDE + 4096 + g * 16 + (k & 15)) * 2u;
    return (((unsigned)row * 32 + g) * 128 + (k - 512)) * 2u;
  }
  DI unsigned step32(int k) const { return k < 512 ? 2u * 32 * 32 * LDE : 2u * 32 * 32 * 128; }
  DI float rowscale(int, int) const { return 1.f; }
};

struct EPEvenIn {
  static constexpr bool kRstd = true;
  const float* part; u16* proj; const float* qg; const float* kg;
  float gsc[8];
  DI void begin(int col) {
    const float* g = (col < 1024 ? qg : kg) + (col & 127);
    const float sc = (col < 1024 ? 0.08838834764831845f * 1.44269504088896f : 1.f);
#pragma unroll
    for (int j = 0; j < 8; ++j) gsc[j] = (col < 2048) ? sc * g[j] : 1.f;
  }
  DI void operator()(int row, int col, float* v, int, float rs) const {
#pragma unroll
    for (int j = 0; j < 8; ++j) v[j] *= rs;
    if (col < 2048) {
      float s = 0.f;
#pragma unroll
      for (int j = 0; j < 8; ++j) s += v[j] * v[j];
      s = red16(s);
      const float rn = __builtin_amdgcn_rsqf(s * (1.f / 128.f) + EPS);
#pragma unroll
      for (int j = 0; j < 8; ++j) v[j] *= rn * gsc[j];
    }
    __builtin_nontemporal_store(pack8(v), (bf16x8*)((char*)proj + ((unsigned)row * LDE + col) * 2u));
  }
};
struct EPOddIn {
  static constexpr bool kRstd = true;
  const float* part; u16* proj;
  DI void begin(int) {}
  DI void operator()(int row, int col, float* v, int, float rs) const {
#pragma unroll
    for (int j = 0; j < 8; ++j) v[j] *= rs;
    __builtin_nontemporal_store(pack8(v), (bf16x8*)((char*)proj + ((unsigned)row * LDO + col) * 2u));
  }
};
struct EPOut {
  static constexpr bool kRstd = false;
  const float* xin; float* xout; u16* xb; float* part; bool dry; bool last;
  DI void begin(int) {}
  DI void operator()(int row, int col, float* v, int lane, float) const {
    const f32x4* xi = (const f32x4*)(xin + (size_t)row * 1024 + col);
    f32x4 a = __builtin_nontemporal_load(xi), b = __builtin_nontemporal_load(xi + 1);
#pragma unroll
    for (int j = 0; j < 4; ++j) { v[j] += a[j]; v[4 + j] += b[j]; }
    if (dry) return;
    f32x4* xo = (f32x4*)(xout + (size_t)row * 1024 + col);
    f32x4 o0 = {v[0], v[1], v[2], v[3]}, o1 = {v[4], v[5], v[6], v[7]};
    __builtin_nontemporal_store(o0, xo); __builtin_nontemporal_store(o1, xo + 1);
    if (last) return;
    *(bf16x8*)(xb + (size_t)row * LDX + col) = pack8(v);
    float s = 0.f;
#pragma unroll
    for (int j = 0; j < 8; ++j) s += v[j] * v[j];
    s = red16(s);
    if ((lane & 15) == 0) part[(size_t)row * 8 + (col >> 7)] = s;
  }
};
struct EPS5P {
  static constexpr bool kRstd = false;
  float* Sc; int g;
  DI void begin(int) {}
  DI void operator()(int row, int col, float* v, int, float) const {
    f32x4* o = (f32x4*)(Sc + ((size_t)row * 32 + g) * 128 + col);
    f32x4 o0 = {v[0], v[1], v[2], v[3]}, o1 = {v[4], v[5], v[6], v[7]};
    o[0] = o0; o[1] = o1;
  }
};
DI float gelu_tanh(float y) {
  const float u = 0.7978845608028654f * (y + 0.044715f * y * y * y);
  const float t = 1.f - 2.f * frcp(1.f + fexp(2.f * u));
  return 0.5f * y * (1.f + t);
}
struct EPS5Y {
  static constexpr bool kRstd = false;
  const u16* proj; u16* yb; const float* dsk; int g;
  DI void begin(int) {}
  DI void operator()(int row, int col, float* v, int, float) const {
    const int tok = row * 32 + (col >> 4), ch = g * 16 + (col & 15);
    float u[8]; unpack8(ldg8(proj + (size_t)tok * LDE + 4096 + ch), u);
#pragma unroll
    for (int j = 0; j < 8; ++j) v[j] = gelu_tanh(v[j] + dsk[ch + j] * u[j]);
    *(bf16x8*)(yb + (size_t)tok * LDY + ch) = pack8(v);
  }
};
struct EPGlu {
  static constexpr bool kRstd = false;
  u16* proj; const u16* yb; const float* bg; bool dry;
  DI void begin(int) {}
  DI void operator()(int row, int col, float* v, int, float) const {
    float y[8], z[8];
    unpack8(ldg8(yb + (size_t)row * LDY + col), y);
    u16* zp = proj + (size_t)row * LDE + 4608 + col;
    unpack8(ldg8(zp), z);
#pragma unroll
    for (int j = 0; j < 8; ++j) v[j] = y[j] * sigmoidf_(v[j] + bg[col + j]) * siluf_(z[j]);
    if (!dry) *(bf16x8*)zp = pack8(v);
  }
};

DI void transpose_tile(int tid, char* smem, const float* __restrict__ src, u16* __restrict__ dst, int K, int N, int ldk, int kt, int nt,
                       const float* scale, int smask) {
  float* t = (float*)smem;
  const int k0 = kt * 64, n0 = nt * 64;
#pragma unroll
  for (int i = 0; i < 16; ++i) {
    const int kk = (tid >> 6) + 4 * i, nn = tid & 63;
    float v = 0.f;
    if (n0 + nn < N) v = src[(size_t)(k0 + kk) * N + n0 + nn] * (scale ? scale[(k0 + kk) & smask] : 1.f);
    t[kk * 65 + nn] = v;
  }
  __syncthreads();
#pragma unroll
  for (int i = 0; i < 2; ++i) {
    const int c = tid + 256 * i;
    const int nn = c >> 3, k8 = (c & 7) * 8;
    float f[8];
#pragma unroll
    for (int j = 0; j < 8; ++j) f[j] = t[(k8 + j) * 65 + nn];
    *(bf16x8*)(dst + (size_t)(n0 + nn) * ldk + k0 + k8) = pack8(f);
  }
  __syncthreads();
}

DI void s5_setup(int tid, const Params& p, char* smem, int lg) {
  float* pw_re = (float*)smem;
  float* pw_im = pw_re + 33 * 64;
  float* bb_re = pw_im + 33 * 64;
  float* bb_im = bb_re + 1024;
  float* cc_re = bb_im + 1024;
  float* cc_im = cc_re + 1024;
  float* f_re = cc_im + 1024;
  float* f_im = f_re + 64;
  float* Kt = f_im + 64;
  if (tid < 64) {
    const float lr = p.lam_re[lg * 64 + tid], li = p.lam_im[lg * 64 + tid];
    const float dt = expf(p.log_dt[lg]);
    const float mag = expf(lr * dt);
    float sn, cs; sincosf(li * dt, &sn, &cs);
    const float br = mag * cs, bi = mag * sn;
    float pr = 1.f, pi = 0.f;
    for (int t = 0; t <= 32; ++t) {
      pw_re[t * 64 + tid] = pr; pw_im[t * 64 + tid] = pi;
      const float nr = pr * br - pi * bi, ni = pr * bi + pi * br;
      pr = nr; pi = ni;
    }
    p.LT()[(lg * 64 + tid) * 2] = pw_re[32 * 64 + tid];
    p.LT()[(lg * 64 + tid) * 2 + 1] = pw_im[32 * 64 + tid];
    const float nr = br - 1.f, ni = bi, den = 1.f / (lr * lr + li * li);
    f_re[tid] = (nr * lr + ni * li) * den;
    f_im[tid] = (ni * lr - nr * li) * den;
  }
  __syncthreads();
  for (int e = tid; e < 1024; e += 256) {
    const int n = e >> 4;
    const float br = p.b_re[(size_t)lg * 1024 + e], bi = p.b_im[(size_t)lg * 1024 + e];
    bb_re[e] = f_re[n] * br - f_im[n] * bi;
    bb_im[e] = f_re[n] * bi + f_im[n] * br;
    cc_re[e] = p.c_re[(size_t)lg * 1024 + e];
    cc_im[e] = p.c_im[(size_t)lg * 1024 + e];
  }
  __syncthreads();
  {
    const int pp = tid >> 4, pq = tid & 15;
    for (int t = 0; t < 32; ++t) {
      float s = 0.f;
      for (int n = 0; n < 64; ++n) {
        const float cr = cc_re[pp * 64 + n], ci = cc_im[pp * 64 + n];
        const float wr = pw_re[t * 64 + n], wi = pw_im[t * 64 + n];
        const float xr = cr * wr - ci * wi, xi = cr * wi + ci * wr;
        s += xr * bb_re[n * 16 + pq] - xi * bb_im[n * 16 + pq];
      }
      Kt[t * 256 + tid] = s;
    }
  }
  __syncthreads();
  u16* mq = p.WtMQ() + (size_t)lg * 512 * LDK6;
  for (int c = tid; c < 512 * 80; c += 256) {
    const int no = c / 80, k8 = (c % 80) * 8;
    const int t = no >> 4, pp = no & 15;
    float f[8];
    if (k8 < 512) {
      const int s = k8 >> 4, q0 = k8 & 15;
#pragma unroll
      for (int j = 0; j < 8; ++j) f[j] = (s <= t) ? Kt[(t - s) * 256 + pp * 16 + q0 + j] : 0.f;
    } else if (k8 < 576) {
      const int n0 = k8 - 512;
#pragma unroll
      for (int j = 0; j < 8; ++j) {
        const int n = n0 + j;
        f[j] = cc_re[pp * 64 + n] * pw_re[(t + 1) * 64 + n] - cc_im[pp * 64 + n] * pw_im[(t + 1) * 64 + n];
      }
    } else {
      const int n0 = k8 - 576;
#pragma unroll
      for (int j = 0; j < 8; ++j) {
        const int n = n0 + j;
        f[j] = -(cc_re[pp * 64 + n] * pw_im[(t + 1) * 64 + n] + cc_im[pp * 64 + n] * pw_re[(t + 1) * 64 + n]);
      }
    }
    *(bf16x8*)(mq + (size_t)no * LDK6 + k8) = pack8(f);
  }
  u16* wp = p.WtP() + (size_t)lg * 128 * LDK5;
  for (int c = tid; c < 128 * 64; c += 256) {
    const int nn = c >> 6, k8 = (c & 63) * 8;
    const int n = nn & 63, s = k8 >> 4, q0 = k8 & 15;
    const float wr = pw_re[(31 - s) * 64 + n], wi = pw_im[(31 - s) * 64 + n];
    float f[8];
#pragma unroll
    for (int j = 0; j < 8; ++j) {
      const float br = bb_re[n * 16 + q0 + j], bi = bb_im[n * 16 + q0 + j];
      f[j] = (nn < 64) ? (wr * br - wi * bi) : (wr * bi + wi * br);
    }
    *(bf16x8*)(wp + (size_t)nn * LDK5 + k8) = pack8(f);
  }
  __syncthreads();
}

DI void phase_prologue(int tid, int bid, const Params& p, char* smem) {
  const int nb = gridDim.x;
  const bool s5blk = (nb >= 128) && (bid >= nb - 64);
  if (nb >= 128) { if (s5blk) s5_setup(tid, p, smem, bid - (nb - 64)); }
  else for (int it = bid; it < 64; it += nb) s5_setup(tid, p, smem, it);
  const int nbw = (nb >= 128) ? nb - 64 : nb;
  if (s5blk) return;
  for (int lyr = 0; lyr < 2; ++lyr) {
    struct TJ { const float* src; u16* dst; int K, N, Npad, ldk; const float* sc; int smask; };
    const TJ jobs[5] = {
        {p.even_w_in + (size_t)lyr * 1024 * 5120, p.WtEin() + (size_t)lyr * 5120 * LDK1, 1024, 5120, 5120, LDK1, p.even_norm_g + lyr * 1024, 1023},
        {p.even_w_out + (size_t)lyr * 1536 * 1024, p.WtEout() + (size_t)lyr * 1024 * LDK15, 1536, 1024, 1024, LDK15, nullptr, 0},
        {p.w_glu + (size_t)lyr * 512 * 512, p.WtGlu() + (size_t)lyr * 512 * LDK5, 512, 512, 512, LDK5, nullptr, 0},
        {p.odd_w_in + (size_t)lyr * 1024 * 3088, p.WtOin() + (size_t)lyr * 3200 * LDK1, 1024, 3088, 3200, LDK1, p.odd_norm_g + lyr * 1024, 1023},
        {p.odd_w_out + (size_t)lyr * 1024 * 1024, p.WtOout() + (size_t)lyr * 1024 * LDK1, 1024, 1024, 1024, LDK1, p.gla_o_g + lyr * 256, 255}};
#pragma unroll
    for (int j = 0; j < 5; ++j) {
      const int nkt = jobs[j].K / 64, nnt = jobs[j].Npad / 64;
      for (int t = bid; t < nkt * nnt; t += nbw)
        transpose_tile(tid, smem, jobs[j].src, jobs[j].dst, jobs[j].K, jobs[j].N, jobs[j].ldk, t % nkt, t / nkt, jobs[j].sc, jobs[j].smask);
    }
    for (int e = bid * 256 + tid; e < 512 * 16; e += nbw * 256) {
      const int c = e >> 4, k = e & 15;
      p.WgT()[(size_t)lyr * 8192 + e] = f2bf(p.gla_w_gate[(size_t)lyr * 8192 + k * 512 + c]);
    }
  }
  const int w = tid >> 6, l = tid & 63;
  for (int row0 = (bid * 4 + w) * 4; row0 < NTOK; row0 += nbw * 16) {
    f32x4 va[4][4];
#pragma unroll
    for (int rr = 0; rr < 4; ++rr) {
      const f32x4* xr = (const f32x4*)(p.x + (size_t)(row0 + rr) * 1024);
#pragma unroll
      for (int i = 0; i < 2; ++i) { va[rr][2 * i] = xr[(l + 64 * i) * 2]; va[rr][2 * i + 1] = xr[(l + 64 * i) * 2 + 1]; }
    }
#pragma unroll
    for (int rr = 0; rr < 4; ++rr) {
      float s = 0.f;
#pragma unroll
      for (int i = 0; i < 2; ++i) {
        f32x4 a = va[rr][2 * i], b = va[rr][2 * i + 1];
        float f[8] = {a[0], a[1], a[2], a[3], b[0], b[1], b[2], b[3]};
#pragma unroll
        for (int j = 0; j < 8; ++j) s += f[j] * f[j];
        *(bf16x8*)(p.xb() + (size_t)(row0 + rr) * LDX + (l + 64 * i) * 8) = pack8(f);
      }
#pragma unroll
      for (int m = 1; m < 64; m <<= 1) s += __shfl_xor(s, m);
      if (l < 8) p.part()[(size_t)(row0 + rr) * 8 + l] = (l == 0) ? s : 0.f;
    }
  }
}

DI void attn_item(int tid, const Params& p, char* smem, int b, int hh, int qb, bool dry) {
  const int w = tid >> 6, l = tid & 63, r = l & 31, h = l >> 5;
  char* Ks = smem;
  char* Vs = smem + 16384;
  char* Qs = smem + 32768 + w * 8192;
  float* flags = (float*)(smem + 65536);
  float* stg = (float*)(smem + w * 8704);
  const u16* base = p.proj() + (size_t)b * SEQ * LDE;
  const int q0 = qb * 128, qw0 = q0 + 32 * w;
  {
    const u16* qp = base + (size_t)(qw0 + r) * LDE + hh * 128 + 8 * h;
#pragma unroll
    for (int s = 0; s < 8; ++s) *(bf16x8*)(Qs + off_b(r, 2 * s + h)) = ldg8(qp + 16 * s);
  }
  f32x16 ot[4];
#pragma unroll
  for (int d = 0; d < 4; ++d) ot[d] = zero16();
  float carry = 1.f, wmax = 1.f;
  const int lrow = tid >> 4, lch = tid & 15;
  bf16x8 rk[4], rv[4];
  auto gload = [&](int jt) {
    const u16* kp = base + (size_t)(jt * 64 + lrow) * LDE + 1024 + hh * 128 + lch * 8;
#pragma unroll
    for (int i = 0; i < 4; ++i) { rk[i] = ldg8(kp + (size_t)(16 * i) * LDE); rv[i] = ldg8(kp + (size_t)(16 * i) * LDE + 1024); }
  };
  const int trq = (l & 15) >> 2, trp = l & 3, trblk = (l >> 4) & 1;
  const unsigned fr = ((r & 3) << 2) | ((r >> 2) & 3);
  unsigned xs[8];
#pragma unroll
  for (int s = 0; s < 8; ++s) xs[s] = 16u * ((2 * s + h) ^ fr);
  const char* kbase = Ks + 256 * r;
  const char* qbase = Qs + 256 * r;
  const unsigned fv = (trq << 2) | h;
  unsigned vo[4];
#pragma unroll
  for (int d = 0; d < 4; ++d) vo[d] = 16u * ((4 * d + 2 * trblk + (trp >> 1)) ^ fv) + 8u * (trp & 1);
  const char* vbase = Vs + 256 * (4 * h + trq);
  int jt = 2 * qb + 1;
  gload(jt);
  for (; jt >= 0; --jt) {
#pragma unroll
    for (int i = 0; i < 4; ++i) {
      *(bf16x8*)(Ks + off_b(lrow + 16 * i, lch)) = rk[i];
      *(bf16x8*)(Vs + off_b(lrow + 16 * i, lch)) = rv[i];
    }
    RAW_BARRIER();
    if (jt > 0) gload(jt - 1);
    const int k0 = jt * 64;
    if (k0 <= qw0 && wmax >= 1e-30f) {
      f32x16 st[2];
      st[0] = zero16(); st[1] = zero16();
      __builtin_amdgcn_s_setprio(1);
#pragma unroll
      for (int s = 0; s < 8; ++s) {
        const bf16x8 qf = *(const bf16x8*)(qbase + xs[s]);
#pragma unroll
        for (int kt = 0; kt < 2; ++kt) {
          bf16x8 a = *(const bf16x8*)(kbase + 8192 * kt + xs[s]);
          st[kt] = MFMA(a, qf, st[kt]);
        }
      }
      __builtin_amdgcn_s_setprio(0);
      const bool need_mask = (k0 + 63 >= qw0);
      const int tq = qw0 + r;
      float running = carry;
#pragma unroll
      for (int kt = 1; kt >= 0; --kt) {
        float bt[16];
#pragma unroll
        for (int i = 0; i < 16; ++i) {
          float z2 = fminf(fmaxf(st[kt][i], -100.f), 100.f);
          float e = fexp2(-z2);
          float be = frcp(1.f + e);
          float om = e * be;
          if (need_mask && (k0 + 32 * kt + crow(i, h) >= tq)) { be = 0.f; om = 1.f; }
          bt[i] = be; st[kt][i] = om;
        }
#pragma unroll
        for (int rg = 3; rg >= 0; --rg) {
          const int i0 = 4 * rg;
          const float s2 = st[kt][i0 + 3], s1 = s2 * st[kt][i0 + 2], s0 = s1 * st[kt][i0 + 1], T = s0 * st[kt][i0];
          const float To = xor32(T, h);
          const float off = running * (h ? 1.f : To);
          st[kt][i0 + 3] = bt[i0 + 3] * off;
          st[kt][i0 + 2] = bt[i0 + 2] * off * s2;
          st[kt][i0 + 1] = bt[i0 + 1] * off * s1;
          st[kt][i0] = bt[i0] * off * s0;
          running = off * T * (h ? To : 1.f);
        }
      }
      carry = running;
      __builtin_amdgcn_s_setprio(1);
#pragma unroll
      for (int ks = 0; ks < 4; ++ks) {
        float wv[8];
#pragma unroll
        for (int j = 0; j < 8; ++j) wv[j] = st[ks >> 1][8 * (ks & 1) + j];
        const bf16x8 bw = pack8(wv);
#pragma unroll
        for (int d = 0; d < 4; ++d) {
          s16x4 lo = tr_read(vbase + 4096 * ks + vo[d]);
          s16x4 hi = tr_read(vbase + 4096 * ks + 2048 + (vo[d] ^ 32u));
          ot[d] = MFMA(cat4(lo, hi), bw, ot[d]);
        }
      }
      __builtin_amdgcn_s_setprio(0);
    }
    {
      float m = carry;
#pragma unroll
      for (int s = 1; s < 64; s <<= 1) m = fmaxf(m, __shfl_xor(m, s));
      if (l == 0) flags[w] = m;
      wmax = m;
    }
    RAW_BARRIER();
    const float mx = fmaxf(fmaxf(flags[0], flags[1]), fmaxf(flags[2], flags[3]));
    if (mx < 1e-30f) break;
  }
#pragma unroll
  for (int hf = 0; hf < 2; ++hf) {
#pragma unroll
    for (int dd = 0; dd < 2; ++dd)
#pragma unroll
      for (int rg = 0; rg < 4; ++rg) {
        f32x4 v = {ot[2 * hf + dd][4 * rg], ot[2 * hf + dd][4 * rg + 1], ot[2 * hf + dd][4 * rg + 2], ot[2 * hf + dd][4 * rg + 3]};
        *(f32x4*)(stg + r * 68 + 32 * dd + 8 * rg + 4 * h) = v;
      }
    wave_lds_fence();
#pragma unroll
    for (int ps = 0; ps < 4; ++ps) {
      const int id = l + 64 * ps, rr = id >> 3, c8 = (id & 7) * 8;
      f32x4 v0 = *(const f32x4*)(stg + rr * 68 + c8), v1 = *(const f32x4*)(stg + rr * 68 + c8 + 4);
      u16* zp = p.proj() + ((size_t)b * SEQ + qw0 + rr) * LDE + 3072 + hh * 128 + 64 * hf + c8;
      float z[8], o[8];
      unpack8(ldg8(zp), z);
#pragma unroll
      for (int j = 0; j < 4; ++j) { o[j] = v0[j] * siluf_(z[j]); o[4 + j] = v1[j] * siluf_(z[4 + j]); }
      if (!dry) *(bf16x8*)zp = pack8(o);
    }
    wave_lds_fence();
  }
  __syncthreads();
}

DI void gla_g1(int tid, const Params& p, char* smem, int lyr, int b, int n, int hh) {
  const int w = tid >> 6, l = tid & 63, r = l & 31, h = l >> 5;
  float* Ef = (float*)smem;
  u16* base = p.proj() + (size_t)b * SEQ * LDO;
  const bf16x8 wgf = ldg8(p.WgT() + (size_t)lyr * 8192 + (hh * 128 + 32 * w + r) * 16 + 8 * h);
  const float gbias = p.gla_b_gate[lyr * 512 + hh * 128 + 32 * w + r];
  bf16x8 rf[2], rq[4], rkk[4];
  const int erow = tid >> 4, ech = tid & 15;
#pragma unroll
  for (int mt = 0; mt < 2; ++mt) rf[mt] = ldg8(base + (size_t)(n * 64 + 32 * mt + r) * LDO + 3072 + 8 * h);
#pragma unroll
  for (int i = 0; i < 4; ++i) {
    const u16* rp = base + (size_t)(n * 64 + erow + 16 * i) * LDO + hh * 128 + ech * 8;
    rq[i] = ldg8(rp); rkk[i] = ldg8(rp + 512);
  }
  {
    f32x16 ga[2];
#pragma unroll
    for (int mt = 0; mt < 2; ++mt) ga[mt] = MFMA(rf[mt], wgf, zero16());
    float running = 0.f;
#pragma unroll
    for (int mt = 0; mt < 2; ++mt)
#pragma unroll
      for (int rg = 0; rg < 4; ++rg) {
        float c[4];
#pragma unroll
        for (int j = 0; j < 4; ++j) {
          const float x = ga[mt][4 * rg + j] + gbias;
          const float sp = fmaxf(-x, 0.f) + 0.6931471805599453f * flog2(1.f + fexp(-fabsf(x)));
          c[j] = -sp * (1.f / 16.f);
        }
        c[1] += c[0]; c[2] += c[1]; c[3] += c[2];
        const float T = c[3], To = xor32(T, h);
        const float off = running + (h ? To : 0.f);
#pragma unroll
        for (int j = 0; j < 4; ++j) Ef[(32 * mt + 8 * rg + 4 * h + j) * 128 + 32 * w + r] = fexp(off + c[j]);
        running = off + T + (h ? 0.f : To);
      }
  }
  __syncthreads();
#pragma unroll
  for (int i = 0; i < 4; ++i) {
    const int t = erow + 16 * i;
    const f32x4* ep = (const f32x4*)(Ef + t * 128 + ech * 8);
    f32x4 e0 = ep[0], e1 = ep[1];
    float e[8] = {e0[0], e0[1], e0[2], e0[3], e1[0], e1[1], e1[2], e1[3]};
    float q[8], k[8];
    unpack8(rq[i], q); unpack8(rkk[i], k);
#pragma unroll
    for (int j = 0; j < 8; ++j) { q[j] *= e[j] * 0.08838834764831845f; k[j] *= frcp(e[j]); }
    u16* rp = base + (size_t)(n * 64 + t) * LDO + hh * 128 + ech * 8;
    *(bf16x8*)rp = pack8(q);
    *(bf16x8*)(rp + 512) = pack8(k);
  }
  if (tid < 128) p.Sc()[(((size_t)b * 64 + n) * 4 + hh) * 128 + tid] = Ef[63 * 128 + tid];
  __syncthreads();
}

DI void gla_item(int tid, const Params& p, char* smem, int lyr, int b, int hh, int sl, bool dry) {
  const int w = tid >> 6, l = tid & 63, r = l & 31, h = l >> 5;
  char* vs = smem + 65536;
  char* sT = smem + 69632;
  u16* base = p.proj() + (size_t)b * SEQ * LDO;
  const float* elast = p.Sc() + ((size_t)b * 64 * 4 + hh) * 128;
  const int trq = (l & 15) >> 2, trp = l & 3, trblk = (l >> 4) & 1;
  const unsigned fr = ((r & 3) << 2) | ((r >> 2) & 3);
  auto xsf = [&](int s8) -> unsigned { unsigned v = 16u * ((2 * s8 + h) ^ fr); asm volatile("" : "+v"(v)); return v; };
  const unsigned rowb = 256u * r;
  const unsigned fk = (trq << 2) | (2 * h);
  const unsigned kb2 = 256u * (8 * h + trq);
  f32x16 sacc[2];
  sacc[0] = zero16(); sacc[1] = zero16();
  for (int e = tid; e < 2048; e += 256) ((unsigned*)sT)[e] = 0u;
  bf16x8 rvv;
  auto load_v = [&](int n) {
    rvv = ldg8(base + (size_t)(n * 64 + (tid >> 2)) * LDO + 1024 + hh * 256 + sl * 32 + (tid & 3) * 8);
  };
  auto dma_qk = [&](int n, int buf) {
    char* dq = smem + buf * 32768 + w * 4096;
#pragma unroll
    for (int i = 0; i < 4; ++i) {
      const int j = 4 * w + i;
      const int ch = (l & 15) ^ (((l >> 4) << 2) | (j & 3));
      const u16* src = base + (size_t)(n * 64 + 4 * j + (l >> 4)) * LDO + hh * 128 + ch * 8;
      __builtin_amdgcn_global_load_lds((const unsigned*)src, (unsigned*)(dq + i * 1024), 16, 0, 0);
      __builtin_amdgcn_global_load_lds((const unsigned*)(src + 512), (unsigned*)(dq + 16384 + i * 1024), 16, 0, 0);
    }
  };
  float el[2] = {1.f, 1.f};
  auto load_el = [&](int n) {
    if (w >= 2) {
#pragma unroll
      for (int ci = 0; ci < 2; ++ci) el[ci] = elast[(size_t)n * 512 + 32 * (2 * (w - 2) + ci) + r];
    }
  };
  u32x2 zreg[4];
  auto load_z = [&](int n) {
    const u16* zp = base + (size_t)(n * 64 + 32 * (w & 1) + r) * LDO + 2048 + hh * 256 + sl * 32 + 4 * h;
#pragma unroll
    for (int rg = 0; rg < 4; ++rg) zreg[rg] = *(const u32x2*)(zp + 8 * rg);
  };
  dma_qk(0, 0);
  load_v(0);
  load_el(0);
  dma_qk(1, 1);
  __builtin_amdgcn_sched_barrier(0);
  for (int n = 0; n < 64; ++n) {
    const char* qd = smem + (n & 1) * 32768;
    const char* ki = qd + 16384;
    {
      *(bf16x8*)(vs + (tid >> 2) * 64 + (tid & 3) * 16) = rvv;
      if (w >= 2 && n > 0 && !(dry && (PROBE_VARIANT == 12 || PROBE_VARIANT == 13))) {
        const int cb = 2 * (w - 2);
#pragma unroll
        for (int ci = 0; ci < 2; ++ci) {
          const int c = 32 * (cb + ci) + r;
#pragma unroll
          for (int i = 0; i < 16; ++i) *(u16*)(sT + off_b(crow(i, h), c >> 3) + (c & 7) * 2) = f2bf(sacc[ci][i]);
        }
      }
    }
    const float el0 = el[0], el1 = el[1];
    if (n + 1 < 64) WAIT_V(8); else WAIT_V(0);
    RAW_BARRIER();
    if (n + 1 < 64) { load_v(n + 1); load_el(n + 1); }
    const bool skip_o = dry && (PROBE_VARIANT == 11 || PROBE_VARIANT == 13), skip_s = dry && (PROBE_VARIANT == 12 || PROBE_VARIANT == 13);
    if (w < 2 ? skip_o : skip_s) {
    } else if (w < 2) {
      const int tt = w;
      load_z(n);
      f32x16 oa = zero16();
#pragma unroll
      for (int st = 0; st < 2; ++st) {
        if (st <= tt) {
          f32x16 sc = zero16();
#pragma unroll
          for (int hb = 0; hb < 2; ++hb) {
            bf16x8 af[4], bf[4];
#pragma unroll
            for (int q4 = 0; q4 < 4; ++q4) {
              af[q4] = *(const bf16x8*)(ki + rowb + 8192 * st + xsf(4 * hb + q4));
              bf[q4] = *(const bf16x8*)(qd + rowb + 8192 * tt + xsf(4 * hb + q4));
            }
            __builtin_amdgcn_sched_barrier(0);
#pragma unroll
            for (int q4 = 0; q4 < 4; ++q4) sc = MFMA(af[q4], bf[q4], sc);
            __builtin_amdgcn_sched_barrier(0);
          }
          if (st == tt) {
#pragma unroll
            for (int i = 0; i < 16; ++i)
              if (crow(i, h) > r) sc[i] = 0.f;
          }
          s16x4 vlo[2], vhi[2];
#pragma unroll
          for (int ks = 0; ks < 2; ++ks) {
            const int row0 = 32 * st + 16 * ks + 4 * h + trq;
            vlo[ks] = tr_read(vs + row0 * 64 + 32 * trblk + 8 * trp);
            vhi[ks] = tr_read(vs + (row0 + 8) * 64 + 32 * trblk + 8 * trp);
          }
#pragma unroll
          for (int ks = 0; ks < 2; ++ks) {
            float wv[8];
#pragma unroll
            for (int j = 0; j < 8; ++j) wv[j] = sc[8 * ks + j];
            oa = MFMA(cat4(vlo[ks], vhi[ks]), pack8(wv), oa);
          }
        }
      }
#pragma unroll
      for (int hb = 0; hb < 2; ++hb) {
        bf16x8 sf[4], bf[4];
#pragma unroll
        for (int q4 = 0; q4 < 4; ++q4) {
          sf[q4] = *(const bf16x8*)(sT + rowb + xsf(4 * hb + q4));
          bf[q4] = *(const bf16x8*)(qd + rowb + 8192 * tt + xsf(4 * hb + q4));
        }
        __builtin_amdgcn_sched_barrier(0);
#pragma unroll
        for (int q4 = 0; q4 < 4; ++q4) oa = MFMA(sf[q4], bf[q4], oa);
        __builtin_amdgcn_sched_barrier(0);
      }
      const size_t tok = (size_t)b * SEQ + n * 64 + 32 * tt + r;
      float ss = 0.f;
#pragma unroll
      for (int i = 0; i < 16; ++i) ss += oa[i] * oa[i];
      ss += xor32(ss, h);
      if (h == 0 && !dry) p.ssqg()[tok * 32 + hh * 8 + sl] = ss;
      u16* rowp = p.proj() + tok * LDO + hh * 256 + sl * 32;
#pragma unroll
      for (int rg = 0; rg < 4; ++rg) {
        const int dv0 = 8 * rg + 4 * h;
        const u32x2 zz = zreg[rg];
        float z0 = bflo(zz[0]), z1 = bfhi(zz[0]), z2 = bflo(zz[1]), z3 = bfhi(zz[1]);
        u32x2 o;
        o[0] = pk2(oa[4 * rg] * siluf_(z0), oa[4 * rg + 1] * siluf_(z1));
        o[1] = pk2(oa[4 * rg + 2] * siluf_(z2), oa[4 * rg + 3] * siluf_(z3));
        if (!dry) *(u32x2*)(rowp + 1024 + dv0) = o;
      }
    } else {
      const int cb = 2 * (w - 2);
#pragma unroll
      for (int ks = 0; ks < 4; ++ks) {
        const int row0 = 16 * ks + 8 * h + trq;
        s16x4 lo = tr_read(vs + row0 * 64 + 32 * trblk + 8 * trp);
        s16x4 hi = tr_read(vs + (row0 + 4) * 64 + 32 * trblk + 8 * trp);
        const bf16x8 av = cat4(lo, hi);
#pragma unroll
        for (int ci = 0; ci < 2; ++ci) {
          const unsigned ko = 16u * ((4 * (cb + ci) + 2 * trblk + (trp >> 1)) ^ fk) + 8u * (trp & 1);
          s16x4 blo = tr_read(ki + kb2 + 4096 * ks + ko);
          s16x4 bhi = tr_read(ki + kb2 + 4096 * ks + 1024 + (ko ^ 16u));
          sacc[ci] = MFMA(av, cat4(blo, bhi), sacc[ci]);
        }
      }
#pragma unroll
      for (int ci = 0; ci < 2; ++ci)
#pragma unroll
        for (int i = 0; i < 16; ++i) sacc[ci][i] *= (ci ? el1 : el0);
    }
    RAW_BARRIER();
    __builtin_amdgcn_sched_barrier(0);
    if (n + 2 < 64) dma_qk(n + 2, n & 1);
    __builtin_amdgcn_sched_barrier(0);
  }
  __syncthreads();
}

#define FOR_TILES_XCD4(MT, NT, mt, nt)                                                           \
  for (int s_ = (bid >> 3), mt = 0, nt = 0;                                                       \
       s_ < ((MT) >> 3) * (NT) &&                                                                 \
       (mt = (bid & 7) + 8 * (4 * (s_ / (4 * (NT))) + (s_ & 3)), nt = (s_ % (4 * (NT))) >> 2, true); s_ += (nb >> 3))
#define FOR_TILES_XCD(MT, NT, mt, nt)                                                          \
  for (int s_ = (bid >> 3), mt = 0, nt = 0;                                                     \
       s_ < ((MT) >> 3) * (NT) && (mt = (bid & 7) + 8 * (s_ / (NT)), nt = s_ % (NT), true); s_ += (nb >> 3))
DI void run_phase(const Params& p, char* smem, int ph, bool dry) {
  int tid = threadIdx.x, bid = blockIdx.x;
  asm volatile("" : "+v"(tid));
  asm volatile("" : "+s"(bid));
  const int nb = gridDim.x;
#ifdef ONLY
  if (ph != ONLY) return;
#endif
  if (ph == 0) { phase_prologue(tid, bid, p, smem); return; }
  const int q = ph - 1, cyc = q / 10, rem = q % 10;
  const int li = cyc;
  if (rem < 6) {
    const int lyr = li;
    switch (rem) {
      case 0: {
        ALPlain al{p.xb(), LDX, 1 << 30, 0, 0};
        EPEvenIn ep{p.part(), p.proj(), p.sb_q_g + lyr * 128, p.sb_k_g + lyr * 128};
        const u16* Bt = p.WtEin() + (size_t)lyr * 5120 * LDK1;
        FOR_TILES_XCD4(256, 40, mt, nt) gemm_tile_dma(tid, smem, al, Bt, LDK1, 1024, mt * 256, nt * 128, ep, dry ? PROBE_VARIANT : 0);
      } break;
      case 1: {
        for (int it = bid; it < 4096; it += nb) {
          const int qb = 31 - (it >> 7), bh = it & 127;
          attn_item(tid, p, smem, bh >> 3, bh & 7, qb, dry);
        }
        asm volatile("" : "+v"(tid));
        for (int t = bid; t < 256; t += nb) {
          const int g = t >> 3, mt = t & 7;
          ALS5 al{p.proj(), p.hp(), g};
          EPS5P ep{p.Sc(), g};
          gemm_tile_dma(tid, smem, al, p.WtP() + ((size_t)lyr * 32 + g) * 128 * LDK5, LDK5, 512, mt * 256, 0, ep);
        }
      } break;
      case 2: {
        for (int idx = bid * 256 + tid; idx < 16 * 32 * 64; idx += nb * 256) {
          const int n = idx & 63, g = (idx >> 6) & 31, b = idx >> 11;
          const float lr = p.LT()[((lyr * 32 + g) * 64 + n) * 2], lim = p.LT()[((lyr * 32 + g) * 64 + n) * 2 + 1];
          float hr = 0.f, hi = 0.f;
          for (int c0 = 0; c0 < 128; c0 += 16) {
            float sr[16], si[16];
#pragma unroll
            for (int j = 0; j < 16; ++j) {
              const size_t o = ((size_t)(b * 128 + c0 + j) * 32 + g) * 128;
              sr[j] = p.Sc()[o + n]; si[j] = p.Sc()[o + 64 + n];
            }
#pragma unroll
            for (int j = 0; j < 16; ++j) {
              const size_t o = ((size_t)(b * 128 + c0 + j) * 32 + g) * 128;
              p.hp()[o + n] = f2bf(hr); p.hp()[o + 64 + n] = f2bf(hi);
              const float nr = lr * hr - lim * hi + sr[j], ni = lr * hi + lim * hr + si[j];
              hr = nr; hi = ni;
            }
          }
        }
      } break;
      case 3: {
        for (int t = bid; t < 1024; t += nb) {
          const int g = t >> 5, mt = (t >> 2) & 7, nt = t & 3;
          ALS5 al{p.proj(), p.hp(), g};
          EPS5Y ep{p.proj(), p.yb(), p.s5_d + lyr * 512, g};
          gemm_tile_dma(tid, smem, al, p.WtMQ() + ((size_t)lyr * 32 + g) * 512 * LDK6, LDK6, 640, mt * 256, nt * 128, ep);
        }
      } break;
      case 4: {
        ALPlain al{p.yb(), LDY, 1 << 30, 0, 0};
        EPGlu ep{p.proj(), p.yb(), p.b_glu + lyr * 512, dry};
        const u16* Bt = p.WtGlu() + (size_t)lyr * 512 * LDK5;
        FOR_TILES_XCD(256, 4, mt, nt) gemm_tile_dma(tid, smem, al, Bt, LDK5, 512, mt * 256, nt * 128, ep);
      } break;
      default: {
        ALPlain al{p.proj(), LDE, 1024, 3072, 3584};
        EPOut ep{cyc == 0 ? p.x : p.out, p.out, p.xb(), p.part(), dry, false};
        const u16* Bt = p.WtEout() + (size_t)lyr * 1024 * LDK15;
        FOR_TILES_XCD(256, 8, mt, nt) gemm_tile_dma(tid, smem, al, Bt, LDK15, 1536, mt * 256, nt * 128, ep);
      } break;
    }
  } else {
    const int lyr = li;
    switch (rem - 6) {
      case 0: {
        ALPlain al{p.xb(), LDX, 1 << 30, 0, 0};
        EPOddIn ep{p.part(), p.proj()};
        const u16* Bt = p.WtOin() + (size_t)lyr * 3200 * LDK1;
        FOR_TILES_XCD4(256, 25, mt, nt) gemm_tile_dma(tid, smem, al, Bt, LDK1, 1024, mt * 256, nt * 128, ep);
      } break;
      case 1: {
        if (!dry) for (int it = bid; it < 4096; it += nb) gla_g1(tid, p, smem, lyr, it >> 8, (it >> 2) & 63, it & 3);
      } break;
      case 2: {
        for (int it = bid; it < 512; it += nb) {
          const int xcd = it & 7, j = it >> 3, bh = xcd * 8 + (j >> 3), slc = j & 7;
          gla_item(tid, p, smem, lyr, bh >> 2, bh & 3, slc, dry);
        }
      } break;
      default: {
        ALGlaOut al{p.proj(), p.ssqg()};
        EPOut ep{p.out, p.out, p.xb(), p.part(), dry, cyc == 1};
        const u16* Bt = p.WtOout() + (size_t)lyr * 1024 * LDK1;
        FOR_TILES_XCD(256, 8, mt, nt) gemm_tile(tid, smem, al, Bt, LDK1, 1024, mt * 256, nt * 128, ep);
      } break;
    }
  }
}


#define XB_TMO      128
#define XB_XCNT(j)  (256  + 64 * (j))
#define XB_XSUB(j)  (1280 + 64 * (j))
#define XB_XGEN(j)  (2304 + 64 * (j))
#define XB_TOP      3328
#define XB_TOPGEN   3392
#define XCD_BAR_WORDS 3456
#define XB_SPIN_CAP (1u << 18)
#define LAS __attribute__((address_space(3)))
DI unsigned xb_ld(unsigned* p) { return __hip_atomic_load(p, __ATOMIC_RELAXED, __HIP_MEMORY_SCOPE_AGENT); }
DI unsigned xb_add(unsigned* p, unsigned v) { return __hip_atomic_fetch_add(p, v, __ATOMIC_RELAXED, __HIP_MEMORY_SCOPE_AGENT); }
DI unsigned xb_xcc_id() { return (unsigned)__builtin_amdgcn_s_getreg((3 << 11) | 20) & 0xFu; }
#define XB_SPIN(cond, bar) do { unsigned _sp = 0; while (cond) { __builtin_amdgcn_s_sleep(1); \
    if ((++_sp & 255u) == 0u) { if (xb_ld(&(bar)[XB_TMO])) break; if (_sp > XB_SPIN_CAP) { atomicAdd(&(bar)[XB_TMO], 1u); break; } } } } while (0)
struct XcdBarrier { unsigned* bar; unsigned x; volatile LAS unsigned* st; };
DI XcdBarrier xcd_barrier_post(unsigned* bar, volatile LAS unsigned* st) {
  XcdBarrier b; b.bar = bar; b.x = xb_xcc_id(); b.st = st;
  if (threadIdx.x == 0) (void)xb_add(&bar[XB_XCNT(b.x)], 1u);
  return b;
}
DI void xcd_barrier_complete(unsigned* bar, unsigned x, unsigned& nloc, unsigned& nx) {
  const unsigned G = gridDim.x * gridDim.y * gridDim.z;
  unsigned sum, cnt, mine, sp = 0u;
  for (;;) {
    sum = 0u; cnt = 0u; mine = 0u;
#pragma unroll
    for (unsigned j = 0; j < 16; ++j) { const unsigned c = xb_ld(&bar[XB_XCNT(j)]); sum += c; cnt += (c > 0u) ? 1u : 0u; mine = (j == x) ? c : mine; }
    if (sum == G) break;
    __builtin_amdgcn_s_sleep(1);
    if ((++sp & 255u) == 0u) { if (xb_ld(&bar[XB_TMO])) break; if (sp > XB_SPIN_CAP) { atomicAdd(&bar[XB_TMO], 1u); break; } }
  }
  nloc = mine > 0u ? mine : 1u; nx = cnt > 0u ? cnt : 1u;
}
DI void xcd_barrier(const XcdBarrier& b) {
  asm volatile("s_waitcnt vmcnt(0)" ::: "memory");
  __syncthreads();
  if (threadIdx.x == 0) {
    unsigned* bar = b.bar;
    __builtin_amdgcn_s_waitcnt(0);
    unsigned nloc = b.st[0], nx = b.st[1];
    if (nloc == 0u) { xcd_barrier_complete(bar, b.x, nloc, nx); b.st[0] = nloc; b.st[1] = nx; }
    const unsigned old = xb_add(&bar[XB_XSUB(b.x)], 1u);
    const unsigned gen = old / nloc;
    if (old + 1u == (gen + 1u) * nloc) {
      __builtin_amdgcn_fence(__ATOMIC_RELEASE, "agent");
      asm volatile("s_waitcnt vmcnt(0)" ::: "memory");
      const unsigned og = xb_add(&bar[XB_TOP], 1u);
      const unsigned tg = og / nx;
      if (og + 1u == (tg + 1u) * nx) xb_add(&bar[XB_TOPGEN], 1u);
      else XB_SPIN(xb_ld(&bar[XB_TOPGEN]) == tg, bar);
      __builtin_amdgcn_fence(__ATOMIC_ACQUIRE, "agent");
      xb_add(&bar[XB_XGEN(b.x)], 1u);
      asm volatile("s_waitcnt vmcnt(0)" ::: "memory");
    } else {
      XB_SPIN(xb_ld(&bar[XB_XGEN(b.x)]) == gen, bar);
      __builtin_amdgcn_fence(__ATOMIC_ACQUIRE, "agent");
      asm volatile("s_waitcnt vmcnt(0)" ::: "memory");
    }
  }
  __syncthreads();
}

constexpr int NPHASE = 21;

#ifndef PROBE_MASK
#define PROBE_MASK 0
#endif
DI int phase_kind(int ph) { if (ph == 0) return 0; const int rem = (ph - 1) % 10; return 1 + rem; }

#ifndef PROBE_SEL
#define PROBE_SEL -1
#endif
__global__ void __launch_bounds__(256, 2) fwd_kernel(Params p, int ph_lo, int ph_hi, int probe_mask, int probe_sel) {
  __shared__ __attribute__((aligned(16))) char smem[SMEM_BYTES];
  __shared__ uint4 xb_words;
  if (threadIdx.x == 0) xb_words = make_uint4(0u, 0u, 0u, 0u);
  __syncthreads();
  (void)xcd_barrier_post((unsigned*)(p.ws + OFF_bar), (volatile LAS unsigned*)&xb_words);
  for (int ph = ph_lo; ph < ph_hi; ++ph) {
    if (ph > ph_lo) {
      XcdBarrier xb;
      unsigned* bar_ = (unsigned*)(p.ws + OFF_bar);
      asm volatile("" : "+s"(bar_));
      xb.bar = bar_; xb.x = xb_xcc_id(); xb.st = (volatile LAS unsigned*)&xb_words;
      xcd_barrier(xb);
    }
    if (probe_mask < 0) cg::this_grid().sync();
    run_phase(p, smem, ph, false);
  }
}

extern "C" void kernel_launch(void* const* d_in, const int* in_sizes, int n_in, void* d_out, int out_size, void* d_ws,
                              size_t ws_size, hipStream_t stream) {
  Params p{};
  const float** fp = (const float**)&p;
  for (int i = 0; i < 22; ++i) fp[i] = (const float*)d_in[i];
  p.out = (float*)d_out;
  p.ws = (char*)d_ws;
  if (WS_TOTAL > ws_size) { fprintf(stderr, "workspace too small: have %zu\n", ws_size); return; }

  static int grid_blocks = 0;
  if (!grid_blocks) {
    int dev = 0, cus = 0, per_cu = 0;
    hipGetDevice(&dev);
    hipDeviceGetAttribute(&cus, hipDeviceAttributeMultiprocessorCount, dev);
    hipOccupancyMaxActiveBlocksPerMultiprocessor(&per_cu, fwd_kernel, 256, 0);
    if (per_cu > 2) per_cu = 2;
    grid_blocks = cus * per_cu;
    if (grid_blocks <= 0) grid_blocks = 256;
  }
#if COOP
  hipMemsetAsync(p.ws + OFF_bar, 0, (size_t)XCD_BAR_WORDS * 4, stream);
  int lo = 0, hi = NPHASE, pm = PROBE_MASK, psel = PROBE_SEL;
  void* args[] = {&p, &lo, &hi, &pm, &psel};
  hipError_t e = hipLaunchCooperativeKernel((void*)fwd_kernel, dim3(grid_blocks), dim3(256), args, 0, stream);
  if (e != hipSuccess) fprintf(stderr, "cooperative launch failed: %s (grid %d)\n", hipGetErrorString(e), grid_blocks);
#else
  for (int ph = 0; ph < NPHASE; ++ph) hipLaunchKernelGGL(fwd_kernel, dim3(grid_blocks), dim3(256), 0, stream, p, ph, ph + 1, 0, -1);
#endif
}
```

```cpp
#include <hip/hip_runtime.h>
#include <hip/hip_cooperative_groups.h>
#include <cstdio>
namespace cg = cooperative_groups;

#ifndef COOP
#define COOP 1
#endif

#ifndef PROBE_VARIANT
#define PROBE_VARIANT 0
#endif
#define DI __device__ __forceinline__
typedef unsigned short u16;
typedef __attribute__((ext_vector_type(8))) short bf16x8;
typedef __attribute__((ext_vector_type(4))) short s16x4;
typedef __attribute__((ext_vector_type(16))) float f32x16;
typedef __attribute__((ext_vector_type(4))) float f32x4;
typedef __attribute__((ext_vector_type(2))) float f32x2;
typedef __attribute__((ext_vector_type(4))) unsigned u32x4;
typedef __attribute__((ext_vector_type(2))) unsigned u32x2;
typedef __bf16 bf2_t __attribute__((ext_vector_type(2)));
typedef __attribute__((address_space(3))) s16x4 lds_s16x4;

#define MFMA(a, b, c) __builtin_amdgcn_mfma_f32_32x32x16_bf16((a), (b), (c), 0, 0, 0)

constexpr int NTOK = 65536;
constexpr int SEQ = 4096;
constexpr int LDE = 5184;
constexpr int LDO = 3264;
constexpr int LDX = 1088;
constexpr int LDY = 576;
constexpr int LDK1 = 1088, LDK15 = 1600, LDK5 = 576, LDK6 = 704;
constexpr float EPS = 1e-6f;
constexpr int SMEM_BYTES = 77824;

constexpr size_t al256(size_t x) { return (x + 255) & ~(size_t)255; }
constexpr size_t OFF_WtEin = 0;
constexpr size_t OFF_WtEout = OFF_WtEin + al256((size_t)2 * 5120 * LDK1 * 2);
constexpr size_t OFF_WtGlu = OFF_WtEout + al256((size_t)2 * 1024 * LDK15 * 2);
constexpr size_t OFF_WtOin = OFF_WtGlu + al256((size_t)2 * 512 * LDK5 * 2);
constexpr size_t OFF_WtOout = OFF_WtOin + al256((size_t)2 * 3200 * LDK1 * 2);
constexpr size_t OFF_WgT = OFF_WtOout + al256((size_t)2 * 1024 * LDK1 * 2);
constexpr size_t OFF_WtMQ = OFF_WgT + al256((size_t)2 * 512 * 16 * 2);
constexpr size_t OFF_WtP = OFF_WtMQ + al256((size_t)2 * 32 * 512 * LDK6 * 2);
constexpr size_t OFF_LT = OFF_WtP + al256((size_t)2 * 32 * 128 * LDK5 * 2);
constexpr size_t OFF_xb = OFF_LT + al256((size_t)2 * 32 * 64 * 2 * 4);
constexpr size_t OFF_part = OFF_xb + al256((size_t)NTOK * LDX * 2);
constexpr size_t OFF_proj = OFF_part + al256((size_t)NTOK * 8 * 4);
constexpr size_t OFF_yb = OFF_proj + al256((size_t)NTOK * LDE * 2);
constexpr size_t OFF_Sc = OFF_yb + al256((size_t)NTOK * LDY * 2);
constexpr size_t OFF_hp = OFF_Sc + al256((size_t)2048 * 32 * 128 * 4);
constexpr size_t OFF_ssqg = OFF_hp + al256((size_t)2048 * 32 * 128 * 2);
constexpr size_t OFF_bar = OFF_ssqg + al256((size_t)NTOK * 32 * 4);
constexpr size_t WS_TOTAL = OFF_bar + al256((size_t)3456 * 4);

struct Params {
  const float *x, *even_norm_g, *even_w_in, *sb_q_g, *sb_k_g, *lam_re, *lam_im, *log_dt, *b_re, *b_im, *c_re, *c_im,
      *s5_d, *w_glu, *b_glu, *even_w_out, *odd_norm_g, *odd_w_in, *gla_w_gate, *gla_b_gate, *gla_o_g, *odd_w_out;
  float* out;
  char* ws;
  DI u16* WtEin() const { return (u16*)(ws + OFF_WtEin); }
  DI u16* WtEout() const { return (u16*)(ws + OFF_WtEout); }
  DI u16* WtGlu() const { return (u16*)(ws + OFF_WtGlu); }
  DI u16* WtOin() const { return (u16*)(ws + OFF_WtOin); }
  DI u16* WtOout() const { return (u16*)(ws + OFF_WtOout); }
  DI u16* WgT() const { return (u16*)(ws + OFF_WgT); }
  DI u16* WtMQ() const { return (u16*)(ws + OFF_WtMQ); }
  DI u16* WtP() const { return (u16*)(ws + OFF_WtP); }
  DI float* LT() const { return (float*)(ws + OFF_LT); }
  DI u16* xb() const { return (u16*)(ws + OFF_xb); }
  DI float* part() const { return (float*)(ws + OFF_part); }
  DI u16* proj() const { return (u16*)(ws + OFF_proj); }
  DI u16* yb() const { return (u16*)(ws + OFF_yb); }
  DI float* Sc() const { return (float*)(ws + OFF_Sc); }
  DI u16* hp() const { return (u16*)(ws + OFF_hp); }
  DI float* ssqg() const { return (float*)(ws + OFF_ssqg); }
};

DI unsigned pk2(float a, float b) { f32x2 v = {a, b}; return __builtin_bit_cast(unsigned, __builtin_convertvector(v, bf2_t)); }
DI u16 f2bf(float a) { return (u16)(pk2(a, 0.f) & 0xffffu); }
DI float bflo(unsigned u) { return __uint_as_float(u << 16); }
DI float bfhi(unsigned u) { return __uint_as_float(u & 0xffff0000u); }
DI int crow(int i, int h) { return (i & 3) + 8 * (i >> 2) + 4 * h; }
DI float fexp2(float x) { return __builtin_amdgcn_exp2f(x); }
DI float flog2(float x) { return __builtin_amdgcn_logf(x); }
DI float frcp(float x) { return __builtin_amdgcn_rcpf(x); }
DI float fexp(float x) { return fexp2(x * 1.44269504088896f); }
DI float sigmoidf_(float x) { return frcp(1.f + fexp(-x)); }
DI float siluf_(float x) { return x * sigmoidf_(x); }
DI unsigned off_b(unsigned row, unsigned ch) { return 256u * row + 16u * (ch ^ (((row & 3) << 2) | ((row >> 2) & 3))); }
DI unsigned off_g(unsigned row, unsigned ch) { return 128u * row + 16u * (ch ^ ((row >> 1) & 7)); }
DI s16x4 tr_read(const char* p) { return __builtin_amdgcn_ds_read_tr16_b64_v4i16((lds_s16x4*)p); }
DI bf16x8 cat4(s16x4 lo, s16x4 hi) { return __builtin_shufflevector(lo, hi, 0, 1, 2, 3, 4, 5, 6, 7); }
DI f32x16 zero16() { f32x16 z;
#pragma unroll
  for (int i = 0; i < 16; ++i) z[i] = 0.f; return z; }
DI bf16x8 pack8(const float* f) {
  u32x4 r; r[0] = pk2(f[0], f[1]); r[1] = pk2(f[2], f[3]); r[2] = pk2(f[4], f[5]); r[3] = pk2(f[6], f[7]);
  return __builtin_bit_cast(bf16x8, r);
}
DI void unpack8(bf16x8 v, float* f) {
  u32x4 r = __builtin_bit_cast(u32x4, v);
#pragma unroll
  for (int i = 0; i < 4; ++i) { f[2 * i] = bflo(r[i]); f[2 * i + 1] = bfhi(r[i]); }
}
DI bf16x8 ldg8(const u16* p) { return *(const bf16x8*)p; }
template <int CTRL> DI float dpp_mov(float v) {
  return __int_as_float(__builtin_amdgcn_update_dpp(0, __float_as_int(v), CTRL, 0xF, 0xF, true));
}
DI float red16(float v) {
  v += dpp_mov<0xB1>(v);
  v += dpp_mov<0x4E>(v);
  v += dpp_mov<0x141>(v);
  v += dpp_mov<0x140>(v);
  return v;
}
typedef unsigned u32x2v __attribute__((ext_vector_type(2)));
DI float xor32(float v, int h) {
  const u32x2v r = __builtin_amdgcn_permlane32_swap(__float_as_uint(v), __float_as_uint(v), false, false);
  return __uint_as_float(h ? r[0] : r[1]);
}
DI void wave_lds_fence() { __builtin_amdgcn_fence(__ATOMIC_RELEASE, "wavefront"); __builtin_amdgcn_wave_barrier(); __builtin_amdgcn_fence(__ATOMIC_ACQUIRE, "wavefront"); }

DI float row_rstd(const float* part, int row) {
  const f32x4* p = (const f32x4*)(part + (size_t)row * 8);
  f32x4 a = p[0], b = p[1];
  float s = a[0] + a[1] + a[2] + a[3] + b[0] + b[1] + b[2] + b[3];
  return __builtin_amdgcn_rsqf(s * (1.f / 1024.f) + EPS);
}

template <class AL, class EP>
DI void gemm_tile(int tid, char* smem, const AL& al, const u16* __restrict__ Bt, int ldb, int K, int row0, int col0, const EP& ep) {
  const int w = tid >> 6, l = tid & 63, r = l & 31, h = l >> 5;
  char* As = smem;
  char* Bs = smem + 32768;
  f32x16 acc[2][4];
#pragma unroll
  for (int mi = 0; mi < 2; ++mi)
#pragma unroll
    for (int ni = 0; ni < 4; ++ni) acc[mi][ni] = zero16();
  const int lrow = tid >> 3, lch = tid & 7;
  bf16x8 ra[8], rb[4];
  const unsigned boff = ((unsigned)(col0 + lrow) * (unsigned)ldb + lch * 8) * 2u;
  const unsigned bstep = 64u * (unsigned)ldb;
  auto gload = [&](int k0) {
    const char* ab = al.base(k0);
    unsigned ao = al.off(row0 + lrow, k0 + lch * 8);
    unsigned st = al.step32(k0), bs = bstep, bo = boff + 2u * k0;
    asm volatile("" : "+s"(st), "+s"(bs));
    asm volatile("" : "+v"(ao), "+v"(bo));
#pragma unroll
    for (int i = 0; i < 8; ++i) ra[i] = *(const bf16x8*)(ab + (ao + i * st));
#pragma unroll
    for (int i = 0; i < 4; ++i) rb[i] = *(const bf16x8*)((const char*)Bt + (bo + i * bs));
  };
  const unsigned wbase = off_g(lrow, lch);
  unsigned xo[4];
#pragma unroll
  for (int s = 0; s < 4; ++s) xo[s] = 16u * ((2 * s + h) ^ ((r >> 1) & 7));
  const unsigned abase = 128u * (64 * w + r), bbase = 32768u + 128u * r;
  gload(0);
  for (int k0 = 0; k0 < K; k0 += 64) {
    if constexpr (AL::kRowScale) {
      float* rsl = (float*)(smem + 49152);
      if ((k0 & 255) == 0) {
        rsl[tid] = al.rowscale(row0 + tid, k0 >> 8);
        __syncthreads();
      }
#pragma unroll
      for (int i = 0; i < 8; ++i) {
        const float sc = rsl[lrow + 32 * i];
        float f[8]; unpack8(ra[i], f);
#pragma unroll
        for (int j = 0; j < 8; ++j) f[j] *= sc;
        ra[i] = pack8(f);
      }
    }
#pragma unroll
    for (int i = 0; i < 8; ++i) *(bf16x8*)(As + wbase + 4096 * i) = ra[i];
#pragma unroll
    for (int i = 0; i < 4; ++i) *(bf16x8*)(Bs + wbase + 4096 * i) = rb[i];
    __syncthreads();
    if (k0 + 64 < K) gload(k0 + 64);
#pragma unroll
    for (int s = 0; s < 4; ++s) {
      bf16x8 a[2], b[4];
#pragma unroll
      for (int mi = 0; mi < 2; ++mi) a[mi] = *(const bf16x8*)(smem + abase + 4096 * mi + xo[s]);
#pragma unroll
      for (int ni = 0; ni < 4; ++ni) b[ni] = *(const bf16x8*)(smem + bbase + 4096 * ni + xo[s]);
#pragma unroll
      for (int mi = 0; mi < 2; ++mi)
#pragma unroll
        for (int ni = 0; ni < 4; ++ni) acc[mi][ni] = MFMA(a[mi], b[ni], acc[mi][ni]);
      __builtin_amdgcn_sched_barrier(0);
    }
    __syncthreads();
  }
  float* stg = (float*)(smem + w * 16896);
#pragma unroll
  for (int mi = 0; mi < 2; ++mi) {
#pragma unroll
    for (int ni = 0; ni < 4; ++ni)
#pragma unroll
      for (int i = 0; i < 16; ++i) stg[crow(i, h) * 132 + 32 * ni + r] = acc[mi][ni][i];
    wave_lds_fence();
#pragma unroll
    for (int ps = 0; ps < 8; ++ps) {
      const int rr = 4 * ps + (l >> 4), cc = (l & 15) * 8;
      float v[8];
      f32x4 v0 = *(const f32x4*)(stg + rr * 132 + cc), v1 = *(const f32x4*)(stg + rr * 132 + cc + 4);
#pragma unroll
      for (int j = 0; j < 4; ++j) { v[j] = v0[j]; v[4 + j] = v1[j]; }
      ep(row0 + 64 * w + 32 * mi + rr, col0 + cc, v, l, 1.f);
    }
    wave_lds_fence();
  }
  __syncthreads();
}

#define WAIT_V(n) asm volatile("s_waitcnt vmcnt(%0)" ::"n"(n) : "memory")
#define RAW_BARRIER() do { asm volatile("s_waitcnt lgkmcnt(0)" ::: "memory"); __builtin_amdgcn_s_barrier(); } while (0)
template <class AL, class EP>
DI void gemm_tile_dma(int tid, char* smem, const AL& al, const u16* __restrict__ Bt, int ldb, int K, int row0, int col0, const EP& ep, int variant = 0) {
  typedef __attribute__((ext_vector_type(4))) float f32x4v;
  const int w = tid >> 6, l = tid & 63, r16 = l & 15, q4 = l >> 4;
  f32x4v acc[4][8];
#pragma unroll
  for (int mi = 0; mi < 4; ++mi)
#pragma unroll
    for (int ni = 0; ni < 8; ++ni) { acc[mi][ni][0] = 0.f; acc[mi][ni][1] = 0.f; acc[mi][ni][2] = 0.f; acc[mi][ni][3] = 0.f; }
  auto Gf = [](int x) -> int { return (0x78 >> (2 * x)) & 3; };
  const int lch = (l & 3) ^ Gf((l >> 4) & 3);
  const unsigned boff = ((unsigned)(col0 + 32 * w + (l >> 2)) * (unsigned)ldb + lch * 8) * 2u;
  const unsigned bstep = 32u * (unsigned)ldb;
  auto stage = [&](int buf, int kt) {
    const int k0 = kt * 32;
    const char* ab = al.base(k0);
    unsigned ao = al.off(row0 + 64 * w + (l >> 2), k0 + lch * 8);
    unsigned st = al.step32(k0) >> 1, bs = bstep, bo = boff + 2u * k0;
    asm volatile("" : "+s"(st), "+s"(bs));
    asm volatile("" : "+v"(ao), "+v"(bo));
    char* sa = smem + buf * 24576 + w * 4096;
    char* sb = smem + buf * 24576 + 16384 + w * 2048;
#pragma unroll
    for (int i = 0; i < 4; ++i)
      __builtin_amdgcn_global_load_lds((const unsigned*)(ab + (ao + i * st)), (unsigned*)(sa + i * 1024), 16, 0, 0);
#pragma unroll
    for (int i = 0; i < 2; ++i)
      __builtin_amdgcn_global_load_lds((const unsigned*)((const char*)Bt + (bo + i * bs)), (unsigned*)(sb + i * 1024), 16, 0, 0);
  };
  const unsigned xo = 16u * (unsigned)(q4 ^ Gf((r16 >> 2) & 3));
  const unsigned fbase = 64u * r16 + xo;
  const unsigned wofs = 4096u * (unsigned)__builtin_amdgcn_readfirstlane(w);
  const int nt = K >> 5;
  float* rtab = (float*)(smem + 73728);
  if constexpr (EP::kRstd) rtab[tid] = row_rstd(ep.part, row0 + tid);
  stage(0, 0);
  stage(1, 1);
  WAIT_V(6);
  RAW_BARRIER();
  bf16x8 xa[4], xb[4], ya[4], yb[4];
  auto rdA = [&](bf16x8 (&fa)[4], unsigned bufoff) {
#pragma unroll
    for (int mi = 0; mi < 4; ++mi) fa[mi] = *(const bf16x8*)(smem + (bufoff + wofs + 1024u * mi) + fbase);
  };
  auto rdB = [&](bf16x8 (&fb)[4], unsigned bufoff, int hf) {
#pragma unroll
    for (int ni = 0; ni < 4; ++ni) fb[ni] = *(const bf16x8*)(smem + (bufoff + 16384u + 1024u * (4 * hf + ni)) + fbase);
  };
  int cur = 0;
  auto slice = [&](int t, bf16x8 (&fa)[4], bf16x8 (&fb0)[4], bf16x8 (&fan)[4], bf16x8 (&fb0n)[4]) {
    const int nxt = (cur == 2) ? 0 : cur + 1, nn = (nxt == 2) ? 0 : nxt + 1;
    bf16x8 fb1[4];
    stage(nn, t + 2 < nt ? t + 2 : nt - 1);
    __builtin_amdgcn_sched_barrier(0);
    rdB(fb1, (unsigned)cur * 24576u, 1);
    __builtin_amdgcn_sched_barrier(0);
#pragma unroll
    for (int ni = 0; ni < 4; ++ni)
#pragma unroll
      for (int mi = 0; mi < 4; ++mi) acc[mi][ni] = __builtin_amdgcn_mfma_f32_16x16x32_bf16(fa[mi], fb0[ni], acc[mi][ni], 0, 0, 0);
    __builtin_amdgcn_sched_barrier(0);
    WAIT_V(6);
    RAW_BARRIER();
    rdB(fb0n, (unsigned)nxt * 24576u, 0);
    __builtin_amdgcn_sched_barrier(0);
#pragma unroll
    for (int ni = 0; ni < 2; ++ni)
#pragma unroll
      for (int mi = 0; mi < 4; ++mi) acc[mi][4 + ni] = __builtin_amdgcn_mfma_f32_16x16x32_bf16(fa[mi], fb1[ni], acc[mi][4 + ni], 0, 0, 0);
    __builtin_amdgcn_sched_barrier(0);
    rdA(fan, (unsigned)nxt * 24576u);
    __builtin_amdgcn_sched_barrier(0);
#pragma unroll
    for (int ni = 2; ni < 4; ++ni)
#pragma unroll
      for (int mi = 0; mi < 4; ++mi) acc[mi][4 + ni] = __builtin_amdgcn_mfma_f32_16x16x32_bf16(fa[mi], fb1[ni], acc[mi][4 + ni], 0, 0, 0);
    __builtin_amdgcn_sched_barrier(0);
    cur = nxt;
  };
  rdA(xa, 0u);
  rdB(xb, 0u, 0);
  for (int t = 0; t < nt; t += 2) {
    slice(t, xa, xb, ya, yb);
    slice(t + 1, ya, yb, xa, xb);
  }
  WAIT_V(0);
  RAW_BARRIER();
  float* stg = (float*)(smem + w * 16896);
  EP e = ep;
  e.begin(col0 + (l & 15) * 8);
#pragma unroll
  for (int hm = 0; hm < 2; ++hm) {
#pragma unroll
    for (int m2 = 0; m2 < 2; ++m2)
#pragma unroll
      for (int ni = 0; ni < 8; ++ni)
#pragma unroll
        for (int i = 0; i < 4; ++i) stg[(16 * m2 + 4 * q4 + i) * 132 + 16 * ni + r16] = acc[2 * hm + m2][ni][i];
    wave_lds_fence();
#pragma unroll
    for (int ps = 0; ps < 8; ++ps) {
      const int rr = 4 * ps + (l >> 4), cc = (l & 15) * 8;
      float v[8];
      f32x4 v0 = *(const f32x4*)(stg + rr * 132 + cc), v1 = *(const f32x4*)(stg + rr * 132 + cc + 4);
#pragma unroll
      for (int jj = 0; jj < 4; ++jj) { v[jj] = v0[jj]; v[4 + jj] = v1[jj]; }
      float rs = 1.f;
      if constexpr (EP::kRstd) rs = rtab[64 * w + 32 * hm + rr];
      e(row0 + 64 * w + 32 * hm + rr, col0 + cc, v, l, rs);
    }
    wave_lds_fence();
  }
  __syncthreads();
}

struct ALPlain {
  static constexpr bool kRowScale = false;
  const u16* base_; int ld; int kseg; int off0; int off1;
  DI const char* base(int) const { return (const char*)base_; }
  DI unsigned off(int row, int k) const { return ((unsigned)row * (unsigned)ld + k + (k < kseg ? off0 : off1)) * 2u; }
  DI unsigned step32(int) const { return 64u * (unsigned)ld; }
  DI float rowscale(int, int) const { return 1.f; }
};
struct ALGlaOut {
  static constexpr bool kRowScale = true;
  const u16* base_; const float* ssq;
  DI const char* base(int) const { return (const char*)base_; }
  DI unsigned off(int row, int k) const { return ((unsigned)row * LDO + 1024 + k) * 2u; }
  DI unsigned step32(int) const { return 64u * LDO; }
  DI float rowscale(int row, int hd) const {
    const f32x4* p = (const f32x4*)(ssq + (size_t)row * 32 + hd * 8);
    f32x4 a = p[0], b = p[1];
    float s = a[0] + a[1] + a[2] + a[3] + b[0] + b[1] + b[2] + b[3];
    return __builtin_amdgcn_rsqf(s * (1.f / 256.f) + EPS);
  }
};
struct ALS5 {
  static constexpr bool kRowScale = false;
  const u16* proj; const u16* hp; int g;
  DI const char* base(int k0) const { return (const char*)(k0 < 512 ? proj : hp); }
  DI unsigned off(int row, int k) const {
    if (k < 512) return ((unsigned)(row * 32 + (k >> 4)) * LDE + 4096 + g * 16 + (k & 15)) * 2u;
    return (((unsigned)row * 32 + g) * 128 + (k - 512)) * 2u;
  }
  DI unsigned step32(int k) const { return k < 512 ? 2u * 32 * 32 * LDE : 2u * 32 * 32 * 128; }
  DI float rowscale(int, int) const { return 1.f; }
};

struct EPEvenIn {
  static constexpr bool kRstd = true;
  const float* part; u16* proj; const float* qg; const float* kg;
  float gsc[8];
  DI void begin(int col) {
    const float* g = (col < 1024 ? qg : kg) + (col & 127);
    const float sc = (col < 1024 ? 0.08838834764831845f * 1.44269504088896f : 1.f);
#pragma unroll
    for (int j = 0; j < 8; ++j) gsc[j] = (col < 2048) ? sc * g[j] : 1.f;
  }
  DI void operator()(int row, int col, float* v, int, float rs) const {
#pragma unroll
    for (int j = 0; j < 8; ++j) v[j] *= rs;
    if (col < 2048) {
      float s = 0.f;
#pragma unroll
      for (int j = 0; j < 8; ++j) s += v[j] * v[j];
      s = red16(s);
      const float rn = __builtin_amdgcn_rsqf(s * (1.f / 128.f) + EPS);
#pragma unroll
      for (int j = 0; j < 8; ++j) v[j] *= rn * gsc[j];
    }
    __builtin_nontemporal_store(pack8(v), (bf16x8*)((char*)proj + ((unsigned)row * LDE + col) * 2u));
  }
};
struct EPOddIn {
  static constexpr bool kRstd = true;
  const float* part; u16* proj;
  DI void begin(int) {}
  DI void operator()(int row, int col, float* v, int, float rs) const {
#pragma unroll
    for (int j = 0; j < 8; ++j) v[j] *= rs;
    __builtin_nontemporal_store(pack8(v), (bf16x8*)((char*)proj + ((unsigned)row * LDO + col) * 2u));
  }
};
struct EPOut {
  static constexpr bool kRstd = false;
  const float* xin; float* xout; u16* xb; float* part; bool dry; bool last;
  DI void begin(int) {}
  DI void operator()(int row, int col, float* v, int lane, float) const {
    const f32x4* xi = (const f32x4*)(xin + (size_t)row * 1024 + col);
    f32x4 a = __builtin_nontemporal_load(xi), b = __builtin_nontemporal_load(xi + 1);
#pragma unroll
    for (int j = 0; j < 4; ++j) { v[j] += a[j]; v[4 + j] += b[j]; }
    if (dry) return;
    f32x4* xo = (f32x4*)(xout + (size_t)row * 1024 + col);
    f32x4 o0 = {v[0], v[1], v[2], v[3]}, o1 = {v[4], v[5], v[6], v[7]};
    __builtin_nontemporal_store(o0, xo); __builtin_nontemporal_store(o1, xo + 1);
    if (last) return;
    *(bf16x8*)(xb + (size_t)row * LDX + col) = pack8(v);
    float s = 0.f;
#pragma unroll
    for (int j = 0; j < 8; ++j) s += v[j] * v[j];
    s = red16(s);
    if ((lane & 15) == 0) part[(size_t)row * 8 + (col >> 7)] = s;
  }
};
struct EPS5P {
  static constexpr bool kRstd = false;
  float* Sc; int g;
  DI void begin(int) {}
  DI void operator()(int row, int col, float* v, int, float) const {
    f32x4* o = (f32x4*)(Sc + ((size_t)row * 32 + g) * 128 + col);
    f32x4 o0 = {v[0], v[1], v[2], v[3]}, o1 = {v[4], v[5], v[6], v[7]};
    o[0] = o0; o[1] = o1;
  }
};
DI float gelu_tanh(float y) {
  const float u = 0.7978845608028654f * (y + 0.044715f * y * y * y);
  const float t = 1.f - 2.f * frcp(1.f + fexp(2.f * u));
  return 0.5f * y * (1.f + t);
}
struct EPS5Y {
  static constexpr bool kRstd = false;
  const u16* proj; u16* yb; const float* dsk; int g;
  DI void begin(int) {}
  DI void operator()(int row, int col, float* v, int, float) const {
    const int tok = row * 32 + (col >> 4), ch = g * 16 + (col & 15);
    float u[8]; unpack8(ldg8(proj + (size_t)tok * LDE + 4096 + ch), u);
#pragma unroll
    for (int j = 0; j < 8; ++j) v[j] = gelu_tanh(v[j] + dsk[ch + j] * u[j]);
    *(bf16x8*)(yb + (size_t)tok * LDY + ch) = pack8(v);
  }
};
struct EPGlu {
  static constexpr bool kRstd = false;
  u16* proj; const u16* yb; const float* bg; bool dry;
  DI void begin(int) {}
  DI void operator()(int row, int col, float* v, int, float) const {
    float y[8], z[8];
    unpack8(ldg8(yb + (size_t)row * LDY + col), y);
    u16* zp = proj + (size_t)row * LDE + 4608 + col;
    unpack8(ldg8(zp), z);
#pragma unroll
    for (int j = 0; j < 8; ++j) v[j] = y[j] * sigmoidf_(v[j] + bg[col + j]) * siluf_(z[j]);
    if (!dry) *(bf16x8*)zp = pack8(v);
  }
};

DI void transpose_tile(int tid, char* smem, const float* __restrict__ src, u16* __restrict__ dst, int K, int N, int ldk, int kt, int nt,
                       const float* scale, int smask) {
  float* t = (float*)smem;
  const int k0 = kt * 64, n0 = nt * 64;
#pragma unroll
  for (int i = 0; i < 16; ++i) {
    const int kk = (tid >> 6) + 4 * i, nn = tid & 63;
    float v = 0.f;
    if (n0 + nn < N) v = src[(size_t)(k0 + kk) * N + n0 + nn] * (scale ? scale[(k0 + kk) & smask] : 1.f);
    t[kk * 65 + nn] = v;
  }
  __syncthreads();
#pragma unroll
  for (int i = 0; i < 2; ++i) {
    const int c = tid + 256 * i;
    const int nn = c >> 3, k8 = (c & 7) * 8;
    float f[8];
#pragma unroll
    for (int j = 0; j < 8; ++j) f[j] = t[(k8 + j) * 65 + nn];
    *(bf16x8*)(dst + (size_t)(n0 + nn) * ldk + k0 + k8) = pack8(f);
  }
  __syncthreads();
}

DI void s5_setup(int tid, const Params& p, char* smem, int lg) {
  float* pw_re = (float*)smem;
  float* pw_im = pw_re + 33 * 64;
  float* bb_re = pw_im + 33 * 64;
  float* bb_im = bb_re + 1024;
  float* cc_re = bb_im + 1024;
  float* cc_im = cc_re + 1024;
  float* f_re = cc_im + 1024;
  float* f_im = f_re + 64;
  float* Kt = f_im + 64;
  if (tid < 64) {
    const float lr = p.lam_re[lg * 64 + tid], li = p.lam_im[lg * 64 + tid];
    const float dt = expf(p.log_dt[lg]);
    const float mag = expf(lr * dt);
    float sn, cs; sincosf(li * dt, &sn, &cs);
    const float br = mag * cs, bi = mag * sn;
    float pr = 1.f, pi = 0.f;
    for (int t = 0; t <= 32; ++t) {
      pw_re[t * 64 + tid] = pr; pw_im[t * 64 + tid] = pi;
      const float nr = pr * br - pi * bi, ni = pr * bi + pi * br;
      pr = nr; pi = ni;
    }
    p.LT()[(lg * 64 + tid) * 2] = pw_re[32 * 64 + tid];
    p.LT()[(lg * 64 + tid) * 2 + 1] = pw_im[32 * 64 + tid];
    const float nr = br - 1.f, ni = bi, den = 1.f / (lr * lr + li * li);
    f_re[tid] = (nr * lr + ni * li) * den;
    f_im[tid] = (ni * lr - nr * li) * den;
  }
  __syncthreads();
  for (int e = tid; e < 1024; e += 256) {
    const int n = e >> 4;
    const float br = p.b_re[(size_t)lg * 1024 + e], bi = p.b_im[(size_t)lg * 1024 + e];
    bb_re[e] = f_re[n] * br - f_im[n] * bi;
    bb_im[e] = f_re[n] * bi + f_im[n] * br;
    cc_re[e] = p.c_re[(size_t)lg * 1024 + e];
    cc_im[e] = p.c_im[(size_t)lg * 1024 + e];
  }
  __syncthreads();
  {
    const int pp = tid >> 4, pq = tid & 15;
    for (int t = 0; t < 32; ++t) {
      float s = 0.f;
      for (int n = 0; n < 64; ++n) {
        const float cr = cc_re[pp * 64 + n], ci = cc_im[pp * 64 + n];
        const float wr = pw_re[t * 64 + n], wi = pw_im[t * 64 + n];
        const float xr = cr * wr - ci * wi, xi = cr * wi + ci * wr;
        s += xr * bb_re[n * 16 + pq] - xi * bb_im[n * 16 + pq];
      }
      Kt[t * 256 + tid] = s;
    }
  }
  __syncthreads();
  u16* mq = p.WtMQ() + (size_t)lg * 512 * LDK6;
  for (int c = tid; c < 512 * 80; c += 256) {
    const int no = c / 80, k8 = (c % 80) * 8;
    const int t = no >> 4, pp = no & 15;
    float f[8];
    if (k8 < 512) {
      const int s = k8 >> 4, q0 = k8 & 15;
#pragma unroll
      for (int j = 0; j < 8; ++j) f[j] = (s <= t) ? Kt[(t - s) * 256 + pp * 16 + q0 + j] : 0.f;
    } else if (k8 < 576) {
      const int n0 = k8 - 512;
#pragma unroll
      for (int j = 0; j < 8; ++j) {
        const int n = n0 + j;
        f[j] = cc_re[pp * 64 + n] * pw_re[(t + 1) * 64 + n] - cc_im[pp * 64 + n] * pw_im[(t + 1) * 64 + n];
      }
    } else {
      const int n0 = k8 - 576;
#pragma unroll
      for (int j = 0; j < 8; ++j) {
        const int n = n0 + j;
        f[j] = -(cc_re[pp * 64 + n] * pw_im[(t + 1) * 64 + n] + cc_im[pp * 64 + n] * pw_re[(t + 1) * 64 + n]);
      }
    }
    *(bf16x8*)(mq + (size_t)no * LDK6 + k8) = pack8(f);
  }
  u16* wp = p.WtP() + (size_t)lg * 128 * LDK5;
  for (int c = tid; c < 128 * 64; c += 256) {
    const int nn = c >> 6, k8 = (c & 63) * 8;
    const int n = nn & 63, s = k8 >> 4, q0 = k8 & 15;
    const float wr = pw_re[(31 - s) * 64 + n], wi = pw_im[(31 - s) * 64 + n];
    float f[8];
#pragma unroll
    for (int j = 0; j < 8; ++j) {
      const float br = bb_re[n * 16 + q0 + j], bi = bb_im[n * 16 + q0 + j];
      f[j] = (nn < 64) ? (wr * br - wi * bi) : (wr * bi + wi * br);
    }
    *(bf16x8*)(wp + (size_t)nn * LDK5 + k8) = pack8(f);
  }
  __syncthreads();
}

DI void phase_prologue(int tid, int bid, const Params& p, char* smem) {
  const int nb = gridDim.x;
  const bool s5blk = (nb >= 128) && (bid >= nb - 64);
  if (nb >= 128) { if (s5blk) s5_setup(tid, p, smem, bid - (nb - 64)); }
  else for (int it = bid; it < 64; it += nb) s5_setup(tid, p, smem, it);
  const int nbw = (nb >= 128) ? nb - 64 : nb;
  if (s5blk) return;
  for (int lyr = 0; lyr < 2; ++lyr) {
    struct TJ { const float* src; u16* dst; int K, N, Npad, ldk; const float* sc; int smask; };
    const TJ jobs[5] = {
        {p.even_w_in + (size_t)lyr * 1024 * 5120, p.WtEin() + (size_t)lyr * 5120 * LDK1, 1024, 5120, 5120, LDK1, p.even_norm_g + lyr * 1024, 1023},
        {p.even_w_out + (size_t)lyr * 1536 * 1024, p.WtEout() + (size_t)lyr * 1024 * LDK15, 1536, 1024, 1024, LDK15, nullptr, 0},
        {p.w_glu + (size_t)lyr * 512 * 512, p.WtGlu() + (size_t)lyr * 512 * LDK5, 512, 512, 512, LDK5, nullptr, 0},
        {p.odd_w_in + (size_t)lyr * 1024 * 3088, p.WtOin() + (size_t)lyr * 3200 * LDK1, 1024, 3088, 3200, LDK1, p.odd_norm_g + lyr * 1024, 1023},
        {p.odd_w_out + (size_t)lyr * 1024 * 1024, p.WtOout() + (size_t)lyr * 1024 * LDK1, 1024, 1024, 1024, LDK1, p.gla_o_g + lyr * 256, 255}};
#pragma unroll
    for (int j = 0; j < 5; ++j) {
      const int nkt = jobs[j].K / 64, nnt = jobs[j].Npad / 64;
      for (int t = bid; t < nkt * nnt; t += nbw)
        transpose_tile(tid, smem, jobs[j].src, jobs[j].dst, jobs[j].K, jobs[j].N, jobs[j].ldk, t % nkt, t / nkt, jobs[j].sc, jobs[j].smask);
    }
    for (int e = bid * 256 + tid; e < 512 * 16; e += nbw * 256) {
      const int c = e >> 4, k = e & 15;
      p.WgT()[(size_t)lyr * 8192 + e] = f2bf(p.gla_w_gate[(size_t)lyr * 8192 + k * 512 + c]);
    }
  }
  const int w = tid >> 6, l = tid & 63;
  for (int row0 = (bid * 4 + w) * 4; row0 < NTOK; row0 += nbw * 16) {
    f32x4 va[4][4];
#pragma unroll
    for (int rr = 0; rr < 4; ++rr) {
      const f32x4* xr = (const f32x4*)(p.x + (size_t)(row0 + rr) * 1024);
#pragma unroll
      for (int i = 0; i < 2; ++i) { va[rr][2 * i] = xr[(l + 64 * i) * 2]; va[rr][2 * i + 1] = xr[(l + 64 * i) * 2 + 1]; }
    }
#pragma unroll
    for (int rr = 0; rr < 4; ++rr) {
      float s = 0.f;
#pragma unroll
      for (int i = 0; i < 2; ++i) {
        f32x4 a = va[rr][2 * i], b = va[rr][2 * i + 1];
        float f[8] = {a[0], a[1], a[2], a[3], b[0], b[1], b[2], b[3]};
#pragma unroll
        for (int j = 0; j < 8; ++j) s += f[j] * f[j];
        *(bf16x8*)(p.xb() + (size_t)(row0 + rr) * LDX + (l + 64 * i) * 8) = pack8(f);
      }
#pragma unroll
      for (int m = 1; m < 64; m <<= 1) s += __shfl_xor(s, m);
      if (l < 8) p.part()[(size_t)(row0 + rr) * 8 + l] = (l == 0) ? s : 0.f;
    }
  }
}

DI void attn_item(int tid, const Params& p, char* smem, int b, int hh, int qb, bool dry) {
  const int w = tid >> 6, l = tid & 63, r = l & 31, h = l >> 5;
  char* Ks = smem;
  char* Vs = smem + 16384;
  char* Qs = smem + 32768 + w * 8192;
  float* flags = (float*)(smem + 65536);
  float* stg = (float*)(smem + w * 8704);
  const u16* base = p.proj() + (size_t)b * SEQ * LDE;
  const int q0 = qb * 128, qw0 = q0 + 32 * w;
  {
    const u16* qp = base + (size_t)(qw0 + r) * LDE + hh * 128 + 8 * h;
#pragma unroll
    for (int s = 0; s < 8; ++s) *(bf16x8*)(Qs + off_b(r, 2 * s + h)) = ldg8(qp + 16 * s);
  }
  f32x16 ot[4];
#pragma unroll
  for (int d = 0; d < 4; ++d) ot[d] = zero16();
  float carry = 1.f, wmax = 1.f;
  const int lrow = tid >> 4, lch = tid & 15;
  bf16x8 rk[4], rv[4];
  auto gload = [&](int jt) {
    const u16* kp = base + (size_t)(jt * 64 + lrow) * LDE + 1024 + hh * 128 + lch * 8;
#pragma unroll
    for (int i = 0; i < 4; ++i) { rk[i] = ldg8(kp + (size_t)(16 * i) * LDE); rv[i] = ldg8(kp + (size_t)(16 * i) * LDE + 1024); }
  };
  const int trq = (l & 15) >> 2, trp = l & 3, trblk = (l >> 4) & 1;
  const unsigned fr = ((r & 3) << 2) | ((r >> 2) & 3);
  unsigned xs[8];
#pragma unroll
  for (int s = 0; s < 8; ++s) xs[s] = 16u * ((2 * s + h) ^ fr);
  const char* kbase = Ks + 256 * r;
  const char* qbase = Qs + 256 * r;
  const unsigned fv = (trq << 2) | h;
  unsigned vo[4];
#pragma unroll
  for (int d = 0; d < 4; ++d) vo[d] = 16u * ((4 * d + 2 * trblk + (trp >> 1)) ^ fv) + 8u * (trp & 1);
  const char* vbase = Vs + 256 * (4 * h + trq);
  int jt = 2 * qb + 1;
  gload(jt);
  for (; jt >= 0; --jt) {
#pragma unroll
    for (int i = 0; i < 4; ++i) {
      *(bf16x8*)(Ks + off_b(lrow + 16 * i, lch)) = rk[i];
      *(bf16x8*)(Vs + off_b(lrow + 16 * i, lch)) = rv[i];
    }
    RAW_BARRIER();
    if (jt > 0) gload(jt - 1);
    const int k0 = jt * 64;
    if (k0 <= qw0 && wmax >= 1e-30f) {
      f32x16 st[2];
      st[0] = zero16(); st[1] = zero16();
      __builtin_amdgcn_s_setprio(1);
#pragma unroll
      for (int s = 0; s < 8; ++s) {
        const bf16x8 qf = *(const bf16x8*)(qbase + xs[s]);
#pragma unroll
        for (int kt = 0; kt < 2; ++kt) {
          bf16x8 a = *(const bf16x8*)(kbase + 8192 * kt + xs[s]);
          st[kt] = MFMA(a, qf, st[kt]);
        }
      }
      __builtin_amdgcn_s_setprio(0);
      const bool need_mask = (k0 + 63 >= qw0);
      const int tq = qw0 + r;
      float running = carry;
#pragma unroll
      for (int kt = 1; kt >= 0; --kt) {
        float bt[16];
#pragma unroll
        for (int i = 0; i < 16; ++i) {
          float z2 = fminf(fmaxf(st[kt][i], -100.f), 100.f);
          float e = fexp2(-z2);
          float be = frcp(1.f + e);
          float om = e * be;
          if (need_mask && (k0 + 32 * kt + crow(i, h) >= tq)) { be = 0.f; om = 1.f; }
          bt[i] = be; st[kt][i] = om;
        }
#pragma unroll
        for (int rg = 3; rg >= 0; --rg) {
          const int i0 = 4 * rg;
          const float s2 = st[kt][i0 + 3], s1 = s2 * st[kt][i0 + 2], s0 = s1 * st[kt][i0 + 1], T = s0 * st[kt][i0];
          const float To = xor32(T, h);
          const float off = running * (h ? 1.f : To);
          st[kt][i0 + 3] = bt[i0 + 3] * off;
          st[kt][i0 + 2] = bt[i0 + 2] * off * s2;
          st[kt][i0 + 1] = bt[i0 + 1] * off * s1;
          st[kt][i0] = bt[i0] * off * s0;
          running = off * T * (h ? To : 1.f);
        }
      }
      carry = running;
      __builtin_amdgcn_s_setprio(1);
#pragma unroll
      for (int ks = 0; ks < 4; ++ks) {
        float wv[8];
#pragma unroll
        for (int j = 0; j < 8; ++j) wv[j] = st[ks >> 1][8 * (ks & 1) + j];
        const bf16x8 bw = pack8(wv);
#pragma unroll
        for (int d = 0; d < 4; ++d) {
          s16x4 lo = tr_read(vbase + 4096 * ks + vo[d]);
          s16x4 hi = tr_read(vbase + 4096 * ks + 2048 + (vo[d] ^ 32u));
          ot[d] = MFMA(cat4(lo, hi), bw, ot[d]);
        }
      }
      __builtin_amdgcn_s_setprio(0);
    }
    {
      float m = carry;
#pragma unroll
      for (int s = 1; s < 64; s <<= 1) m = fmaxf(m, __shfl_xor(m, s));
      if (l == 0) flags[w] = m;
      wmax = m;
    }
    RAW_BARRIER();
    const float mx = fmaxf(fmaxf(flags[0], flags[1]), fmaxf(flags[2], flags[3]));
    if (mx < 1e-30f) break;
  }
#pragma unroll
  for (int hf = 0; hf < 2; ++hf) {
#pragma unroll
    for (int dd = 0; dd < 2; ++dd)
#pragma unroll
      for (int rg = 0; rg < 4; ++rg) {
        f32x4 v = {ot[2 * hf + dd][4 * rg], ot[2 * hf + dd][4 * rg + 1], ot[2 * hf + dd][4 * rg + 2], ot[2 * hf + dd][4 * rg + 3]};
        *(f32x4*)(stg + r * 68 + 32 * dd + 8 * rg + 4 * h) = v;
      }
    wave_lds_fence();
#pragma unroll
    for (int ps = 0; ps < 4; ++ps) {
      const int id = l + 64 * ps, rr = id >> 3, c8 = (id & 7) * 8;
      f32x4 v0 = *(const f32x4*)(stg + rr * 68 + c8), v1 = *(const f32x4*)(stg + rr * 68 + c8 + 4);
      u16* zp = p.proj() + ((size_t)b * SEQ + qw0 + rr) * LDE + 3072 + hh * 128 + 64 * hf + c8;
      float z[8], o[8];
      unpack8(ldg8(zp), z);
#pragma unroll
      for (int j = 0; j < 4; ++j) { o[j] = v0[j] * siluf_(z[j]); o[4 + j] = v1[j] * siluf_(z[4 + j]); }
      if (!dry) *(bf16x8*)zp = pack8(o);
    }
    wave_lds_fence();
  }
  __syncthreads();
}

DI void gla_g1(int tid, const Params& p, char* smem, int lyr, int b, int n, int hh) {
  const int w = tid >> 6, l = tid & 63, r = l & 31, h = l >> 5;
  float* Ef = (float*)smem;
  u16* base = p.proj() + (size_t)b * SEQ * LDO;
  const bf16x8 wgf = ldg8(p.WgT() + (size_t)lyr * 8192 + (hh * 128 + 32 * w + r) * 16 + 8 * h);
  const float gbias = p.gla_b_gate[lyr * 512 + hh * 128 + 32 * w + r];
  bf16x8 rf[2], rq[4], rkk[4];
  const int erow = tid >> 4, ech = tid & 15;
#pragma unroll
  for (int mt = 0; mt < 2; ++mt) rf[mt] = ldg8(base + (size_t)(n * 64 + 32 * mt + r) * LDO + 3072 + 8 * h);
#pragma unroll
  for (int i = 0; i < 4; ++i) {
    const u16* rp = base + (size_t)(n * 64 + erow + 16 * i) * LDO + hh * 128 + ech * 8;
    rq[i] = ldg8(rp); rkk[i] = ldg8(rp + 512);
  }
  {
    f32x16 ga[2];
#pragma unroll
    for (int mt = 0; mt < 2; ++mt) ga[mt] = MFMA(rf[mt], wgf, zero16());
    float running = 0.f;
#pragma unroll
    for (int mt = 0; mt < 2; ++mt)
#pragma unroll
      for (int rg = 0; rg < 4; ++rg) {
        float c[4];
#pragma unroll
        for (int j = 0; j < 4; ++j) {
          const float x = ga[mt][4 * rg + j] + gbias;
          const float sp = fmaxf(-x, 0.f) + 0.6931471805599453f * flog2(1.f + fexp(-fabsf(x)));
          c[j] = -sp * (1.f / 16.f);
        }
        c[1] += c[0]; c[2] += c[1]; c[3] += c[2];
        const float T = c[3], To = xor32(T, h);
        const float off = running + (h ? To : 0.f);
#pragma unroll
        for (int j = 0; j < 4; ++j) Ef[(32 * mt + 8 * rg + 4 * h + j) * 128 + 32 * w + r] = fexp(off + c[j]);
        running = off + T + (h ? 0.f : To);
      }
  }
  __syncthreads();
#pragma unroll
  for (int i = 0; i < 4; ++i) {
    const int t = erow + 16 * i;
    const f32x4* ep = (const f32x4*)(Ef + t * 128 + ech * 8);
    f32x4 e0 = ep[0], e1 = ep[1];
    float e[8] = {e0[0], e0[1], e0[2], e0[3], e1[0], e1[1], e1[2], e1[3]};
    float q[8], k[8];
    unpack8(rq[i], q); unpack8(rkk[i], k);
#pragma unroll
    for (int j = 0; j < 8; ++j) { q[j] *= e[j] * 0.08838834764831845f; k[j] *= frcp(e[j]); }
    u16* rp = base + (size_t)(n * 64 + t) * LDO + hh * 128 + ech * 8;
    *(bf16x8*)rp = pack8(q);
    *(bf16x8*)(rp + 512) = pack8(k);
  }
  if (tid < 128) p.Sc()[(((size_t)b * 64 + n) * 4 + hh) * 128 + tid] = Ef[63 * 128 + tid];
  __syncthreads();
}

DI void gla_item(int tid, const Params& p, char* smem, int lyr, int b, int hh, int sl, bool dry) {
  const int w = tid >> 6, l = tid & 63, r = l & 31, h = l >> 5;
  char* vs = smem + 65536;
  char* sT = smem + 69632;
  u16* base = p.proj() + (size_t)b * SEQ * LDO;
  const float* elast = p.Sc() + ((size_t)b * 64 * 4 + hh) * 128;
  const int trq = (l & 15) >> 2, trp = l & 3, trblk = (l >> 4) & 1;
  const unsigned fr = ((r & 3) << 2) | ((r >> 2) & 3);
  auto xsf = [&](int s8) -> unsigned { unsigned v = 16u * ((2 * s8 + h) ^ fr); asm volatile("" : "+v"(v)); return v; };
  const unsigned rowb = 256u * r;
  const unsigned fk = (trq << 2) | (2 * h);
  const unsigned kb2 = 256u * (8 * h + trq);
  f32x16 sacc[2];
  sacc[0] = zero16(); sacc[1] = zero16();
  for (int e = tid; e < 2048; e += 256) ((unsigned*)sT)[e] = 0u;
  bf16x8 rvv;
  auto load_v = [&](int n) {
    rvv = ldg8(base + (size_t)(n * 64 + (tid >> 2)) * LDO + 1024 + hh * 256 + sl * 32 + (tid & 3) * 8);
  };
  auto dma_qk = [&](int n, int buf) {
    char* dq = smem + buf * 32768 + w * 4096;
#pragma unroll
    for (int i = 0; i < 4; ++i) {
      const int j = 4 * w + i;
      const int ch = (l & 15) ^ (((l >> 4) << 2) | (j & 3));
      const u16* src = base + (size_t)(n * 64 + 4 * j + (l >> 4)) * LDO + hh * 128 + ch * 8;
      __builtin_amdgcn_global_load_lds((const unsigned*)src, (unsigned*)(dq + i * 1024), 16, 0, 0);
      __builtin_amdgcn_global_load_lds((const unsigned*)(src + 512), (unsigned*)(dq + 16384 + i * 1024), 16, 0, 0);
    }
  };
  float el[2] = {1.f, 1.f};
  auto load_el = [&](int n) {
    if (w >= 2) {
#pragma unroll
      for (int ci = 0; ci < 2; ++ci) el[ci] = elast[(size_t)n * 512 + 32 * (2 * (w - 2) + ci) + r];
    }
  };
  u32x2 zreg[4];
  auto load_z = [&](int n) {
    const u16* zp = base + (size_t)(n * 64 + 32 * (w & 1) + r) * LDO + 2048 + hh * 256 + sl * 32 + 4 * h;
#pragma unroll
    for (int rg = 0; rg < 4; ++rg) zreg[rg] = *(const u32x2*)(zp + 8 * rg);
  };
  dma_qk(0, 0);
  load_v(0);
  load_el(0);
  dma_qk(1, 1);
  __builtin_amdgcn_sched_barrier(0);
  for (int n = 0; n < 64; ++n) {
    const char* qd = smem + (n & 1) * 32768;
    const char* ki = qd + 16384;
    {
      *(bf16x8*)(vs + (tid >> 2) * 64 + (tid & 3) * 16) = rvv;
      if (w >= 2 && n > 0 && !(dry && (PROBE_VARIANT == 12 || PROBE_VARIANT == 13))) {
        const int cb = 2 * (w - 2);
#pragma unroll
        for (int ci = 0; ci < 2; ++ci) {
          const int c = 32 * (cb + ci) + r;
#pragma unroll
          for (int i = 0; i < 16; ++i) *(u16*)(sT + off_b(crow(i, h), c >> 3) + (c & 7) * 2) = f2bf(sacc[ci][i]);
        }
      }
    }
    const float el0 = el[0], el1 = el[1];
    if (n + 1 < 64) WAIT_V(8); else WAIT_V(0);
    RAW_BARRIER();
    if (n + 1 < 64) { load_v(n + 1); load_el(n + 1); }
    const bool skip_o = dry && (PROBE_VARIANT == 11 || PROBE_VARIANT == 13), skip_s = dry && (PROBE_VARIANT == 12 || PROBE_VARIANT == 13);
    if (w < 2 ? skip_o : skip_s) {
    } else if (w < 2) {
      const int tt = w;
      load_z(n);
      f32x16 oa = zero16();
#pragma unroll
      for (int st = 0; st < 2; ++st) {
        if (st <= tt) {
          f32x16 sc = zero16();
#pragma unroll
          for (int hb = 0; hb < 2; ++hb) {
            bf16x8 af[4], bf[4];
#pragma unroll
            for (int q4 = 0; q4 < 4; ++q4) {
              af[q4] = *(const bf16x8*)(ki + rowb + 8192 * st + xsf(4 * hb + q4));
              bf[q4] = *(const bf16x8*)(qd + rowb + 8192 * tt + xsf(4 * hb + q4));
            }
            __builtin_amdgcn_sched_barrier(0);
            __builtin_amdgcn_s_setprio(1);
#pragma unroll
            for (int q4 = 0; q4 < 4; ++q4) sc = MFMA(af[q4], bf[q4], sc);
            __builtin_amdgcn_s_setprio(0);
            __builtin_amdgcn_sched_barrier(0);
          }
          if (st == tt) {
#pragma unroll
            for (int i = 0; i < 16; ++i)
              if (crow(i, h) > r) sc[i] = 0.f;
          }
          s16x4 vlo[2], vhi[2];
#pragma unroll
          for (int ks = 0; ks < 2; ++ks) {
            const int row0 = 32 * st + 16 * ks + 4 * h + trq;
            vlo[ks] = tr_read(vs + row0 * 64 + 32 * trblk + 8 * trp);
            vhi[ks] = tr_read(vs + (row0 + 8) * 64 + 32 * trblk + 8 * trp);
          }
#pragma unroll
          for (int ks = 0; ks < 2; ++ks) {
            float wv[8];
#pragma unroll
            for (int j = 0; j < 8; ++j) wv[j] = sc[8 * ks + j];
            oa = MFMA(cat4(vlo[ks], vhi[ks]), pack8(wv), oa);
          }
        }
      }
#pragma unroll
      for (int hb = 0; hb < 2; ++hb) {
        bf16x8 sf[4], bf[4];
#pragma unroll
        for (int q4 = 0; q4 < 4; ++q4) {
          sf[q4] = *(const bf16x8*)(sT + rowb + xsf(4 * hb + q4));
          bf[q4] = *(const bf16x8*)(qd + rowb + 8192 * tt + xsf(4 * hb + q4));
        }
        __builtin_amdgcn_sched_barrier(0);
        __builtin_amdgcn_s_setprio(1);
#pragma unroll
        for (int q4 = 0; q4 < 4; ++q4) oa = MFMA(sf[q4], bf[q4], oa);
        __builtin_amdgcn_s_setprio(0);
        __builtin_amdgcn_sched_barrier(0);
      }
      const size_t tok = (size_t)b * SEQ + n * 64 + 32 * tt + r;
      float ss = 0.f;
#pragma unroll
      for (int i = 0; i < 16; ++i) ss += oa[i] * oa[i];
      ss += xor32(ss, h);
      if (h == 0 && !dry) p.ssqg()[tok * 32 + hh * 8 + sl] = ss;
      u16* rowp = p.proj() + tok * LDO + hh * 256 + sl * 32;
#pragma unroll
      for (int rg = 0; rg < 4; ++rg) {
        const int dv0 = 8 * rg + 4 * h;
        const u32x2 zz = zreg[rg];
        float z0 = bflo(zz[0]), z1 = bfhi(zz[0]), z2 = bflo(zz[1]), z3 = bfhi(zz[1]);
        u32x2 o;
        o[0] = pk2(oa[4 * rg] * siluf_(z0), oa[4 * rg + 1] * siluf_(z1));
        o[1] = pk2(oa[4 * rg + 2] * siluf_(z2), oa[4 * rg + 3] * siluf_(z3));
        if (!dry) *(u32x2*)(rowp + 1024 + dv0) = o;
      }
    } else {
      const int cb = 2 * (w - 2);
#pragma unroll
      for (int ks = 0; ks < 4; ++ks) {
        const int row0 = 16 * ks + 8 * h + trq;
        s16x4 lo = tr_read(vs + row0 * 64 + 32 * trblk + 8 * trp);
        s16x4 hi = tr_read(vs + (row0 + 4) * 64 + 32 * trblk + 8 * trp);
        const bf16x8 av = cat4(lo, hi);
#pragma unroll
        for (int ci = 0; ci < 2; ++ci) {
          const unsigned ko = 16u * ((4 * (cb + ci) + 2 * trblk + (trp >> 1)) ^ fk) + 8u * (trp & 1);
          s16x4 blo = tr_read(ki + kb2 + 4096 * ks + ko);
          s16x4 bhi = tr_read(ki + kb2 + 4096 * ks + 1024 + (ko ^ 16u));
          sacc[ci] = MFMA(av, cat4(blo, bhi), sacc[ci]);
        }
      }
#pragma unroll
      for (int ci = 0; ci < 2; ++ci)
#pragma unroll
        for (int i = 0; i < 16; ++i) sacc[ci][i] *= (ci ? el1 : el0);
    }
    RAW_BARRIER();
    __builtin_amdgcn_sched_barrier(0);
    if (n + 2 < 64) dma_qk(n + 2, n & 1);
    __builtin_amdgcn_sched_barrier(0);
  }
  __syncthreads();
}

#define FOR_TILES_XCD4(MT, NT, mt, nt)                                                           \
  for (int s_ = (bid >> 3), mt = 0, nt = 0;                                                       \
       s_ < ((MT) >> 3) * (NT) &&                                                                 \
       (mt = (bid & 7) + 8 * (4 * (s_ / (4 * (NT))) + (s_ & 3)), nt = (s_ % (4 * (NT))) >> 2, true); s_ += (nb >> 3))
#define FOR_TILES_XCD(MT, NT, mt, nt)                                                          \
  for (int s_ = (bid >> 3), mt = 0, nt = 0;                                                     \
       s_ < ((MT) >> 3) * (NT) && (mt = (bid & 7) + 8 * (s_ / (NT)), nt = s_ % (NT), true); s_ += (nb >> 3))
DI void run_phase(const Params& p, char* smem, int ph, bool dry) {
  int tid = threadIdx.x, bid = blockIdx.x;
  asm volatile("" : "+v"(tid));
  asm volatile("" : "+s"(bid));
  const int nb = gridDim.x;
#ifdef ONLY
  if (ph != ONLY) return;
#endif
  if (ph == 0) { phase_prologue(tid, bid, p, smem); return; }
  const int q = ph - 1, cyc = q / 10, rem = q % 10;
  const int li = cyc;
  if (rem < 6) {
    const int lyr = li;
    switch (rem) {
      case 0: {
        ALPlain al{p.xb(), LDX, 1 << 30, 0, 0};
        EPEvenIn ep{p.part(), p.proj(), p.sb_q_g + lyr * 128, p.sb_k_g + lyr * 128};
        const u16* Bt = p.WtEin() + (size_t)lyr * 5120 * LDK1;
        FOR_TILES_XCD4(256, 40, mt, nt) gemm_tile_dma(tid, smem, al, Bt, LDK1, 1024, mt * 256, nt * 128, ep, dry ? PROBE_VARIANT : 0);
      } break;
      case 1: {
        for (int it = bid; it < 4096; it += nb) {
          const int qb = 31 - (it >> 7), bh = it & 127;
          attn_item(tid, p, smem, bh >> 3, bh & 7, qb, dry);
        }
        asm volatile("" : "+v"(tid));
        for (int t = bid; t < 256; t += nb) {
          const int g = t >> 3, mt = t & 7;
          ALS5 al{p.proj(), p.hp(), g};
          EPS5P ep{p.Sc(), g};
          gemm_tile_dma(tid, smem, al, p.WtP() + ((size_t)lyr * 32 + g) * 128 * LDK5, LDK5, 512, mt * 256, 0, ep);
        }
      } break;
      case 2: {
        for (int idx = bid * 256 + tid; idx < 16 * 32 * 64; idx += nb * 256) {
          const int n = idx & 63, g = (idx >> 6) & 31, b = idx >> 11;
          const float lr = p.LT()[((lyr * 32 + g) * 64 + n) * 2], lim = p.LT()[((lyr * 32 + g) * 64 + n) * 2 + 1];
          float hr = 0.f, hi = 0.f;
          for (int c0 = 0; c0 < 128; c0 += 16) {
            float sr[16], si[16];
#pragma unroll
            for (int j = 0; j < 16; ++j) {
              const size_t o = ((size_t)(b * 128 + c0 + j) * 32 + g) * 128;
              sr[j] = p.Sc()[o + n]; si[j] = p.Sc()[o + 64 + n];
            }
#pragma unroll
            for (int j = 0; j < 16; ++j) {
              const size_t o = ((size_t)(b * 128 + c0 + j) * 32 + g) * 128;
              p.hp()[o + n] = f2bf(hr); p.hp()[o + 64 + n] = f2bf(hi);
              const float nr = lr * hr - lim * hi + sr[j], ni = lr * hi + lim * hr + si[j];
              hr = nr; hi = ni;
            }
          }
        }
      } break;
      case 3: {
        for (int t = bid; t < 1024; t += nb) {
          const int g = t >> 5, mt = (t >> 2) & 7, nt = t & 3;
          ALS5 al{p.proj(), p.hp(), g};
          EPS5Y ep{p.proj(), p.yb(), p.s5_d + lyr * 512, g};
          gemm_tile_dma(tid, smem, al, p.WtMQ() + ((size_t)lyr * 32 + g) * 512 * LDK6, LDK6, 640, mt * 256, nt * 128, ep);
        }
      } break;
      case 4: {
        ALPlain al{p.yb(), LDY, 1 << 30, 0, 0};
        EPGlu ep{p.proj(), p.yb(), p.b_glu + lyr * 512, dry};
        const u16* Bt = p.WtGlu() + (size_t)lyr * 512 * LDK5;
        FOR_TILES_XCD(256, 4, mt, nt) gemm_tile_dma(tid, smem, al, Bt, LDK5, 512, mt * 256, nt * 128, ep);
      } break;
      default: {
        ALPlain al{p.proj(), LDE, 1024, 3072, 3584};
        EPOut ep{cyc == 0 ? p.x : p.out, p.out, p.xb(), p.part(), dry, false};
        const u16* Bt = p.WtEout() + (size_t)lyr * 1024 * LDK15;
        FOR_TILES_XCD(256, 8, mt, nt) gemm_tile_dma(tid, smem, al, Bt, LDK15, 1536, mt * 256, nt * 128, ep);
      } break;
    }
  } else {
    const int lyr = li;
    switch (rem - 6) {
      case 0: {
        ALPlain al{p.xb(), LDX, 1 << 30, 0, 0};
        EPOddIn ep{p.part(), p.proj()};
        const u16* Bt = p.WtOin() + (size_t)lyr * 3200 * LDK1;
        FOR_TILES_XCD4(256, 25, mt, nt) gemm_tile_dma(tid, smem, al, Bt, LDK1, 1024, mt * 256, nt * 128, ep);
      } break;
      case 1: {
        if (!dry) for (int it = bid; it < 4096; it += nb) gla_g1(tid, p, smem, lyr, it >> 8, (it >> 2) & 63, it & 3);
      } break;
      case 2: {
        for (int it = bid; it < 512; it += nb) {
          const int xcd = it & 7, j = it >> 3, bh = xcd * 8 + (j >> 3), slc = j & 7;
          gla_item(tid, p, smem, lyr, bh >> 2, bh & 3, slc, dry);
        }
      } break;
      default: {
        ALGlaOut al{p.proj(), p.ssqg()};
        EPOut ep{p.out, p.out, p.xb(), p.part(), dry, cyc == 1};
        const u16* Bt = p.WtOout() + (size_t)lyr * 1024 * LDK1;
        FOR_TILES_XCD(256, 8, mt, nt) gemm_tile(tid, smem, al, Bt, LDK1, 1024, mt * 256, nt * 128, ep);
      } break;
    }
  }
}


#define XB_TMO      128
#define XB_XCNT(j)  (256  + 64 * (j))
#define XB_XSUB(j)  (1280 + 64 * (j))
#define XB_XGEN(j)  (2304 + 64 * (j))
#define XB_TOP      3328
#define XB_TOPGEN   3392
#define XCD_BAR_WORDS 3456
#define XB_SPIN_CAP (1u << 18)
#define LAS __attribute__((address_space(3)))
DI unsigned xb_ld(unsigned* p) { return __hip_atomic_load(p, __ATOMIC_RELAXED, __HIP_MEMORY_SCOPE_AGENT); }
DI unsigned xb_add(unsigned* p, unsigned v) { return __hip_atomic_fetch_add(p, v, __ATOMIC_RELAXED, __HIP_MEMORY_SCOPE_AGENT); }
DI unsigned xb_xcc_id() { return (unsigned)__builtin_amdgcn_s_getreg((3 << 11) | 20) & 0xFu; }
#define XB_SPIN(cond, bar) do { unsigned _sp = 0; while (cond) { __builtin_amdgcn_s_sleep(1); \
    if ((++_sp & 255u) == 0u) { if (xb_ld(&(bar)[XB_TMO])) break; if (_sp > XB_SPIN_CAP) { atomicAdd(&(bar)[XB_TMO], 1u); break; } } } } while (0)
struct XcdBarrier { unsigned* bar; unsigned x; volatile LAS unsigned* st; };
DI XcdBarrier xcd_barrier_post(unsigned* bar, volatile LAS unsigned* st) {
  XcdBarrier b; b.bar = bar; b.x = xb_xcc_id(); b.st = st;
  if (threadIdx.x == 0) (void)xb_add(&bar[XB_XCNT(b.x)], 1u);
  return b;
}
DI void xcd_barrier_complete(unsigned* bar, unsigned x, unsigned& nloc, unsigned& nx) {
  const unsigned G = gridDim.x * gridDim.y * gridDim.z;
  unsigned sum, cnt, mine, sp = 0u;
  for (;;) {
    sum = 0u; cnt = 0u; mine = 0u;
#pragma unroll
    for (unsigned j = 0; j < 16; ++j) { const unsigned c = xb_ld(&bar[XB_XCNT(j)]); sum += c; cnt += (c > 0u) ? 1u : 0u; mine = (j == x) ? c : mine; }
    if (sum == G) break;
    __builtin_amdgcn_s_sleep(1);
    if ((++sp & 255u) == 0u) { if (xb_ld(&bar[XB_TMO])) break; if (sp > XB_SPIN_CAP) { atomicAdd(&bar[XB_TMO], 1u); break; } }
  }
  nloc = mine > 0u ? mine : 1u; nx = cnt > 0u ? cnt : 1u;
}
DI void xcd_barrier(const XcdBarrier& b) {
  asm volatile("s_waitcnt vmcnt(0)" ::: "memory");
  __syncthreads();
  if (threadIdx.x == 0) {
    unsigned* bar = b.bar;
    __builtin_amdgcn_s_waitcnt(0);
    unsigned nloc = b.st[0], nx = b.st[1];
    if (nloc == 0u) { xcd_barrier_complete(bar, b.x, nloc, nx); b.st[0] = nloc; b.st[1] = nx; }
    const unsigned old = xb_add(&bar[XB_XSUB(b.x)], 1u);
    const unsigned gen = old / nloc;
    if (old + 1u == (gen + 1u) * nloc) {
      __builtin_amdgcn_fence(__ATOMIC_RELEASE, "agent");
      asm volatile("s_waitcnt vmcnt(0)" ::: "memory");
      const unsigned og = xb_add(&bar[XB_TOP], 1u);
      const unsigned tg = og / nx;
      if (og + 1u == (tg + 1u) * nx) xb_add(&bar[XB_TOPGEN], 1u);
      else XB_SPIN(xb_ld(&bar[XB_TOPGEN]) == tg, bar);
      __builtin_amdgcn_fence(__ATOMIC_ACQUIRE, "agent");
      xb_add(&bar[XB_XGEN(b.x)], 1u);
      asm volatile("s_waitcnt vmcnt(0)" ::: "memory");
    } else {
      XB_SPIN(xb_ld(&bar[XB_XGEN(b.x)]) == gen, bar);
      __builtin_amdgcn_fence(__ATOMIC_ACQUIRE, "agent");
      asm volatile("s_waitcnt vmcnt(0)" ::: "memory");
    }
  }
  __syncthreads();
}

constexpr int NPHASE = 21;

#ifndef PROBE_MASK
#define PROBE_MASK 0
#endif
DI int phase_kind(int ph) { if (ph == 0) return 0; const int rem = (ph - 1) % 10; return 1 + rem; }

#ifndef PROBE_SEL
#define PROBE_SEL -1
#endif
__global__ void __launch_bounds__(256, 2) fwd_kernel(Params p, int ph_lo, int ph_hi, int probe_mask, int probe_sel) {
  __shared__ __attribute__((aligned(16))) char smem[SMEM_BYTES];
  __shared__ uint4 xb_words;
  if (threadIdx.x == 0) xb_words = make_uint4(0u, 0u, 0u, 0u);
  __syncthreads();
  (void)xcd_barrier_post((unsigned*)(p.ws + OFF_bar), (volatile LAS unsigned*)&xb_words);
  for (int ph = ph_lo; ph < ph_hi; ++ph) {
    if (ph > ph_lo) {
      XcdBarrier xb;
      unsigned* bar_ = (unsigned*)(p.ws + OFF_bar);
      asm volatile("" : "+s"(bar_));
      xb.bar = bar_; xb.x = xb_xcc_id(); xb.st = (volatile LAS unsigned*)&xb_words;
      xcd_barrier(xb);
    }
    if (probe_mask < 0) cg::this_grid().sync();
    run_phase(p, smem, ph, false);
  }
}

extern "C" void kernel_launch(void* const* d_in, const int* in_sizes, int n_in, void* d_out, int out_size, void* d_ws,
                              size_t ws_size, hipStream_t stream) {
  Params p{};
  const float** fp = (const float**)&p;
  for (int i = 0; i < 22; ++i) fp[i] = (const float*)d_in[i];
  p.out = (float*)d_out;
  p.ws = (char*)d_ws;
  if (WS_TOTAL > ws_size) { fprintf(stderr, "workspace too small: have %zu\n", ws_size); return; }

  static int grid_blocks = 0;
  if (!grid_blocks) {
    int dev = 0, cus = 0, per_cu = 0;
    hipGetDevice(&dev);
    hipDeviceGetAttribute(&cus, hipDeviceAttributeMultiprocessorCount, dev);
    hipOccupancyMaxActiveBlocksPerMultiprocessor(&per_cu, fwd_kernel, 256, 0);
    if (per_cu > 2) per_cu = 2;
    grid_blocks = cus * per_cu;
    if (grid_blocks <= 0) grid_blocks = 256;
  }
#if COOP
  hipMemsetAsync(p.ws + OFF_bar, 0, (size_t)XCD_BAR_WORDS * 4, stream);
  int lo = 0, hi = NPHASE, pm = PROBE_MASK, psel = PROBE_SEL;
  void* args[] = {&p, &lo, &hi, &pm, &psel};
  hipError_t e = hipLaunchCooperativeKernel((void*)fwd_kernel, dim3(grid_blocks), dim3(256), args, 0, stream);
  if (e != hipSuccess) fprintf(stderr, "cooperative launch failed: %s (grid %d)\n", hipGetErrorString(e), grid_blocks);
#else
  for (int ph = 0; ph < NPHASE; ++ph) hipLaunchKernelGGL(fwd_kernel, dim3(grid_blocks), dim3(256), 0, stream, p, ph, ph + 1, 0, -1);
#endif
}
```
